# Optimizing an MI355X kernel written in HIP

```python
import jax, jax.numpy as jnp
from jax import lax
import numpy as np

D_MODEL = 2048
BATCH = 2
SEQ = 16384
DEPTH = 1

GRID_W = 64
CTX_LEN = 256
D_MIX = D_MODEL
MLSTM_WIDTH = D_MIX // 2
N_MLSTM_HEADS = 4
DV_MLSTM = MLSTM_WIDTH // N_MLSTM_HEADS
DK_MLSTM = DV_MLSTM // 2
QK_COLS = N_MLSTM_HEADS * DK_MLSTM
N_GATE_COLS = 4 * N_MLSTM_HEADS
CONV_WIDTH = D_MIX - MLSTM_WIDTH
CONV_HALF = CONV_WIDTH // 2
CONV_K = 3
CHUNK = 128
GATE_SOFT_CAP = 15.0
FGATE_BIAS_OFFSET = 3.0
P_IN = 2 * QK_COLS + 2 * MLSTM_WIDTH + N_GATE_COLS + 3 * CONV_WIDTH
N_EXPERTS = 32
TOP_K = 4
D_FF_EXPERT = D_MODEL
SWIGLU_LIMIT = 7.0
SWIGLU_ALPHA = 1.702
EXPERT_BLOCK = 512
N_MOD = 6
EPS = 1e-6

kernel_name = "hymba_mlstm_shortconv_moe_dit"


def rmsnorm(x, g):
    xf = x.astype(jnp.float32)
    y = xf * lax.rsqrt(jnp.mean(xf * xf, axis=-1, keepdims=True) + EPS)
    return (y * g.astype(jnp.float32)).astype(x.dtype)


def modulate(x, g, shift, scale):
    return rmsnorm(x, g) * (1 + scale) + shift


def adaln(cond, w, b):
    return jnp.split(jax.nn.silu(cond) @ w + b, N_MOD, axis=-1)


def soft_cap(x):
    return GATE_SOFT_CAP * jnp.tanh(x / GATE_SOFT_CAP)


def project(xn, w_in_l, b_if_l):
    B, S, _ = xn.shape
    sizes = (QK_COLS, QK_COLS, MLSTM_WIDTH, MLSTM_WIDTH, N_GATE_COLS, CONV_WIDTH, CONV_WIDTH, CONV_WIDTH)
    points = np.cumsum(sizes)[:-1].tolist()
    q, k, v, o, g, cb, cc, cx = jnp.split(xn @ w_in_l, points, axis=-1)
    heads = lambda t, dh: t.reshape(B, S, N_MLSTM_HEADS, dh).transpose(0, 2, 1, 3).astype(jnp.float32)
    q = heads(q, DK_MLSTM) * (DK_MLSTM ** -0.5)
    k = heads(k, DK_MLSTM)
    v = heads(v, DV_MLSTM)
    gp = soft_cap((g.astype(jnp.float32) + b_if_l.astype(jnp.float32))
                  .reshape(B, S, 4, N_MLSTM_HEADS).transpose(2, 0, 3, 1))
    gates = (gp[0], jax.nn.log_sigmoid(gp[1]), gp[2], jax.nn.log_sigmoid(gp[3]))
    return q, k, v, o, gates, cb, cc, cx


def _chunk_stats(k, v, log_i, log_f):
    B, H, S, dk = k.shape
    nc = S // CHUNK
    kc = k.reshape(B, H, nc, CHUNK, dk)
    vc = v.reshape(B, H, nc, CHUNK, -1)
    ic = log_i.reshape(B, H, nc, CHUNK)
    b = jnp.cumsum(log_f.reshape(B, H, nc, CHUNK), axis=-1)
    b_last = b[..., -1]
    w_end = b_last[..., None] - b + ic
    m_loc = jnp.max(w_end, axis=-1)
    ke = kc * jnp.exp(w_end - m_loc[..., None])[..., None]
    C_loc = jnp.einsum('bhcld,bhcle->bhcde', ke, vc)
    n_loc = ke.sum(axis=-2)
    return kc, vc, ic, b, b_last, m_loc, C_loc, n_loc


def _scan_chunks(b_last, m_loc, C_loc, n_loc, state0):
    def step(carry, inp):
        C, n, m = carry
        bl, ml, Cl, nl = inp
        m_new = jnp.maximum(bl + m, ml)
        a = jnp.exp(bl + m - m_new)
        g = jnp.exp(ml - m_new)
        new = (a[..., None, None] * C + g[..., None, None] * Cl, a[..., None] * n + g[..., None] * nl, m_new)
        return new, (C, n, m)
    xs = tuple(jnp.moveaxis(t, 2, 0) for t in (b_last, m_loc, C_loc, n_loc))
    final, entries = lax.scan(step, state0, xs)
    return tuple(jnp.moveaxis(t, 0, 2) for t in entries), final


def mlstm_final_state(k, v, log_i, log_f, state0):
    _, _, _, _, bl, ml, Cl, nl = _chunk_stats(k, v, log_i, log_f)
    return _scan_chunks(bl, ml, Cl, nl, state0)[1]


def mlstm_direction(q, k, v, log_i, log_f, state0):
    kc, vc, ic, b, bl, ml, Cl, nl = _chunk_stats(k, v, log_i, log_f)
    (C0, n0, m0), final = _scan_chunks(bl, ml, Cl, nl, state0)
    B, H, S, _ = q.shape
    qc = q.reshape(kc.shape)
    a = b + m0[..., None]
    lower = jnp.tril(jnp.ones((CHUNK, CHUNK), dtype=bool))
    d = jnp.where(lower, b[..., :, None] - b[..., None, :] + ic[..., None, :], -jnp.inf)
    m = jnp.maximum(a, jnp.max(d, axis=-1))
    w_intra = jnp.exp(d - m[..., None])
    w_state = jnp.exp(a - m)
    s = jnp.einsum('bhcjd,bhcsd->bhcjs', qc, kc) * w_intra
    num = jnp.einsum('bhcjs,bhcse->bhcje', s, vc) + w_state[..., None] * jnp.einsum('bhcjd,bhcde->bhcje', qc, C0)
    den = s.sum(axis=-1) + w_state * jnp.einsum('bhcjd,bhcd->bhcj', qc, n0)
    h = num / jnp.maximum(jnp.abs(den), jnp.exp(-m))[..., None]
    return h.reshape(B, H, S, -1), final


def _flip(t):
    return jnp.flip(t, axis=2)


def zero_state(B):
    return (jnp.zeros((B, N_MLSTM_HEADS, DK_MLSTM, DV_MLSTM), jnp.float32),
            jnp.zeros((B, N_MLSTM_HEADS, DK_MLSTM), jnp.float32),
            jnp.zeros((B, N_MLSTM_HEADS), jnp.float32))


def mlstm_merge(h, o, g):
    B, H, S, dv = h.shape
    h = h.transpose(0, 2, 1, 3)
    h = h * lax.rsqrt(jnp.mean(h * h, axis=-1, keepdims=True) + EPS)
    h = h.reshape(B, S, H * dv) * g.astype(jnp.float32) * jax.nn.sigmoid(o.astype(jnp.float32))
    return h.astype(o.dtype)


def shift_conv3(u, w, axis):
    pad = [(0, 0)] * u.ndim
    pad[axis] = (1, 1)
    up = jnp.pad(u, pad)
    n = u.shape[axis]
    left = lax.slice_in_dim(up, 0, n, axis=axis)
    mid = lax.slice_in_dim(up, 1, n + 1, axis=axis)
    right = lax.slice_in_dim(up, 2, n + 2, axis=axis)
    return w[0] * left + w[1] * mid + w[2] * right


def conv_grid(u, w, rows):
    B, S, CW = u.shape
    gr = u.reshape(B, rows, GRID_W, CW)
    yh = shift_conv3(gr[..., :CONV_HALF], w[:, :CONV_HALF], axis=2)
    yv = shift_conv3(gr[..., CONV_HALF:], w[:, CONV_HALF:], axis=1)
    return jnp.concatenate([yh, yv], axis=-1).reshape(B, S, CW)


def mixer_latent(xn, rows, w_in_l, b_if_l, conv_w_l, norm_g_l, w_out_l, st_f, st_b):
    q, k, v, o, (i_f, f_f, i_b, f_b), cb, cc, cx = project(xn, w_in_l, b_if_l)
    h_f, _ = mlstm_direction(q, k, v, i_f, f_f, st_f)
    h_b, _ = mlstm_direction(_flip(q), _flip(k), _flip(v), _flip(i_b), _flip(f_b), st_b)
    h_m = mlstm_merge(h_f + _flip(h_b), o, norm_g_l)
    y_c = cb * conv_grid(cc * cx, conv_w_l, rows)
    return jnp.concatenate([h_m, y_c], axis=-1) @ w_out_l


def mixer_context(cn, w_in_l, b_if_l, conv_w_l, norm_g_l, w_out_l, need_outputs):
    q, k, v, o, (i_f, f_f, i_b, f_b), cb, cc, cx = project(cn, w_in_l, b_if_l)
    z = zero_state(cn.shape[0])
    if need_outputs:
        h_f, st_f = mlstm_direction(q, k, v, i_f, f_f, z)
        h_b, st_b = mlstm_direction(_flip(q), _flip(k), _flip(v), _flip(i_b), _flip(f_b), z)
        h_m = mlstm_merge(h_f + _flip(h_b), o, norm_g_l)
        y_c = cb * shift_conv3(cc * cx, conv_w_l, axis=1)
        return jnp.concatenate([h_m, y_c], axis=-1) @ w_out_l, st_f, st_b
    st_f = mlstm_final_state(k, v, i_f, f_f, z)
    st_b = mlstm_final_state(_flip(k), _flip(v), _flip(i_b), _flip(f_b), z)
    return None, st_f, st_b


def moe(h, w_router_l, b_router_l, w_gu_l, b_gu_l, w_down_l, b_down_l):
    T, D = h.shape
    logits = (h @ w_router_l + b_router_l).astype(jnp.float32)
    top_vals, top_idx = lax.top_k(logits, TOP_K)
    top_w = jax.nn.softmax(top_vals, axis=-1)
    e_flat = top_idx.reshape(-1)
    w_flat = top_w.reshape(-1)
    tok_flat = jnp.arange(T * TOP_K, dtype=jnp.int32) // TOP_K
    onehot = (e_flat[:, None] == jnp.arange(N_EXPERTS, dtype=jnp.int32)[None, :]).astype(jnp.int32)
    counts = onehot.sum(axis=0)
    rank = jnp.take_along_axis(jnp.cumsum(onehot, axis=0), e_flat[:, None], axis=1)[:, 0] - 1
    padded = (counts + EXPERT_BLOCK - 1) // EXPERT_BLOCK * EXPERT_BLOCK
    pend = jnp.cumsum(padded)
    pstart = pend - padded
    dest = pstart[e_flat] + rank
    n_blocks = -(-(T * TOP_K) // EXPERT_BLOCK) + N_EXPERTS
    n_rows = n_blocks * EXPERT_BLOCK
    row_tok = jnp.zeros((n_rows,), jnp.int32).at[dest].set(tok_flat)
    row_w = jnp.zeros((n_rows,), jnp.float32).at[dest].set(w_flat)
    blk_start = jnp.arange(n_blocks, dtype=jnp.int32) * EXPERT_BLOCK
    blk_expert = jnp.clip(jnp.searchsorted(pend, blk_start, side='right'), 0, N_EXPERTS - 1)

    def expert_block(args):
        tok, wt, e = args
        xb = h[tok]
        gu = xb @ w_gu_l[e] + b_gu_l[e]
        gate = jnp.minimum(gu[:, :D_FF_EXPERT], SWIGLU_LIMIT)
        up = jnp.clip(gu[:, D_FF_EXPERT:], -SWIGLU_LIMIT, SWIGLU_LIMIT)
        act = (up + 1) * gate * jax.nn.sigmoid(SWIGLU_ALPHA * gate)
        y = act @ w_down_l[e] + b_down_l[e]
        return y * wt[:, None].astype(y.dtype)

    ys = lax.map(expert_block, (row_tok.reshape(n_blocks, EXPERT_BLOCK),
                                row_w.reshape(n_blocks, EXPERT_BLOCK), blk_expert))
    return jax.ops.segment_sum(ys.reshape(n_rows, D), row_tok, num_segments=T)


def setup_inputs(seed: int = 0) -> dict:
    key = jax.random.key(seed)
    ks = jax.random.split(key, 20)
    nrm = lambda k, shape, s: jax.random.normal(k, shape, jnp.float32) * s
    gate_offset = jnp.tile(jnp.repeat(jnp.array([0.0, FGATE_BIAS_OFFSET], jnp.float32), N_MLSTM_HEADS), 2)
    return {
        "x": nrm(ks[0], (BATCH, SEQ, D_MODEL), 1.0),
        "c": nrm(ks[1], (BATCH, D_MODEL), 1.0),
        "ctx": nrm(ks[2], (BATCH, CTX_LEN, D_MODEL), 1.0),
        "c_ctx": nrm(ks[3], (D_MODEL,), 1.0),
        "w_ada": nrm(ks[4], (DEPTH, D_MODEL, N_MOD * D_MODEL), 0.5 * D_MODEL ** -0.5),
        "b_ada": nrm(ks[5], (DEPTH, N_MOD * D_MODEL), 0.02),
        "g_mix": 1.0 + nrm(ks[6], (DEPTH, D_MODEL), 0.1),
        "w_in": nrm(ks[7], (DEPTH, D_MODEL, P_IN), D_MODEL ** -0.5),
        "b_if": gate_offset + nrm(ks[8], (DEPTH, N_GATE_COLS), 0.5),
        "conv_w": nrm(ks[9], (DEPTH, CONV_K, CONV_WIDTH), 0.5),
        "mlstm_norm_g": 1.0 + nrm(ks[10], (DEPTH, MLSTM_WIDTH), 0.1),
        "w_out": nrm(ks[11], (DEPTH, D_MIX, D_MODEL), D_MIX ** -0.5),
        "g_ffn": 1.0 + nrm(ks[12], (DEPTH, D_MODEL), 0.1),
        "w_router": nrm(ks[13], (DEPTH, D_MODEL, N_EXPERTS), D_MODEL ** -0.5),
        "b_router": nrm(ks[14], (DEPTH, N_EXPERTS), 0.01),
        "w_gu": nrm(ks[15], (DEPTH, N_EXPERTS, D_MODEL, 2 * D_FF_EXPERT), D_MODEL ** -0.5),
        "b_gu": nrm(ks[16], (DEPTH, N_EXPERTS, 2 * D_FF_EXPERT), 0.01),
        "w_down": nrm(ks[17], (DEPTH, N_EXPERTS, D_FF_EXPERT, D_MODEL), D_FF_EXPERT ** -0.5),
        "b_down": nrm(ks[18], (DEPTH, N_EXPERTS, D_MODEL), 0.01),
        "g_final": 1.0 + nrm(ks[19], (D_MODEL,), 0.1),
    }


def reference(x, c, ctx, c_ctx, w_ada, b_ada, g_mix, w_in, b_if, conv_w, mlstm_norm_g, w_out,
              g_ffn, w_router, b_router, w_gu, b_gu, w_down, b_down, g_final):
    B, S, D = x.shape
    rows = S // GRID_W
    for l in range(DEPTH):
        last = l == DEPTH - 1
        sh_m, sc_m, gt_m, sh_f, sc_f, gt_f = [t[:, None, :] for t in adaln(c, w_ada[l], b_ada[l])]
        csh_m, csc_m, cgt_m, csh_f, csc_f, cgt_f = adaln(c_ctx, w_ada[l], b_ada[l])
        ctx_mix, st_f, st_b = mixer_context(modulate(ctx, g_mix[l], csh_m, csc_m), w_in[l], b_if[l],
                                            conv_w[l], mlstm_norm_g[l], w_out[l], need_outputs=not last)
        xn = modulate(x, g_mix[l], sh_m, sc_m)
        x = x + gt_m * mixer_latent(xn, rows, w_in[l], b_if[l], conv_w[l], mlstm_norm_g[l], w_out[l], st_f, st_b)
        xn = modulate(x, g_ffn[l], sh_f, sc_f)
        x = x + gt_f * moe(xn.reshape(-1, D), w_router[l], b_router[l], w_gu[l], b_gu[l],
                           w_down[l], b_down[l]).reshape(B, S, D)
        if not last:
            ctx = ctx + cgt_m * ctx_mix
            cn = modulate(ctx, g_ffn[l], csh_f, csc_f)
            ctx = ctx + cgt_f * moe(cn.reshape(-1, D), w_router[l], b_router[l], w_gu[l], b_gu[l],
                                    w_down[l], b_down[l]).reshape(ctx.shape)
    return rmsnorm(x, g_final)
```

```cpp
#include <hip/hip_runtime.h>
#include <cstdio>
#include <cstdint>

#ifndef MK_ONE_LAUNCH
#define MK_ONE_LAUNCH 1
#endif

#define DI __device__ __forceinline__
#define LAS __attribute__((address_space(3)))
typedef unsigned short bf16_t;
typedef short bf16x8 __attribute__((ext_vector_type(8)));
typedef short s16x4 __attribute__((ext_vector_type(4)));
typedef float f32x4 __attribute__((ext_vector_type(4)));
typedef float f32x2 __attribute__((ext_vector_type(2)));
typedef float f32x16 __attribute__((ext_vector_type(16)));
typedef unsigned u32x4 __attribute__((ext_vector_type(4)));
typedef unsigned u32x2 __attribute__((ext_vector_type(2)));
typedef __bf16 bf16x2_t __attribute__((ext_vector_type(2)));

constexpr int LDS_CTL_OFF = 147456;
constexpr int LDS_BYTES = LDS_CTL_OFF + 6144;
extern __shared__ __attribute__((aligned(16))) unsigned char lds_raw[];
DI int lane_id() { int l; asm volatile("v_mbcnt_lo_u32_b32 %0, -1, 0\n\tv_mbcnt_hi_u32_b32 %0, -1, %0" : "=v"(l)); return l; }
DI unsigned hw_wave_slot() { return (unsigned)__builtin_amdgcn_s_getreg((5 << 11) | 4) & 63u; }
DI int wave_in_wg() { return __builtin_amdgcn_readfirstlane(((const LAS int*)((LAS unsigned char*)lds_raw + LDS_CTL_OFF + 1024))[hw_wave_slot()]); }
DI int my_tid() { return wave_in_wg() * 64 + lane_id(); }
DI unsigned pk2(float a, float b) { f32x2 f = {a, b}; bf16x2_t h = __builtin_convertvector(f, bf16x2_t); return __builtin_bit_cast(unsigned, h); }
constexpr float WSCALE = 512.0f, WSCALE_INV = 1.0f / 512.0f;
DI unsigned pk4f8(float a, float b, float c, float d) { int p = __builtin_amdgcn_cvt_pk_fp8_f32(a, b, 0, false); p = __builtin_amdgcn_cvt_pk_fp8_f32(c, d, p, true); return (unsigned)p; }
DI unsigned pk4i8(float a, float b, float c, float d) {
    const int qa = (int)a, qb = (int)b, qc = (int)c, qd = (int)d; return (unsigned)(qa & 255) | ((unsigned)(qb & 255) << 8) | ((unsigned)(qc & 255) << 16) | ((unsigned)qd << 24); }
DI float bf_lo(unsigned w) { return __uint_as_float(w << 16); }
DI float bf_hi(unsigned w) { return __uint_as_float(w & 0xffff0000u); }
DI float bf2f(unsigned short s) { return __uint_as_float(((unsigned)s) << 16); }

constexpr int D = 2048, NB = 2, SEQ = 16384, T = NB * SEQ, CTXL = 256, TC = NB * CTXL, MT = T + TC;
constexpr int P_IN = 6160, GATE_COL0 = 3072, NMOD = 6 * D;
constexpr int NE = 32, TOPK = 4;
constexpr int NCHUNK = SEQ / 128;
constexpr float EPS = 1e-6f;
constexpr int NPH = 13;

constexpr size_t MiB = 1u << 20;
constexpr size_t WS_CTL = 0, CTL_ZERO_BYTES = 1 * MiB;
constexpr size_t WS_MODP = 1 * MiB;
constexpr size_t WS_MODF = WS_MODP + 768 * 1024;
constexpr size_t WS_WIN = 2 * MiB;
constexpr size_t WS_WOUT = 27 * MiB;
constexpr size_t WS_WR = 35 * MiB;
constexpr size_t WS_WGU = 36 * MiB;
constexpr size_t WS_WDN = 292 * MiB;
constexpr size_t WS_XN = 420 * MiB;
constexpr size_t WS_GATES = 550 * MiB;
constexpr size_t WS_XSC = WS_GATES + 3 * MiB;
constexpr size_t WS_WSC = WS_GATES + 3 * MiB + 256 * 1024;
constexpr size_t WS_Q = 554 * MiB;
constexpr size_t WS_K = 586 * MiB;
constexpr size_t WS_VT = 619 * MiB;
constexpr size_t WS_O = 684 * MiB;
constexpr size_t WS_CB = 748 * MiB, WS_CC = 812 * MiB, WS_CX = 876 * MiB;
constexpr size_t WS_TUPC = 940 * MiB;
constexpr size_t WS_TUPN = 972 * MiB;
constexpr size_t WS_ENTC = 973 * MiB;
constexpr size_t WS_ENTN = 1005 * MiB;
constexpr size_t WS_HF = 1006 * MiB, WS_HB = 1070 * MiB;
constexpr size_t WS_A2 = 1134 * MiB;
constexpr size_t WS_XG = 1262 * MiB;
constexpr size_t WS_BGU = WS_XG, WS_BDN = WS_XG + 1 * MiB;
constexpr size_t WS_ACT = 1534 * MiB;
constexpr size_t WS_XN8 = 1806 * MiB;
constexpr size_t WS_X1 = 1870 * MiB;
constexpr size_t WS_LOGITS = 2126 * MiB;
constexpr size_t WS_LIST = 2000 * MiB;
constexpr size_t WS_LISTW = 2004 * MiB;
constexpr size_t WS_YS = 2138 * MiB;
constexpr size_t WS_END = 2394 * MiB;
static_assert(WS_ACT + (size_t)139264 * 2048 <= WS_XN8 && WS_XN8 < ((size_t)1 << 31) && WS_X1 + (size_t)T * D * 2 <= WS_LIST && WS_LISTW + 4 * MiB <= ((size_t)1 << 31), "GEMM operands and token lists below 2 GiB");
constexpr int CW_BAR = 4096;
constexpr int CW_GCNT = 16384;
constexpr size_t WS_WOSC = WS_WSC + 32768, WS_ASC = WS_WSC + 262144;
constexpr size_t WS_WR2 = WS_XG + 4 * MiB, WS_RSTD = WS_XG + 8 * MiB, WS_CBR = WS_XG + 9 * MiB;
constexpr int CW_POOL = 20480;


#define XB_TMO      128
#define XB_XCNT(j)  (256  + 64 * (j))
#define XB_XSUB(j)  (1280 + 64 * (j))
#define XB_XGEN(j)  (2304 + 64 * (j))
#define XB_TOP      3328
#define XB_TOPGEN   3392
#define XCD_BAR_WORDS 3456
#define XB_SPIN_CAP (1u << 21)
__device__ __forceinline__ unsigned xb_ld(unsigned* p)              { return __hip_atomic_load(p, __ATOMIC_RELAXED, __HIP_MEMORY_SCOPE_AGENT); }
__device__ __forceinline__ unsigned xb_add(unsigned* p, unsigned v) { return __hip_atomic_fetch_add(p, v, __ATOMIC_RELAXED, __HIP_MEMORY_SCOPE_AGENT); }
__device__ __forceinline__ unsigned xb_xcc_id() { return (unsigned)__builtin_amdgcn_s_getreg((3 << 11) | 20) & 0xFu; }
#define XB_SPIN(cond, bar) do { unsigned _sp = 0; while (cond) { __builtin_amdgcn_s_sleep(1); \
    if ((++_sp & 255u) == 0u) { if (xb_ld(&(bar)[XB_TMO])) break; if (_sp > XB_SPIN_CAP) { atomicAdd(&(bar)[XB_TMO], 1u); break; } } } } while (0)
struct XcdBarrier { unsigned* bar; unsigned x; volatile LAS unsigned* st; };
__device__ __forceinline__ XcdBarrier xcd_barrier_post(unsigned* bar, volatile LAS unsigned* st) {
    XcdBarrier b; b.bar = bar; b.x = xb_xcc_id(); b.st = st;
    if (my_tid() == 0) (void)xb_add(&bar[XB_XCNT(b.x)], 1u);
    return b;
}
__device__ __forceinline__ void xcd_barrier_complete(unsigned* bar, unsigned x, unsigned& nloc, unsigned& nx) {
    const unsigned G = gridDim.x * gridDim.y * gridDim.z;
    unsigned sum, cnt, mine, sp = 0u;
    for (;;) {
        sum = 0u; cnt = 0u; mine = 0u;
#pragma unroll
        for (unsigned j = 0; j < 16; ++j) { const unsigned c = xb_ld(&bar[XB_XCNT(j)]); sum += c; cnt += (c > 0u) ? 1u : 0u; mine = (j == x) ? c : mine; }
        if (sum == G) break;
        __builtin_amdgcn_s_sleep(1);
        if ((++sp & 255u) == 0u) { if (xb_ld(&bar[XB_TMO])) break; if (sp > XB_SPIN_CAP) { atomicAdd(&bar[XB_TMO], 1u); break; } }
    }
    nloc = mine > 0u ? mine : 1u; nx = cnt > 0u ? cnt : 1u;
}
__device__ __forceinline__ void xcd_barrier(const XcdBarrier& b) {
    asm volatile("s_waitcnt vmcnt(0)" ::: "memory");
    __syncthreads();
    if (my_tid() == 0) {
        unsigned* bar = b.bar;
        __builtin_amdgcn_s_waitcnt(0);
        unsigned nloc = b.st[0], nx = b.st[1];
        if (nloc == 0u) { xcd_barrier_complete(bar, b.x, nloc, nx); b.st[0] = nloc; b.st[1] = nx; }
        const unsigned old = xb_add(&bar[XB_XSUB(b.x)], 1u);
        const unsigned gen = old / nloc;
        if (old + 1u == (gen + 1u) * nloc) {
            __builtin_amdgcn_fence(__ATOMIC_RELEASE, "agent");
            asm volatile("s_waitcnt vmcnt(0)" ::: "memory");
            const unsigned og = xb_add(&bar[XB_TOP], 1u);
            const unsigned tg = og / nx;
            if (og + 1u == (tg + 1u) * nx) xb_add(&bar[XB_TOPGEN], 1u);
            else XB_SPIN(xb_ld(&bar[XB_TOPGEN]) == tg, bar);
            __builtin_amdgcn_fence(__ATOMIC_ACQUIRE, "agent");
            xb_add(&bar[XB_XGEN(b.x)], 1u);
            asm volatile("s_waitcnt vmcnt(0)" ::: "memory");
        } else {
            XB_SPIN(xb_ld(&bar[XB_XGEN(b.x)]) == gen, bar);
            __builtin_amdgcn_fence(__ATOMIC_ACQUIRE, "agent");
            asm volatile("s_waitcnt vmcnt(0)" ::: "memory");
        }
    }
    __syncthreads();
}

namespace pg8 {
constexpr int BM = 256, BK = 64, HALF = 128, HTB = HALF * BK * 2, STAGE_BYTES = 8 * HTB, NXCD = 8, WGM = 8;
__host__ __device__ __forceinline__ int lds_byte(int r, int c) { const int st = (r >> 4) * 2 + (c >> 5), rr = r & 15, cc = c & 31, ob = rr * 64 + cc * 2; return st * 1024 + (ob ^ (((ob >> 9) & 1) << 5)); }
__host__ __device__ __forceinline__ void stage_rc(int b, int& R, int& C) { const int st = b / 1024, sb = b % 1024, swz = sb ^ (((sb >> 9) & 1) << 5); R = (st >> 1) * 16 + swz / 64; C = (st & 1) * 32 + (swz % 64) / 2; }
__host__ __device__ __forceinline__ int perm32(int rho) { const int n = rho >> 4, i = rho & 15; return 8 * (i >> 2) + 4 * n + (i & 3); }

struct Unit { unsigned A; unsigned B; char* O; int ldc; int a0; int a1; int buf; };

__device__ __forceinline__ void tile_order(int wgid, int nwg, int nM, int nN, int& pm, int& pn) {
    const int nig = WGM * nN, gid = wgid / nig, fm = gid * WGM, gsz = (nM - fm) < WGM ? (nM - fm) : WGM;
    pm = fm + ((wgid % nig) % gsz); pn = (wgid % nig) / gsz;
}
__device__ __forceinline__ int xcd_remap(int L, int nwg) { const int q = nwg / NXCD, r = nwg % NXCD, xcd = L % NXCD, off = L / NXCD; return (xcd < r ? xcd * (q + 1) : r * (q + 1) + (xcd - r) * q) + off; }

typedef int i32x4_t __attribute__((ext_vector_type(4)));
typedef int i32x8_t __attribute__((ext_vector_type(8)));
__device__ __forceinline__ i32x8_t cat8(bf16x8 a, bf16x8 b) { return __builtin_shufflevector(__builtin_bit_cast(i32x4_t, a), __builtin_bit_cast(i32x4_t, b), 0, 1, 2, 3, 4, 5, 6, 7); }
template <class Epi, class Sched, bool ALIGN_EPI, bool SP2, int DT = 0  >
__device__ __forceinline__ void gemm_phase(LAS unsigned char* lds, const void* wsbase, const int KB, const Sched& S, const Epi& E) {
    constexpr bool F8 = (DT == 1), I8 = (DT == 2);
    const __amdgpu_buffer_rsrc_t rsrc = __builtin_amdgcn_make_buffer_rsrc((void*)wsbase, 0, -1, 0x00020000);
    const int tid = my_tid(), wid = __builtin_amdgcn_readfirstlane(tid >> 6), lane = tid & 63, wr = wid >> 2, wc = wid & 3, fr = lane & 15, fq = lane >> 4;
    const int nt = KB / 128;
    unsigned voffA[2], voffB[2];
#pragma unroll
    for (int i = 0; i < 2; ++i) { int R, C;
        { const int b = tid * 16 + i * 8192; const int p = (b >> 7) & 15, fr_ = ((p & 1) << 3) | (p >> 1); R = (b >> 11) * 16 + fr_; C = ((((b >> 4) & 7) ^ (fr_ & 7))) * 16; }
        const int Rb = Epi::PERM ? ((R & ~31) + perm32(R & 31)) : R;
        voffA[i] = (unsigned)(R * KB + C); voffB[i] = (unsigned)(Rb * KB + C); }
    constexpr bool GATHER = Sched::GATHER;
    unsigned vG[2][2];
    auto load_rows = [&](int buf, int nvalid) { const int t_ = (wid << 6) | lane_id();
#pragma unroll
        for (int i = 0; i < 2; ++i) { const int b = t_ * 16 + i * 8192; const int p = (b >> 7) & 15, fr_ = ((p & 1) << 3) | (p >> 1); const int R = (b >> 11) * 16 + fr_, C = ((((b >> 4) & 7) ^ (fr_ & 7))) * 16;
#pragma unroll
            for (int hh_ = 0; hh_ < 2; ++hh_) { const int rr = hh_ * 128 + R; const unsigned slot = ((const LAS unsigned*)(lds + LDS_CTL_OFF + 2048))[buf * 256 + rr];
                vG[hh_][i] = (rr < nvalid ? (slot >> 2) * (unsigned)KB : 0u) + (unsigned)C; } } };
    constexpr bool ETAB = Sched::ETAB;
    auto dma_etab = [&](const Unit& u_, int buf) {
        if constexpr (ETAB) { if ((wid & ~1) == 4) __builtin_amdgcn_raw_ptr_buffer_load_lds(rsrc, (LAS void*)(lds + LDS_CTL_OFF + 2048 + (wid - 4) * 2048 + buf * 1024), 16, lane_id() * 16, (int)S.etab_off(u_, wid - 4), 0, 0); } };
    constexpr bool BIAS = Sched::BIAS;
    auto dma_bias = [&](const Unit& u_, int buf) {
        if constexpr (BIAS) { if ((wid == 6 || wid == 7) && lane_id() < 32) __builtin_amdgcn_raw_ptr_buffer_load_lds(rsrc, (LAS void*)(lds + LDS_CTL_OFF + 4096 + buf * 1024 + (wid - 6) * 512), 16, lane_id() * 16, (int)S.bias_off(u_, wid - 6), 0, 0); } };
    auto dma_list = [&](unsigned goff, int buf) {
        if (wid == 4) __builtin_amdgcn_raw_ptr_buffer_load_lds(rsrc, (LAS void*)(lds + LDS_CTL_OFF + 2048 + buf * 1024), 16, lane_id() * 16, (int)goff, 0, 0); };
    const unsigned kstep = 128u;
    const unsigned hstep = (unsigned)(HALF * KB);
    const unsigned ldsw = (unsigned)wid * 1024u;
    int aoff[2], boff[2];
#pragma unroll
    for (int x = 0; x < 2; ++x) { const int ch = F8 ? (2 * fq + x) : (fq + 4 * x); const int o = ((((fr & 7) << 1) | (fr >> 3)) << 7) + ((ch ^ (fr & 7)) << 4); aoff[x] = wr * 8192 + o; boff[x] = wc * 4096 + o; }
#define PG8_SA(b, h) (((b) * 2 + (h)) * HTB)
#define PG8_SB(b, h) ((4 + (b) * 2 + (h)) * HTB)
#define PG8_STAGE(bufoff, gbase, voff) do { _Pragma("unroll") for (int _i = 0; _i < 2; ++_i) \
        __builtin_amdgcn_raw_ptr_buffer_load_lds(rsrc, (LAS void*)(lds + (bufoff) + ldsw + _i * 8192), 16, (int)(voff)[_i], (int)(gbase), 0, 0); } while (0)
#define PG8_STAGE_A(bufoff, h, goff) do { if constexpr (GATHER) { PG8_STAGE(bufoff, goff, vG[h]); } else { PG8_STAGE(bufoff, (goff) + (h) * hstep, voffA); } } while (0)
#define PG8_LDA(dst, b, h) do { _Pragma("unroll") for (int m = 0; m < 4; ++m) { \
        if constexpr (F8) dst##8[m] = cat8(*(const LAS bf16x8*)(lds + PG8_SA(b, h) + aoff[0] + m * 2048), *(const LAS bf16x8*)(lds + PG8_SA(b, h) + aoff[1] + m * 2048)); \
        else { _Pragma("unroll") for (int k = 0; k < 2; ++k) dst[m][k] = *(const LAS bf16x8*)(lds + PG8_SA(b, h) + aoff[k] + m * 2048); } } } while (0)
#define PG8_LDB(dst, b, h) do { _Pragma("unroll") for (int n = 0; n < 2; ++n) { \
        if constexpr (F8) dst##8[n] = cat8(*(const LAS bf16x8*)(lds + PG8_SB(b, h) + boff[0] + n * 2048), *(const LAS bf16x8*)(lds + PG8_SB(b, h) + boff[1] + n * 2048)); \
        else { _Pragma("unroll") for (int k = 0; k < 2; ++k) dst[n][k] = *(const LAS bf16x8*)(lds + PG8_SB(b, h) + boff[k] + n * 2048); } } } while (0)
#define PG8_MMA(ai, bj, At, Bt) do { __builtin_amdgcn_s_setprio(1); _Pragma("unroll") for (int m = 0; m < 4; ++m) _Pragma("unroll") for (int n = 0; n < 2; ++n) { \
        if constexpr (F8) { acc[ai][bj][m][n] = __builtin_amdgcn_mfma_scale_f32_16x16x128_f8f6f4(Bt##8[n], At##8[m], acc[ai][bj][m][n], 0, 0, 0, 0, 0, 0); }     \
        else if constexpr (I8) { _Pragma("unroll") for (int k = 0; k < 2; ++k) acc[ai][bj][m][n] = __builtin_bit_cast(f32x4, __builtin_amdgcn_mfma_i32_16x16x64_i8(__builtin_bit_cast(i32x4_t, Bt[n][k]), __builtin_bit_cast(i32x4_t, At[m][k]), __builtin_bit_cast(i32x4_t, acc[ai][bj][m][n]), 0, 0, 0)); } \
        else { _Pragma("unroll") for (int k = 0; k < 2; ++k) acc[ai][bj][m][n] = __builtin_amdgcn_mfma_f32_16x16x32_bf16(Bt[n][k], At[m][k], acc[ai][bj][m][n], 0, 0, 0); } } \
        __builtin_amdgcn_s_setprio(0); } while (0)
#define PG8_WAIT_V(n) asm volatile("s_waitcnt vmcnt(" #n ")" ::: "memory")
#define PG8_WAIT_L(n) asm volatile("s_waitcnt lgkmcnt(" #n ")" ::: "memory")
#define PG8_BAR __builtin_amdgcn_s_barrier()
#define PG8_SCHED __builtin_amdgcn_sched_barrier(0)
    Unit cur, nxt; int ui = 0;
    if (!S.next(0, cur)) return;
    f32x4 acc[2][2][4][2];
#pragma unroll
    for (int a = 0; a < 2; ++a)
#pragma unroll
        for (int b = 0; b < 2; ++b)
#pragma unroll
            for (int m = 0; m < 4; ++m)
#pragma unroll
                for (int n = 0; n < 2; ++n) acc[a][b][m][n] = (f32x4){0.f, 0.f, 0.f, 0.f};
    bf16x8 At[4][2], B0[2][2], B1[2][2]; i32x8_t At8[4], B08[2], B18[2];
    unsigned cA = cur.A, cB = cur.B;
    if constexpr (BIAS) { dma_bias(cur, 0); }
    if constexpr (ETAB) { dma_etab(cur, 0); asm volatile("s_waitcnt vmcnt(0)" ::: "memory"); __builtin_amdgcn_s_barrier(); }
    if constexpr (GATHER) { dma_list(S.list_off(cur), 0); asm volatile("s_waitcnt vmcnt(0)" ::: "memory"); __builtin_amdgcn_s_barrier(); load_rows(0, S.row_cnt(cur)); }
    if constexpr (SP2) {
        PG8_STAGE(PG8_SB(0, 0), cB, voffB); PG8_STAGE(PG8_SB(0, 1), cB + hstep, voffB); PG8_STAGE_A(PG8_SA(0, 0), 0, cA); PG8_STAGE_A(PG8_SA(0, 1), 1, cA);
        if (wr == 1) PG8_BAR;
        PG8_WAIT_V(2); PG8_BAR;
        PG8_STAGE(PG8_SB(1, 0), cB + kstep, voffB); PG8_STAGE_A(PG8_SA(1, 0), 0, cA + kstep); PG8_STAGE(PG8_SB(1, 1), cB + hstep + kstep, voffB);
        PG8_WAIT_V(6); PG8_BAR;
    } else {
        PG8_STAGE(PG8_SB(0, 0), cB, voffB); PG8_STAGE(PG8_SA(0, 0), cA, voffA); PG8_STAGE(PG8_SB(0, 1), cB + hstep, voffB); PG8_STAGE(PG8_SA(0, 1), cA + hstep, voffA);
        if (wr == 1) PG8_BAR;
        PG8_WAIT_V(4); PG8_BAR;
        PG8_STAGE(PG8_SB(1, 0), cB + kstep, voffB); PG8_STAGE(PG8_SA(1, 0), cA + kstep, voffA); PG8_STAGE(PG8_SB(1, 1), cB + hstep + kstep, voffB);
        PG8_WAIT_V(6); PG8_BAR;
    }
    for (;;) {
        const bool has_next = S.next(ui + 1, nxt);
        if constexpr (GATHER) { if (has_next) dma_list(S.list_off(nxt), (ui + 1) & 1); }
        if constexpr (ETAB) { if (has_next) dma_etab(nxt, (ui + 1) & 1); }
        if constexpr (BIAS) { if (has_next) dma_bias(nxt, (ui + 1) & 1); }
        const unsigned nA = has_next ? nxt.A : cA, nB = has_next ? nxt.B : cB;
        for (int t = 0; t < nt; t += 2) {
            const bool last = (t == nt - 2);
            const unsigned a1 = cA + (unsigned)(t + 1) * kstep;
            const unsigned a2 = last ? nA : cA + (unsigned)(t + 2) * kstep, b2 = last ? nB : cB + (unsigned)(t + 2) * kstep;
            const unsigned a3 = a2 + kstep, b3 = b2 + kstep;
            if constexpr (SP2) {
            PG8_LDB(B0, 0, 0); PG8_LDB(B1, 0, 1); PG8_SCHED; PG8_LDA(At, 0, 0); PG8_STAGE_A(PG8_SA(1, 1), 1, a1);
            if constexpr (GATHER) { if (last && has_next) load_rows((ui + 1) & 1, S.row_cnt(nxt)); }
            PG8_WAIT_V(8); PG8_WAIT_L(0); PG8_BAR; PG8_MMA(0, 0, At, B0); PG8_MMA(0, 1, At, B1); PG8_BAR; PG8_SCHED;
            PG8_LDA(At, 0, 1); PG8_STAGE(PG8_SB(0, 0), b2, voffB); PG8_STAGE(PG8_SB(0, 1), b2 + hstep, voffB); PG8_STAGE_A(PG8_SA(0, 0), 0, a2);
            PG8_WAIT_V(8); PG8_WAIT_L(0); PG8_BAR; PG8_MMA(1, 0, At, B0); PG8_MMA(1, 1, At, B1); PG8_BAR; PG8_SCHED;
            PG8_LDB(B0, 1, 0); PG8_LDB(B1, 1, 1); PG8_SCHED; PG8_LDA(At, 1, 0); PG8_STAGE_A(PG8_SA(0, 1), 1, a2);
            PG8_WAIT_V(8); PG8_WAIT_L(0); PG8_BAR; PG8_MMA(0, 0, At, B0); PG8_MMA(0, 1, At, B1); PG8_BAR; PG8_SCHED;
            PG8_LDA(At, 1, 1); PG8_STAGE(PG8_SB(1, 0), b3, voffB); PG8_STAGE(PG8_SB(1, 1), b3 + hstep, voffB); PG8_STAGE_A(PG8_SA(1, 0), 0, a3);
            PG8_WAIT_V(8); PG8_WAIT_L(0); PG8_BAR; PG8_MMA(1, 0, At, B0); PG8_MMA(1, 1, At, B1); PG8_BAR; PG8_SCHED;
            } else {
            PG8_LDB(B0, 0, 0); PG8_SCHED; PG8_LDA(At, 0, 0); PG8_STAGE(PG8_SA(1, 1), a1 + hstep, voffA);
            PG8_WAIT_L(8); PG8_BAR; PG8_WAIT_L(0); PG8_MMA(0, 0, At, B0); PG8_BAR; PG8_SCHED;
            PG8_LDB(B1, 0, 1); PG8_STAGE(PG8_SB(0, 0), b2, voffB);
            PG8_BAR; PG8_WAIT_L(0); PG8_MMA(0, 1, At, B1); PG8_BAR;
            PG8_LDA(At, 0, 1); PG8_STAGE(PG8_SA(0, 0), a2, voffA);
            PG8_BAR; PG8_WAIT_L(0); PG8_MMA(1, 0, At, B0); PG8_BAR; PG8_SCHED;
            PG8_STAGE(PG8_SB(0, 1), b2 + hstep, voffB);
            PG8_WAIT_V(6); PG8_BAR; PG8_MMA(1, 1, At, B1); PG8_BAR;
            PG8_LDB(B0, 1, 0); PG8_SCHED; PG8_LDA(At, 1, 0); PG8_STAGE(PG8_SA(0, 1), a2 + hstep, voffA);
            PG8_WAIT_L(8); PG8_BAR; PG8_WAIT_L(0); PG8_MMA(0, 0, At, B0); PG8_BAR; PG8_SCHED;
            PG8_LDB(B1, 1, 1); PG8_STAGE(PG8_SB(1, 0), b3, voffB);
            PG8_BAR; PG8_WAIT_L(0); PG8_MMA(0, 1, At, B1); PG8_BAR;
            PG8_LDA(At, 1, 1); PG8_STAGE(PG8_SA(1, 0), a3, voffA);
            PG8_BAR; PG8_WAIT_L(0); PG8_MMA(1, 0, At, B0); PG8_BAR; PG8_SCHED;
            PG8_STAGE(PG8_SB(1, 1), b3 + hstep, voffB);
            PG8_WAIT_V(6); PG8_BAR; PG8_MMA(1, 1, At, B1); PG8_BAR;
            }
        }
        if constexpr (ALIGN_EPI) { if (wr == 0) PG8_BAR; }
        { int l2 = lane_id(); asm volatile("" : "+v"(l2)); cur.buf = ui & 1; E(acc, cur, wr, wc, l2 & 15, l2 >> 4); }
        if (!has_next) break;
#pragma unroll
        for (int a = 0; a < 2; ++a)
#pragma unroll
            for (int b = 0; b < 2; ++b)
#pragma unroll
                for (int m = 0; m < 4; ++m)
#pragma unroll
                    for (int n = 0; n < 2; ++n) acc[a][b][m][n] = (f32x4){0.f, 0.f, 0.f, 0.f};
        cur = nxt; cA = nA; cB = nB; ++ui;
        if constexpr (ALIGN_EPI) { if (wr == 1) PG8_BAR; }
    }
    PG8_WAIT_V(0);
    if constexpr (!ALIGN_EPI) { if (wr == 0) PG8_BAR; }
    PG8_BAR;
#undef PG8_SA
#undef PG8_SB
#undef PG8_STAGE
#undef PG8_LDA
#undef PG8_STAGE_A
#undef PG8_LDB
#undef PG8_MMA
#undef PG8_WAIT_V
#undef PG8_WAIT_L
#undef PG8_BAR
#undef PG8_SCHED
}

struct EpiStore {
    static constexpr bool PERM = true;
    const float* bif; const float* xsc; const float* wsc;
    __device__ __forceinline__ void operator()(const f32x4 (&acc)[2][2][4][2], const Unit& u, int wr, int wc, int fr, int fq) const {
        const bool swapped = (u.a1 >= 4 && u.a1 < 8);
        const float* sA = swapped ? wsc + u.a1 * BM : xsc + u.a0 * BM; const float* sB = swapped ? xsc + u.a0 * BM : wsc + u.a1 * BM;
        const int row0 = wr * 64 + fr, col0 = wc * 32 + 8 * fq;
        if (u.ldc == 0) {
            if (wc == 0 && fq < 2) { float* g = (float*)u.O; const f32x4 b0 = *(const f32x4*)(bif + 8 * fq), b1 = *(const f32x4*)(bif + 8 * fq + 4); const f32x4 s0 = *(const f32x4*)(sB + 8 * fq), s1 = *(const f32x4*)(sB + 8 * fq + 4);
#pragma unroll
                for (int ai = 0; ai < 2; ++ai)
#pragma unroll
                    for (int m = 0; m < 4; ++m) { const int r = row0 + ai * HALF + m * 16; const float sr = sA[r]; float* rp = g + (size_t)r * 16 + 8 * fq;
                        const i32x4_t a0 = __builtin_bit_cast(i32x4_t, acc[ai][0][m][0]), a1 = __builtin_bit_cast(i32x4_t, acc[ai][0][m][1]);
                        *(f32x4*)rp = __builtin_convertvector(a0, f32x4) * sr * s0 + b0; *(f32x4*)(rp + 4) = __builtin_convertvector(a1, f32x4) * sr * s1 + b1; } }
            return; }
        bf16_t* base = (bf16_t*)u.O; const int ldc = u.ldc;
        f32x4 sb[2][2];
#pragma unroll
        for (int bj = 0; bj < 2; ++bj)
#pragma unroll
            for (int n = 0; n < 2; ++n) sb[bj][n] = *(const f32x4*)(sB + col0 + bj * HALF + 4 * n);
        if (u.a1 >= 16) {
#pragma unroll
            for (int ai = 0; ai < 2; ++ai)
#pragma unroll
                for (int m = 0; m < 4; ++m) { const int r = row0 + ai * HALF + m * 16; const float sr = sA[r];
                    const f32x4 p0 = (__builtin_convertvector(__builtin_bit_cast(i32x4_t, acc[ai][0][m][0]), f32x4) * sr * sb[0][0]) * (__builtin_convertvector(__builtin_bit_cast(i32x4_t, acc[ai][1][m][0]), f32x4) * sr * sb[1][0]);
                    const f32x4 p1 = (__builtin_convertvector(__builtin_bit_cast(i32x4_t, acc[ai][0][m][1]), f32x4) * sr * sb[0][1]) * (__builtin_convertvector(__builtin_bit_cast(i32x4_t, acc[ai][1][m][1]), f32x4) * sr * sb[1][1]);
                    u32x4 w; w.x = pk2(p0[0], p0[1]); w.y = pk2(p0[2], p0[3]); w.z = pk2(p1[0], p1[1]); w.w = pk2(p1[2], p1[3]);
                    *(u32x4*)(base + (size_t)r * ldc + col0) = w; }
            return; }
#pragma unroll
        for (int ai = 0; ai < 2; ++ai)
#pragma unroll
            for (int m = 0; m < 4; ++m) { const int r = row0 + ai * HALF + m * 16; const float sr = sA[r]; bf16_t* rowp = base + (size_t)r * ldc + col0;
#pragma unroll
                for (int bj = 0; bj < 2; ++bj) { const f32x4 v0 = __builtin_convertvector(__builtin_bit_cast(i32x4_t, acc[ai][bj][m][0]), f32x4) * sr * sb[bj][0], v1 = __builtin_convertvector(__builtin_bit_cast(i32x4_t, acc[ai][bj][m][1]), f32x4) * sr * sb[bj][1];
                    u32x4 w; w.x = pk2(v0[0], v0[1]); w.y = pk2(v0[2], v0[3]); w.z = pk2(v1[0], v1[1]); w.w = pk2(v1[2], v1[3]);
                    *(u32x4*)(rowp + bj * HALF) = w; } }
    }
};
struct EpiLogits {
    static constexpr bool PERM = true;
    const float* br; const float* rstd; const float* cbr;
    __device__ __forceinline__ void operator()(const f32x4 (&acc)[2][2][4][2], const Unit& u, int wr, int wc, int fr, int fq) const {
        if (wc != 0) return;
        const float* cb = cbr + (u.a0 >= 64 ? 32 : 0);
        float* lg = (float*)u.O; const f32x4 b0 = *(const f32x4*)(br + 8 * fq) + *(const f32x4*)(cb + 8 * fq), b1 = *(const f32x4*)(br + 8 * fq + 4) + *(const f32x4*)(cb + 8 * fq + 4);
#pragma unroll
        for (int ai = 0; ai < 2; ++ai)
#pragma unroll
            for (int m = 0; m < 4; ++m) { const int rl = wr * 64 + fr + ai * HALF + m * 16; const float sr = rstd[u.a0 * BM + rl]; float* rp = lg + (size_t)rl * NE + 8 * fq; *(f32x4*)rp = acc[ai][0][m][0] * sr + b0; *(f32x4*)(rp + 4) = acc[ai][0][m][1] * sr + b1; }
    }
};
struct EpiX1 {
    static constexpr bool PERM = false;
    const float* x; bf16_t* x1; const float* modf;
    __device__ __forceinline__ void operator()(const f32x4 (&acc)[2][2][4][2], const Unit& u, int wr, int wc, int fr, int fq) const {
        const int row0 = u.a0 * BM + wr * 64 + fr, col0 = u.a1 * BM + wc * 32 + 4 * fq;
        const int b = (u.a0 * BM) / SEQ; const float* gt = modf + (size_t)b * NMOD + 2 * D;
        f32x4 gv[2][2];
#pragma unroll
        for (int bj = 0; bj < 2; ++bj)
#pragma unroll
            for (int n = 0; n < 2; ++n) gv[bj][n] = *(const f32x4*)(gt + col0 + bj * HALF + n * 16);
#pragma unroll
        for (int ai = 0; ai < 2; ++ai)
#pragma unroll
            for (int m = 0; m < 4; ++m) { const size_t off = (size_t)(row0 + ai * HALF + m * 16) * D + col0;
#pragma unroll
                for (int bj = 0; bj < 2; ++bj)
#pragma unroll
                    for (int n = 0; n < 2; ++n) { const f32x4 xv = *(const f32x4*)(x + off + bj * HALF + n * 16); const f32x4 r = xv + gv[bj][n] * acc[ai][bj][m][n];
                        u32x2 w; w.x = pk2(r[0], r[1]); w.y = pk2(r[2], r[3]); *(u32x2*)(x1 + off + bj * HALF + n * 16) = w; } }
    }
};
struct EpiX1q {
    static constexpr bool PERM = false;
    const float* x; bf16_t* x1; const float* modf; const float* asc; const float* wosc;
    __device__ __forceinline__ void operator()(const f32x4 (&acc)[2][2][4][2], const Unit& u, int wr, int wc, int fr, int fq) const {
        const int row0 = u.a0 * BM + wr * 64 + fr, col0 = u.a1 * BM + wc * 32 + 4 * fq;
        const int b = (u.a0 * BM) / SEQ; const float* gt = modf + (size_t)b * NMOD + 2 * D;
        f32x4 gv[2][2];
#pragma unroll
        for (int bj = 0; bj < 2; ++bj)
#pragma unroll
            for (int n = 0; n < 2; ++n) gv[bj][n] = *(const f32x4*)(gt + col0 + bj * HALF + n * 16) * *(const f32x4*)(wosc + col0 + bj * HALF + n * 16);
#pragma unroll
        for (int ai = 0; ai < 2; ++ai)
#pragma unroll
            for (int m = 0; m < 4; ++m) { const int row = row0 + ai * HALF + m * 16; const float sr = asc[row]; const size_t off = (size_t)row * D + col0;
#pragma unroll
                for (int bj = 0; bj < 2; ++bj)
#pragma unroll
                    for (int n = 0; n < 2; ++n) { const f32x4 xv = *(const f32x4*)(x + off + bj * HALF + n * 16); const f32x4 r = xv + gv[bj][n] * (__builtin_convertvector(__builtin_bit_cast(i32x4_t, acc[ai][bj][m][n]), f32x4) * sr);
                        u32x2 w; w.x = pk2(r[0], r[1]); w.y = pk2(r[2], r[3]); *(u32x2*)(x1 + off + bj * HALF + n * 16) = w; } }
    }
};
struct EpiAct {
    static constexpr bool PERM = true;
    const float* bgu;
    __device__ __forceinline__ void operator()(const f32x4 (&acc)[2][2][4][2], const Unit& u, int wr, int wc, int fr, int fq) const {
        unsigned char* base = (unsigned char*)u.O; const int acol = u.a1 * 128 + wc * 32 + 8 * fq;
        const LAS float* bt = (const LAS float*)((LAS unsigned char*)lds_raw + LDS_CTL_OFF + 4096 + u.buf * 1024) + wc * 32 + 8 * fq;
        const int row0 = wr * 64 + fr;
        f32x4 bgv[2], buv[2];
#pragma unroll
        for (int n = 0; n < 2; ++n) { bgv[n] = *(const LAS f32x4*)(bt + 4 * n); buv[n] = *(const LAS f32x4*)(bt + 128 + 4 * n); }
#pragma unroll
        for (int ai = 0; ai < 2; ++ai)
#pragma unroll
            for (int m = 0; m < 4; ++m) {
                float o[8];
#pragma unroll
                for (int n = 0; n < 2; ++n) { const f32x4 g4 = acc[ai][0][m][n] * WSCALE_INV + bgv[n], u4 = acc[ai][1][m][n] * WSCALE_INV + buv[n];
#pragma unroll
                    for (int e = 0; e < 4; e += 2) {
                        f32x2 g = {fminf(g4[e], 7.0f), fminf(g4[e + 1], 7.0f)}; const f32x2 up = {fminf(fmaxf(u4[e], -7.0f), 7.0f), fminf(fmaxf(u4[e + 1], -7.0f), 7.0f)};
                        const f32x2 z = g * (-2.4554669595930157f); f32x2 ex; ex.x = __builtin_amdgcn_exp2f(z.x); ex.y = __builtin_amdgcn_exp2f(z.y);
                        const f32x2 den = ex + 1.0f; f32x2 sg; sg.x = __builtin_amdgcn_rcpf(den.x); sg.y = __builtin_amdgcn_rcpf(den.y);
                        const f32x2 r = (up + 1.0f) * g * sg; o[4 * n + e] = r.x; o[4 * n + e + 1] = r.y; } }
                u32x2 w; w.x = pk4f8(o[0], o[1], o[2], o[3]); w.y = pk4f8(o[4], o[5], o[6], o[7]);
                *(u32x2*)(base + (size_t)(row0 + ai * HALF + m * 16) * 2048 + acol) = w; __builtin_amdgcn_sched_barrier(0); }
    }
};
struct EpiDown {
    static constexpr bool PERM = true;
    const float* bdn; unsigned char* ys;
    __device__ __forceinline__ void operator()(const f32x4 (&acc)[2][2][4][2], const Unit& u, int wr, int wc, int fr, int fq) const {
        const LAS int* slots = (const LAS int*)((LAS unsigned char*)lds_raw + LDS_CTL_OFF + 2048 + u.buf * 1024); const LAS float* wts = (const LAS float*)((LAS unsigned char*)lds_raw + LDS_CTL_OFF + 4096 + u.buf * 1024); const int valid = u.ldc;
        const int col0 = u.a1 * BM + wc * 32 + 8 * fq; const float* bp = bdn + (size_t)u.a0 * D + col0;
        f32x4 bv[2][2];
#pragma unroll
        for (int bj = 0; bj < 2; ++bj)
#pragma unroll
            for (int n = 0; n < 2; ++n) bv[bj][n] = *(const f32x4*)(bp + bj * HALF + 4 * n);
        const int row0 = wr * 64 + fr;
#pragma unroll
        for (int ai = 0; ai < 2; ++ai)
#pragma unroll
            for (int m = 0; m < 4; ++m) { const int r = row0 + ai * HALF + m * 16;
                if (r < valid) { const int slot = slots[r]; const float w = wts[r]; unsigned char* rowp = ys + (size_t)slot * D + col0;
#pragma unroll
                    for (int bj = 0; bj < 2; ++bj) { const f32x4 v0 = (acc[ai][bj][m][0] * WSCALE_INV + bv[bj][0]) * w, v1 = (acc[ai][bj][m][1] * WSCALE_INV + bv[bj][1]) * w;
                        u32x2 o; o.x = pk4f8(v0[0], v0[1], v0[2], v0[3]); o.y = pk4f8(v1[0], v1[1], v1[2], v1[3]);
                        *(u32x2*)(rowp + bj * HALF) = o; } } }
    }
};
}

struct Params { const float* in[20]; float* out; unsigned char* ws; int ph_lo, ph_hi; };
enum { I_X = 0, I_C, I_CTX, I_CCTX, I_WADA, I_BADA, I_GMIX, I_WIN, I_BIF, I_CONVW, I_NORMG, I_WOUT, I_GFFN, I_WR, I_BR, I_WGU, I_BGU, I_WDN, I_BDN, I_GFIN };

template <int CTRL, int ROWMASK> DI float dpp_f(float v) { return __builtin_bit_cast(float, __builtin_amdgcn_update_dpp(0, __builtin_bit_cast(int, v), CTRL, ROWMASK, 0xF, false)); }
DI float row16_sum(float v) {
    v += dpp_f<0xB1, 0xF>(v); v += dpp_f<0x4E, 0xF>(v); v += dpp_f<0x124, 0xF>(v); v += dpp_f<0x128, 0xF>(v); return v; }
DI float wave_sum(float v) {
    v = row16_sum(v);
    v += dpp_f<0x142, 0xA>(v); v += dpp_f<0x143, 0xC>(v);
    return __builtin_bit_cast(float, __builtin_amdgcn_readlane(__builtin_bit_cast(int, v), 63));
}
DI float wave_max(float v) {
    v = fmaxf(v, dpp_f<0xB1, 0xF>(v)); v = fmaxf(v, dpp_f<0x4E, 0xF>(v)); v = fmaxf(v, dpp_f<0x124, 0xF>(v)); v = fmaxf(v, dpp_f<0x128, 0xF>(v));
    v = fmaxf(v, dpp_f<0x142, 0xA>(v)); v = fmaxf(v, dpp_f<0x143, 0xC>(v));
    return __builtin_bit_cast(float, __builtin_amdgcn_readlane(__builtin_bit_cast(int, v), 63));
}
DI float silu(float x) { return x / (1.0f + __expf(-x)); }

DI void p0_adaln(const Params& P, LAS unsigned char* lds, int G, int bid) {
    const int tid = my_tid(), wid = __builtin_amdgcn_readfirstlane(tid >> 6), lane = tid & 63;
    LAS float* sc = (LAS float*)lds;
    LAS float* red = (LAS float*)(lds + 8192);
    const float* w_ada = P.in[I_WADA];
    float* modp = (float*)(P.ws + WS_MODP);
    for (int it = bid; it < 48 * 4; it += G) {
        const int nb = it % 48, ks = it / 48;
        __syncthreads();
        for (int i = tid; i < 3 * 512; i += 512) { const int r = i / 512, k = i % 512; const float cv = (r < 2) ? P.in[I_C][r * D + ks * 512 + k] : P.in[I_CCTX][ks * 512 + k]; sc[i] = silu(cv); }
        __syncthreads();
        f32x4 a0 = {0, 0, 0, 0}, a1 = a0, a2 = a0;
        const float* wp = w_ada + (size_t)(ks * 512 + wid * 64) * NMOD + nb * 256 + lane * 4;
#pragma unroll 8
        for (int k = 0; k < 64; ++k) { const f32x4 w = *(const f32x4*)(wp + (size_t)k * NMOD); const int kk = wid * 64 + k;
            a0 += w * sc[kk]; a1 += w * sc[512 + kk]; a2 += w * sc[1024 + kk]; }
        *(LAS f32x4*)(red + (wid * 3 + 0) * 256 + lane * 4) = a0; *(LAS f32x4*)(red + (wid * 3 + 1) * 256 + lane * 4) = a1; *(LAS f32x4*)(red + (wid * 3 + 2) * 256 + lane * 4) = a2;
        __syncthreads();
        for (int i = tid; i < 768; i += 512) { const int r = i / 256, c = i % 256; float s = 0.f;
#pragma unroll
            for (int w = 0; w < 8; ++w) s += red[(w * 3 + r) * 256 + c];
            modp[((size_t)ks * 3 + r) * NMOD + nb * 256 + c] = s; }
    }
    __syncthreads();
}
DI void p0_transpose_item(const float* W, int K, int N, bf16_t* WT, int kind, LAS float* scr, int item, int lane) {
    const int nblk = (N + 31) / 32, kb = item / nblk, nb = item % nblk, k0 = 64 * kb, n0 = 32 * nb;
    { const int c4 = (lane & 7) * 4, r8 = lane >> 3; const bool okc = (n0 + c4) < N;
      f32x4 v[8];
#pragma unroll
      for (int i = 0; i < 8; ++i) v[i] = okc ? *(const f32x4*)(W + (size_t)(k0 + 8 * i + r8) * N + n0 + c4) : (f32x4){0.f, 0.f, 0.f, 0.f};
#pragma unroll
      for (int i = 0; i < 8; ++i) { LAS float* d = scr + (8 * i + r8) * 33 + c4; d[0] = v[i][0]; d[1] = v[i][1]; d[2] = v[i][2]; d[3] = v[i][3]; } }
    asm volatile("s_waitcnt lgkmcnt(0)" ::: "memory");
    const int c = lane & 7;
#pragma unroll
    for (int j = 0; j < 4; ++j) { const int n = (lane >> 3) + 8 * j; const int src = n0 + n; int dst = src; float scale = 1.0f;
        if (kind == 0) { if (src < 512) scale = 0.08838834764831845f; if (src >= GATE_COL0) dst = (src < GATE_COL0 + 16 || src >= P_IN) ? -1 : src - 16; }
        else if (kind == 2) { const int jj = src & 2047; dst = (jj >> 7) * 256 + (src >> 11) * 128 + (jj & 127); }
        const LAS float* s = scr + (8 * c) * 33 + n;
        u32x4 o; o.x = pk2(s[0 * 33] * scale, s[1 * 33] * scale); o.y = pk2(s[2 * 33] * scale, s[3 * 33] * scale); o.z = pk2(s[4 * 33] * scale, s[5 * 33] * scale); o.w = pk2(s[6 * 33] * scale, s[7 * 33] * scale);
        if (dst >= 0) *(u32x4*)(WT + (size_t)dst * K + k0 + 8 * c) = o; }
    asm volatile("s_waitcnt lgkmcnt(0)" ::: "memory");
}
DI void p0_transpose_item8(const float* W, int N, unsigned char* WT, int kind, LAS float* scr, int item, int lane) {
    const int nblk = N / 32, kb = item / nblk, nb = item % nblk, k0 = 128 * kb, n0 = 32 * nb;
    { const int c4 = (lane & 7) * 4, r8 = lane >> 3;
      f32x4 v[16];
#pragma unroll
      for (int i = 0; i < 16; ++i) v[i] = *(const f32x4*)(W + (size_t)(k0 + 8 * i + r8) * N + n0 + c4);
#pragma unroll
      for (int i = 0; i < 16; ++i) { LAS float* d = scr + (8 * i + r8) * 33 + c4; d[0] = v[i][0]; d[1] = v[i][1]; d[2] = v[i][2]; d[3] = v[i][3]; } }
    asm volatile("s_waitcnt lgkmcnt(0)" ::: "memory");
    const int c = lane & 7;
#pragma unroll
    for (int j = 0; j < 4; ++j) { const int n = (lane >> 3) + 8 * j; const int src = n0 + n; int dst = src;
        if (kind == 2) { const int jj = src & 2047; dst = (jj >> 7) * 256 + (src >> 11) * 128 + (jj & 127); }
        const LAS float* sp = scr + (16 * c) * 33 + n;
        u32x4 o; o.x = pk4f8(sp[0 * 33] * WSCALE, sp[1 * 33] * WSCALE, sp[2 * 33] * WSCALE, sp[3 * 33] * WSCALE); o.y = pk4f8(sp[4 * 33] * WSCALE, sp[5 * 33] * WSCALE, sp[6 * 33] * WSCALE, sp[7 * 33] * WSCALE);
        o.z = pk4f8(sp[8 * 33] * WSCALE, sp[9 * 33] * WSCALE, sp[10 * 33] * WSCALE, sp[11 * 33] * WSCALE); o.w = pk4f8(sp[12 * 33] * WSCALE, sp[13 * 33] * WSCALE, sp[14 * 33] * WSCALE, sp[15 * 33] * WSCALE);
        *(u32x4*)(WT + (size_t)dst * D + k0 + 16 * c) = o; }
    asm volatile("s_waitcnt lgkmcnt(0)" ::: "memory");
}
DI void p0_small_rows(const Params& P, int G, int bid) {
    const int t = my_tid();
    for (int i = bid * 512 + t; i < NE * 4096 / 4; i += G * 512) ((f32x4*)(P.ws + WS_BGU))[i] = ((const f32x4*)P.in[I_BGU])[i];
    for (int i = bid * 512 + t; i < NE * D / 4; i += G * 512) ((f32x4*)(P.ws + WS_BDN))[i] = ((const f32x4*)P.in[I_BDN])[i];
    for (int r = bid; r < 512; r += G) {
        if (r < 256) { const int rr = r; if (rr >= 16) { *(unsigned*)((unsigned char*)(P.ws + WS_WIN) + (size_t)(6144 + rr) * D + 4 * t) = 0u; if (t == 0) ((float*)(P.ws + WS_WSC))[6144 + rr] = 1.0f; } }
        else { const int rr = r - 256; u32x2 z; z.x = 0u; z.y = 0u;
            *(u32x2*)((bf16_t*)(P.ws + WS_WR2) + (size_t)rr * D + 4 * t) = z; *(u32x2*)((bf16_t*)(P.ws + WS_WR2) + (size_t)(256 + rr) * D + 4 * t) = z; } }
}
DI int win_dst(int src) { int dst = src < GATE_COL0 ? src : (src < GATE_COL0 + 16 ? 6144 + (src - GATE_COL0) : (src < P_IN ? src - 16 : -1));
    if (dst >= 4096 && dst < 6144) { const int c = (dst - 4096) & 1023; dst = 4096 + (c >> 7) * 256 + (dst >= 5120 ? 128 : 0) + (c & 127); }
    return dst; }
template <bool WIN>
DI void p0_w_int8(const Params& P, LAS unsigned char* lds, int G, int bid, int item0) {
    const int tid = my_tid(), wid = __builtin_amdgcn_readfirstlane(tid >> 6), lane = tid & 63;
    LAS float* scr = (LAS float*)(lds + wid * 16896); LAS float* part = (LAS float*)(lds + 135168); LAS float* sinv = part + 256;
    const float* W = WIN ? P.in[I_WIN] : P.in[I_WOUT]; unsigned char* WT = (unsigned char*)(P.ws + (WIN ? WS_WIN : WS_WOUT)); float* wsc = (float*)(P.ws + (WIN ? WS_WSC : WS_WOSC));
    constexpr int NCOL = WIN ? P_IN : D, NITEM = WIN ? 193 : 64;
    const int c4 = (lane & 7) * 4, r8 = lane >> 3;
    for (int item = bid - item0; item < NITEM; item += G) { if (item < 0) continue; const int n0 = 32 * item; const bool okc = (n0 + c4) < NCOL;
        f32x4 mx = {0.f, 0.f, 0.f, 0.f};
#pragma unroll 8
        for (int i = 0; i < 32; ++i) { const f32x4 v = okc ? *(const f32x4*)(W + (size_t)(256 * wid + 8 * i + r8) * NCOL + n0 + c4) : (f32x4){0.f, 0.f, 0.f, 0.f};
            mx[0] = fmaxf(mx[0], fabsf(v[0])); mx[1] = fmaxf(mx[1], fabsf(v[1])); mx[2] = fmaxf(mx[2], fabsf(v[2])); mx[3] = fmaxf(mx[3], fabsf(v[3])); }
#pragma unroll
        for (int e = 0; e < 4; ++e) { mx[e] = fmaxf(mx[e], __shfl_xor(mx[e], 8)); mx[e] = fmaxf(mx[e], __shfl_xor(mx[e], 16)); mx[e] = fmaxf(mx[e], __shfl_xor(mx[e], 32)); }
        if (lane < 8) *(LAS f32x4*)(part + wid * 32 + c4) = mx;
        __syncthreads();
        if (tid < 32) { float cm = 0.f;
#pragma unroll
            for (int w = 0; w < 8; ++w) cm = fmaxf(cm, part[w * 32 + tid]);
            const int src = n0 + tid; const int dst = !WIN ? src : win_dst(src);
            sinv[tid] = cm > 0.f ? 127.0f / cm : 0.f;
            if (dst >= 0) wsc[dst] = (cm > 0.f ? cm * (1.0f / 127.0f) : 1.0f) * ((WIN && dst < 512) ? 0.08838834764831845f : 1.0f); }
        __syncthreads();
        const f32x4 iv = *(const LAS f32x4*)(sinv + c4);
#pragma unroll 1
        for (int sb = 0; sb < 2; ++sb) { const int k0 = 256 * wid + 128 * sb;
            f32x4 v[16];
#pragma unroll
            for (int i = 0; i < 16; ++i) v[i] = okc ? *(const f32x4*)(W + (size_t)(k0 + 8 * i + r8) * NCOL + n0 + c4) : (f32x4){0.f, 0.f, 0.f, 0.f};
#pragma unroll
            for (int i = 0; i < 16; ++i) { LAS float* d = scr + (8 * i + r8) * 33 + c4; d[0] = __builtin_rintf(v[i][0] * iv[0]); d[1] = __builtin_rintf(v[i][1] * iv[1]); d[2] = __builtin_rintf(v[i][2] * iv[2]); d[3] = __builtin_rintf(v[i][3] * iv[3]); }
            asm volatile("s_waitcnt lgkmcnt(0)" ::: "memory");
            const int c = lane & 7;
#pragma unroll
            for (int j = 0; j < 4; ++j) { const int n = (lane >> 3) + 8 * j; const int src = n0 + n; const int dst = !WIN ? src : win_dst(src);
                const LAS float* sp = scr + (16 * c) * 33 + n;
                u32x4 o; o.x = pk4i8(sp[0 * 33], sp[1 * 33], sp[2 * 33], sp[3 * 33]); o.y = pk4i8(sp[4 * 33], sp[5 * 33], sp[6 * 33], sp[7 * 33]);
                o.z = pk4i8(sp[8 * 33], sp[9 * 33], sp[10 * 33], sp[11 * 33]); o.w = pk4i8(sp[12 * 33], sp[13 * 33], sp[14 * 33], sp[15 * 33]);
                if (dst >= 0) *(u32x4*)(WT + (size_t)dst * D + k0 + 16 * c) = o; }
            asm volatile("s_waitcnt lgkmcnt(0)" ::: "memory"); }
        __syncthreads();
    }
}
DI void p0_convert(const Params& P, LAS unsigned char* lds, int G, int bid) {
    const int tid = my_tid(), wid = __builtin_amdgcn_readfirstlane(tid >> 6), lane = tid & 63;
    LAS float* scr = (LAS float*)(lds + wid * 16896);
    const int gw = bid * 8 + wid, NGW = G * 8;
    for (int it = gw; it < 32 * 64; it += NGW) p0_transpose_item(P.in[I_WOUT], D, D, (bf16_t*)(P.ws + WS_WOUT), 1, scr, it, lane);
}
constexpr int CV_GU1 = 16 * 128, CV_DN1 = 16 * 64, CV_ITEMS = NE * (CV_GU1 + CV_DN1);
struct CvItem { const float* W; unsigned char* WT; int N, kind, k0, n0; };
DI CvItem cv_decode(const Params& P, int it) { CvItem c; int item;
    if (it < NE * CV_GU1) { const int e = it / CV_GU1; c.W = P.in[I_WGU] + (size_t)e * D * 4096; c.N = 4096; c.WT = (unsigned char*)(P.ws + WS_WGU) + (size_t)e * 4096 * D; c.kind = 2; item = it % CV_GU1; }
    else { const int r = it - NE * CV_GU1; const int e = r / CV_DN1; c.W = P.in[I_WDN] + (size_t)e * D * D; c.N = D; c.WT = (unsigned char*)(P.ws + WS_WDN) + (size_t)e * D * D; c.kind = 3; item = r % CV_DN1; }
    const int nblk = c.N / 32, kb = item / nblk, nb = item % nblk; c.k0 = 128 * kb; c.n0 = 32 * nb; return c; }
DI void cv_issue(const CvItem& c, int lane, f32x4 (&v)[16]) { const int c4 = (lane & 7) * 4, r8 = lane >> 3;
#pragma unroll
    for (int i = 0; i < 16; ++i) v[i] = *(const f32x4*)(c.W + (size_t)(c.k0 + 8 * i + r8) * c.N + c.n0 + c4); }
DI void cv_finish(const CvItem& cc, int lane, LAS float* scr, const f32x4 (&v)[16]) {
    { const int c4 = (lane & 7) * 4, r8 = lane >> 3;
#pragma unroll
      for (int i = 0; i < 16; ++i) { LAS float* d = scr + (8 * i + r8) * 33 + c4; d[0] = v[i][0]; d[1] = v[i][1]; d[2] = v[i][2]; d[3] = v[i][3]; } }
    asm volatile("s_waitcnt lgkmcnt(0)" ::: "memory");
    const int c = lane & 7;
#pragma unroll
    for (int j = 0; j < 4; ++j) { const int n = (lane >> 3) + 8 * j; const int src = cc.n0 + n; int dst = src;
        if (cc.kind == 2) { const int jj = src & 2047; dst = (jj >> 7) * 256 + (src >> 11) * 128 + (jj & 127); }
        const LAS float* sp = scr + (16 * c) * 33 + n;
        u32x4 o; o.x = pk4f8(sp[0 * 33] * WSCALE, sp[1 * 33] * WSCALE, sp[2 * 33] * WSCALE, sp[3 * 33] * WSCALE); o.y = pk4f8(sp[4 * 33] * WSCALE, sp[5 * 33] * WSCALE, sp[6 * 33] * WSCALE, sp[7 * 33] * WSCALE);
        o.z = pk4f8(sp[8 * 33] * WSCALE, sp[9 * 33] * WSCALE, sp[10 * 33] * WSCALE, sp[11 * 33] * WSCALE); o.w = pk4f8(sp[12 * 33] * WSCALE, sp[13 * 33] * WSCALE, sp[14 * 33] * WSCALE, sp[15 * 33] * WSCALE);
        *(u32x4*)(cc.WT + (size_t)dst * D + cc.k0 + 16 * c) = o; }
    asm volatile("s_waitcnt lgkmcnt(0)" ::: "memory");
}
DI void conv_experts(const Params& P, LAS unsigned char* lds, int gw, int nw, int lo, int hi) {
    const int wid = wave_in_wg(), lane = lane_id();
    LAS float* scr = (LAS float*)(lds + wid * 16896);
    int it = lo + gw; if (it >= hi) return;
    CvItem cur = cv_decode(P, it); f32x4 v[16]; cv_issue(cur, lane, v);
    for (;;) { const int nx = it + nw; const bool more = nx < hi;
        const CvItem nxt = cv_decode(P, more ? nx : it); f32x4 vn[16]; cv_issue(nxt, lane, vn);
        asm volatile("" ::: "memory");
        cv_finish(cur, lane, scr, v);
        if (!more) break;
#pragma unroll
        for (int i = 0; i < 16; ++i) v[i] = vn[i];
        cur = nxt; it = nx; }
}
constexpr int CV_BLK = 8, CV_NBLK_ALL = CV_ITEMS / CV_BLK, CV_NBLK_A = (CV_NBLK_ALL / 100) * 94;
DI void conv_pool(const Params& P, LAS unsigned char* lds, int pool, int blk_lo, int blk_hi) {
    const int wid = wave_in_wg(), lane = lane_id();
    LAS float* scr = (LAS float*)(lds + wid * 16896);
    unsigned* ctr = (unsigned*)(P.ws + WS_CTL) + CW_POOL + pool * 64;
    const int CV_NBLK = blk_hi;
    auto claim = [&]() -> int { unsigned v_ = 0u; if (lane == 0) v_ = __hip_atomic_fetch_add(ctr, 1u, __ATOMIC_RELAXED, __HIP_MEMORY_SCOPE_AGENT); return blk_lo + (int)__builtin_amdgcn_readfirstlane(v_); };
    const int blk = claim(); if (blk >= CV_NBLK) return;
    int it = blk * CV_BLK, left = CV_BLK;
    CvItem cur = cv_decode(P, it); f32x4 v[16]; cv_issue(cur, lane, v);
    for (;;) { int nx = it + 1; bool more = true;
        if (left > 1) --left; else { const int nb = claim(); if (nb >= CV_NBLK) { more = false; nx = it; } else { nx = nb * CV_BLK; left = CV_BLK; } }
        const CvItem nxt = cv_decode(P, nx); f32x4 vn[16]; cv_issue(nxt, lane, vn);
        asm volatile("" ::: "memory");
        cv_finish(cur, lane, scr, v);
        if (!more) break;
#pragma unroll
        for (int i = 0; i < 16; ++i) v[i] = vn[i];
        cur = nxt; it = nx; }
}

DI void nm_fill_mod(LAS unsigned char* lds, const Params& P, int cond, int chunk_shift, int chunk_scale, const float* g) {
    LAS float* av = (LAS float*)lds; LAS float* bv = (LAS float*)(lds + 8192);
    const float* modp = (const float*)(P.ws + WS_MODP); const float* bada = P.in[I_BADA];
    const int t = my_tid(); float shv[4], scv[4], gv[4];
#pragma unroll
    for (int u = 0; u < 4; ++u) { const int i = t + 512 * u; float sh = bada[chunk_shift * D + i], sc = bada[chunk_scale * D + i];
#pragma unroll
        for (int ks = 0; ks < 4; ++ks) { sh += modp[((size_t)ks * 3 + cond) * NMOD + chunk_shift * D + i]; sc += modp[((size_t)ks * 3 + cond) * NMOD + chunk_scale * D + i]; }
        shv[u] = sh; scv[u] = sc; gv[u] = g[i]; }
#pragma unroll
    for (int u = 0; u < 4; ++u) { const int i = t + 512 * u; av[i] = gv[u] * (1.0f + scv[u]); bv[i] = shv[u]; }
}
DI void unpack8(const u32x4 r, f32x4& lo, f32x4& hi) { lo = (f32x4){bf_lo(r.x), bf_hi(r.x), bf_lo(r.y), bf_hi(r.y)}; hi = (f32x4){bf_lo(r.z), bf_hi(r.z), bf_lo(r.w), bf_hi(r.w)}; }
template <int OUT, bool SRCBF>
DI void nm_rowpair(LAS unsigned char* lds, const void* src0v, const void* src1v, bf16_t* b0, bf16_t* b1, unsigned char* q0, unsigned char* q1, int lane, float* sc0 = nullptr) {
    const LAS float* av = (const LAS float*)lds; const LAS float* bv = (const LAS float*)(lds + 8192);
    f32x4 xa[8], xb[8]; float sa = 0.f, sb = 0.f;
    if constexpr (SRCBF) { const bf16_t* s0 = (const bf16_t*)src0v; const bf16_t* s1 = (const bf16_t*)src1v; u32x4 ra_[4], rb_[4];
#pragma unroll
        for (int j = 0; j < 4; ++j) { const int c = 512 * j + 8 * lane; ra_[j] = *(const u32x4*)(s0 + c); rb_[j] = *(const u32x4*)(s1 + c); }
#pragma unroll
        for (int j = 0; j < 4; ++j) { unpack8(ra_[j], xa[2 * j], xa[2 * j + 1]); unpack8(rb_[j], xb[2 * j], xb[2 * j + 1]); }
    } else { const float* src0 = (const float*)src0v; const float* src1 = (const float*)src1v;
#pragma unroll
    for (int j = 0; j < 4; ++j) { const int c = 512 * j + 8 * lane; xa[2 * j] = *(const f32x4*)(src0 + c); xa[2 * j + 1] = *(const f32x4*)(src0 + c + 4); xb[2 * j] = *(const f32x4*)(src1 + c); xb[2 * j + 1] = *(const f32x4*)(src1 + c + 4); } }
#pragma unroll
    for (int j = 0; j < 8; ++j) { sa += (xa[j][0] * xa[j][0] + xa[j][1] * xa[j][1]) + (xa[j][2] * xa[j][2] + xa[j][3] * xa[j][3]); sb += (xb[j][0] * xb[j][0] + xb[j][1] * xb[j][1]) + (xb[j][2] * xb[j][2] + xb[j][3] * xb[j][3]); }
    const float ra = 1.0f / sqrtf(wave_sum(sa) * (1.0f / D) + EPS), rb = 1.0f / sqrtf(wave_sum(sb) * (1.0f / D) + EPS);
    if constexpr (OUT == 2) {
        float ma = 0.f, mb = 0.f;
#pragma unroll
        for (int j = 0; j < 4; ++j) { const int c = 512 * j + 8 * lane;
            const f32x4 A0 = *(const LAS f32x4*)(av + c), A1 = *(const LAS f32x4*)(av + c + 4), B0 = *(const LAS f32x4*)(bv + c), B1 = *(const LAS f32x4*)(bv + c + 4);
            xa[2 * j] = xa[2 * j] * ra * A0 + B0; xa[2 * j + 1] = xa[2 * j + 1] * ra * A1 + B1; xb[2 * j] = xb[2 * j] * rb * A0 + B0; xb[2 * j + 1] = xb[2 * j + 1] * rb * A1 + B1;
#pragma unroll
            for (int e = 0; e < 4; ++e) { ma = fmaxf(ma, fmaxf(fabsf(xa[2 * j][e]), fabsf(xa[2 * j + 1][e]))); mb = fmaxf(mb, fmaxf(fabsf(xb[2 * j][e]), fabsf(xb[2 * j + 1][e]))); } }
        ma = wave_max(ma); mb = wave_max(mb);
        const float ia = ma > 0.f ? 127.0f / ma : 0.f, ib = mb > 0.f ? 127.0f / mb : 0.f;
        if (lane == 0) { sc0[0] = ma > 0.f ? ma * (1.0f / 127.0f) : 1.0f; sc0[1] = mb > 0.f ? mb * (1.0f / 127.0f) : 1.0f; }
#pragma unroll
        for (int j = 0; j < 4; ++j) { const int c = 512 * j + 8 * lane;
            u32x2 qa; qa.x = pk4i8(__builtin_rintf(xa[2 * j][0] * ia), __builtin_rintf(xa[2 * j][1] * ia), __builtin_rintf(xa[2 * j][2] * ia), __builtin_rintf(xa[2 * j][3] * ia));
            qa.y = pk4i8(__builtin_rintf(xa[2 * j + 1][0] * ia), __builtin_rintf(xa[2 * j + 1][1] * ia), __builtin_rintf(xa[2 * j + 1][2] * ia), __builtin_rintf(xa[2 * j + 1][3] * ia)); *(u32x2*)(q0 + c) = qa;
            u32x2 qb; qb.x = pk4i8(__builtin_rintf(xb[2 * j][0] * ib), __builtin_rintf(xb[2 * j][1] * ib), __builtin_rintf(xb[2 * j][2] * ib), __builtin_rintf(xb[2 * j][3] * ib));
            qb.y = pk4i8(__builtin_rintf(xb[2 * j + 1][0] * ib), __builtin_rintf(xb[2 * j + 1][1] * ib), __builtin_rintf(xb[2 * j + 1][2] * ib), __builtin_rintf(xb[2 * j + 1][3] * ib)); *(u32x2*)(q1 + c) = qb; }
        return; }
    constexpr bool F8OUT = (OUT == 1 || OUT == 3), BFOUT = (OUT != 3);
    if constexpr (OUT == 3) { if (lane == 0) { sc0[0] = ra; sc0[1] = rb; } }
#pragma unroll
    for (int j = 0; j < 4; ++j) { const int c = 512 * j + 8 * lane;
        const f32x4 A0 = *(const LAS f32x4*)(av + c), A1 = *(const LAS f32x4*)(av + c + 4), B0 = *(const LAS f32x4*)(bv + c), B1 = *(const LAS f32x4*)(bv + c + 4);
        const f32x4 ya0 = xa[2 * j] * ra * A0 + B0, ya1 = xa[2 * j + 1] * ra * A1 + B1, yb0 = xb[2 * j] * rb * A0 + B0, yb1 = xb[2 * j + 1] * rb * A1 + B1;
        if constexpr (BFOUT) { u32x4 w; w.x = pk2(ya0[0], ya0[1]); w.y = pk2(ya0[2], ya0[3]); w.z = pk2(ya1[0], ya1[1]); w.w = pk2(ya1[2], ya1[3]); *(u32x4*)(b0 + c) = w;
        u32x4 v; v.x = pk2(yb0[0], yb0[1]); v.y = pk2(yb0[2], yb0[3]); v.z = pk2(yb1[0], yb1[1]); v.w = pk2(yb1[2], yb1[3]); *(u32x4*)(b1 + c) = v; }
        if constexpr (F8OUT) { u32x2 qa; qa.x = pk4f8(ya0[0], ya0[1], ya0[2], ya0[3]); qa.y = pk4f8(ya1[0], ya1[1], ya1[2], ya1[3]); *(u32x2*)(q0 + c) = qa;
                               u32x2 qb; qb.x = pk4f8(yb0[0], yb0[1], yb0[2], yb0[3]); qb.y = pk4f8(yb1[0], yb1[1], yb1[2], yb1[3]); *(u32x2*)(q1 + c) = qb; }
    }
}
DI void p1_modulate(const Params& P, LAS unsigned char* lds, int G, int bid) {
    const int tid = my_tid(), wid = __builtin_amdgcn_readfirstlane(tid >> 6), lane = tid & 63;
    unsigned char* XN = (unsigned char*)(P.ws + WS_XN); float* xsc = (float*)(P.ws + WS_XSC);
    {
        const float* modp = (const float*)(P.ws + WS_MODP); float* modf = (float*)(P.ws + WS_MODF);
        for (int i = bid * 512 + tid; i < 3 * NMOD; i += G * 512) { const int r = i / NMOD, c = i % NMOD; float s = P.in[I_BADA][c];
#pragma unroll
            for (int ks = 0; ks < 4; ++ks) s += modp[((size_t)ks * 3 + r) * NMOD + c];
            modf[i] = s; }
    }
    int cur_cond = -1;
    for (int blk = bid; blk < 256; blk += G) {
        const int cond = blk < 128 ? 0 : 1;
        if (cond != cur_cond) { __syncthreads(); nm_fill_mod(lds, P, cond, 0, 1, P.in[I_GMIX]); cur_cond = cond; }
        __syncthreads();
#pragma unroll 1
        for (int pr = 0; pr < 8; ++pr) { const int row = blk * 128 + wid * 16 + pr * 2; const float* s0 = P.in[I_X] + (size_t)row * D;
            nm_rowpair<2, false>(lds, s0, s0 + D, nullptr, nullptr, XN + (size_t)row * D, XN + (size_t)(row + 1) * D, lane, xsc + row); }
    }
    __syncthreads(); nm_fill_mod(lds, P, 2, 0, 1, P.in[I_GMIX]); __syncthreads();
#pragma unroll 1
    for (int pr = bid * 8 + wid; pr < TC / 2; pr += G * 8) { const int row = T + pr * 2; const float* s0 = P.in[I_CTX] + (size_t)(pr * 2) * D;
        nm_rowpair<2, false>(lds, s0, s0 + D, nullptr, nullptr, XN + (size_t)row * D, XN + (size_t)(row + 1) * D, lane, xsc + row); }
    __syncthreads();
}
DI void p8_modulate(const Params& P, LAS unsigned char* lds, int G, int bid) {
    const int tid = my_tid(), wid = __builtin_amdgcn_readfirstlane(tid >> 6), lane = tid & 63;
    unsigned char* XN8 = (unsigned char*)(P.ws + WS_XN8); const bf16_t* X1 = (const bf16_t*)(P.ws + WS_X1); float* rstd = (float*)(P.ws + WS_RSTD);
    { const float* modf = (const float*)(P.ws + WS_MODF); const float* gf = P.in[I_GFFN]; const float* wr_ = P.in[I_WR]; LAS float* red = (LAS float*)(lds + 16384);
      for (int item = bid; item < 64; item += G) { const int b = item >> 5, rr = item & 31; const float* mf = modf + (size_t)b * NMOD;
          float v[4], part = 0.f;
#pragma unroll
          for (int i = 0; i < 4; ++i) { const int k = 4 * tid + i; const float w = wr_[(size_t)k * NE + rr]; v[i] = w * (gf[k] * (1.0f + mf[4 * D + k])); part += w * mf[3 * D + k]; }
          u32x2 o; o.x = pk2(v[0], v[1]); o.y = pk2(v[2], v[3]); *(u32x2*)((bf16_t*)(P.ws + WS_WR2) + (size_t)(b * 256 + rr) * D + 4 * tid) = o;
          part = wave_sum(part);
          __syncthreads(); if (lane == 0) red[wid] = part; __syncthreads();
          if (tid == 0) ((float*)(P.ws + WS_CBR))[b * 32 + rr] = ((red[0] + red[1]) + (red[2] + red[3])) + ((red[4] + red[5]) + (red[6] + red[7])); } }
    int cur_cond = -1;
    for (int blk = bid; blk < 256; blk += G) {
        const int cond = blk < 128 ? 0 : 1;
        if (cond != cur_cond) { __syncthreads(); nm_fill_mod(lds, P, cond, 3, 4, P.in[I_GFFN]); cur_cond = cond; }
        __syncthreads();
#pragma unroll 1
        for (int pr = 0; pr < 8; ++pr) { const int row = blk * 128 + wid * 16 + pr * 2; const bf16_t* s0 = X1 + (size_t)row * D;
            nm_rowpair<3, true>(lds, s0, s0 + D, nullptr, nullptr, XN8 + (size_t)row * D, XN8 + (size_t)(row + 1) * D, lane, rstd + row); }
    }
    __syncthreads();
}

struct SchedIn { static constexpr bool GATHER = false, ETAB = false, BIAS = false;
    unsigned char* ws; int G, c;
    DI bool next(int i, pg8::Unit& u) const {
        const int L = i * G + c; if (L >= 3200 + 14) return false;
        int pm, pn;
        if (L < 3200) pg8::tile_order(pg8::xcd_remap(L, 3200), 3200, 128, 25, pm, pn);
        else { const int j = L - 3200; pm = 128 + j / 7; pn = (j % 7) < 6 ? 2 + (j % 7) : 24; }
        const unsigned xrow = (unsigned)(WS_XN + (size_t)pm * 256 * D), wrow = (unsigned)(WS_WIN + (size_t)pn * 256 * D);
        u.a0 = pm; u.a1 = pn;
        if (pn >= 4 && pn < 8) { u.A = wrow; u.B = xrow; u.ldc = MT; u.O = (char*)(ws + WS_VT) + ((size_t)(pn - 4) * 256 * MT + (size_t)pm * 256) * 2; }
        else if (pn == 24) { u.A = xrow; u.B = wrow; u.ldc = 0; u.O = (char*)(ws + WS_GATES) + (size_t)pm * 256 * 16 * 4; }
        else { u.A = xrow; u.B = wrow;
            size_t base; int ldc, pc;
            if (pn < 2) { base = WS_Q; ldc = 512; pc = pn; } else if (pn < 4) { base = WS_K; ldc = 512; pc = pn - 2; }
            else if (pn < 12) { base = WS_O; ldc = 1024; pc = pn - 8; } else if (pn < 16) { base = WS_CB; ldc = 1024; pc = pn - 12; }
            else { base = WS_CC; ldc = 1024; pc = pn - 16; }
            u.ldc = ldc; u.O = (char*)(ws + base) + ((size_t)pm * 256 * ldc + (size_t)pc * (pn >= 16 ? 128 : 256)) * 2; }
        return true;
    }
};
struct SchedRouter { static constexpr bool GATHER = false, ETAB = false, BIAS = false;
    unsigned char* ws; int G, c;
    DI bool next(int i, pg8::Unit& u) const {
        const int L = i * G + c; if (L >= 128) return false;
        u.A = (unsigned)(WS_X1 + (size_t)L * 256 * D * 2); u.B = (unsigned)(WS_WR2 + (size_t)(L >= 64 ? 1 : 0) * 256 * D * 2); u.O = (char*)(ws + WS_LOGITS) + (size_t)L * 256 * NE * 4; u.ldc = 0; u.a0 = L; u.a1 = 0; return true;
    }
};
struct SchedOut { static constexpr bool GATHER = false, ETAB = false, BIAS = false;
    unsigned char* ws; int G, c;
    DI bool next(int i, pg8::Unit& u) const {
        const int L = i * G + c; if (L >= 1024) return false;
        int pm, pn; pg8::tile_order(pg8::xcd_remap(L, 1024), 1024, 128, 8, pm, pn);
        u.A = (unsigned)(WS_A2 + (size_t)pm * 256 * D); u.B = (unsigned)(WS_WOUT + (size_t)pn * 256 * D); u.O = nullptr; u.ldc = 0; u.a0 = pm; u.a1 = pn; return true;
    }
};
DI void moe_tables(const Params& P, LAS unsigned char* lds, int npn, int G, int bid) {
    LAS int* tab = (LAS int*)(lds + LDS_CTL_OFF + 64); LAS int* ul = (LAS int*)(lds + LDS_CTL_OFF + 384);
    __syncthreads();
    if (my_tid() < 32) { const unsigned* gc = (const unsigned*)(P.ws + WS_CTL) + CW_GCNT; const int e = my_tid();
        const int cn = (int)__hip_atomic_load(gc + e, __ATOMIC_RELAXED, __HIP_MEMORY_SCOPE_AGENT);
        const int tiles = (cn + 255) >> 8; int inc = tiles;
#pragma unroll
        for (int o = 1; o < 32; o <<= 1) { const int t_ = __shfl_up(inc, o); if (e >= o) inc += t_; }
        tab[e] = cn; tab[32 + e] = inc - tiles; if (e == 31) tab[64] = inc; }
    __syncthreads();
    if (npn > 0 && my_tid() < 64) { const int i = my_tid(); const int nwg = tab[64] * npn; const int L = i * G + bid; int d0 = -1, d1 = 0;
        if (L < nwg) { const int wg = pg8::xcd_remap(L, nwg); int e = 0;
            for (int k = 1; k < 32; ++k) if (wg >= tab[32 + k] * npn) e = k;
            const int t0 = tab[32 + e], nM = tab[32 + e + 1] - t0, w = wg - t0 * npn; int pm, pn; pg8::tile_order(w, nM * npn, nM, npn, pm, pn);
            d0 = e | (pn << 8) | (pm << 16); d1 = t0; }
        ul[2 * i] = d0; ul[2 * i + 1] = d1; }
    __syncthreads();
}
template <bool GATHER_> struct SchedMoeT { static constexpr bool GATHER = GATHER_, ETAB = !GATHER_, BIAS = GATHER_;
    DI unsigned etab_off(const pg8::Unit& u, int which) const { return (unsigned)((const unsigned char*)u.O - ws) + (which ? (unsigned)(WS_LISTW - WS_LIST) : 0u); }
    unsigned char* ws; const LAS int* tab; int down;
    DI unsigned bias_off(const pg8::Unit& u, int which) const { return down ? (unsigned)(WS_BDN + ((size_t)u.a0 * D + (size_t)u.a1 * 256 + which * 128) * 4) : (unsigned)(WS_BGU + ((size_t)u.a0 * 4096 + (size_t)u.a1 * 128 + which * 2048) * 4); }
    DI unsigned list_off(const pg8::Unit& u) const { return (unsigned)(WS_LIST + ((size_t)u.a0 * T + (size_t)u.ldc) * 4); }
    DI int row_cnt(const pg8::Unit& u) const { return __builtin_amdgcn_readfirstlane(tab[u.a0]) - u.ldc; }
    DI bool next(int i, pg8::Unit& u) const {
        if (i >= 64) return false;
        const LAS int* ul = tab + 80;
        const int d0 = __builtin_amdgcn_readfirstlane(ul[2 * i]); if (d0 < 0) return false;
        const int t0 = __builtin_amdgcn_readfirstlane(ul[2 * i + 1]); const int e = d0 & 255, pn = (d0 >> 8) & 255, pm = d0 >> 16;
        const size_t row0 = (size_t)(t0 + pm) * 256;
        u.a0 = e; u.a1 = pn;
        if (!down) { u.A = GATHER_ ? (unsigned)WS_XN8 : (unsigned)(WS_XG + row0 * D); u.B = (unsigned)(WS_WGU + ((size_t)e * 4096 + (size_t)pn * 256) * D); u.O = (char*)(ws + WS_ACT) + row0 * D; u.ldc = pm * 256; }
        else { u.A = (unsigned)(WS_ACT + row0 * D); u.B = (unsigned)(WS_WDN + ((size_t)e * D + (size_t)pn * 256) * D);
               u.O = (char*)(ws + WS_LIST) + ((size_t)e * T + (size_t)pm * 256) * 4; const int rem = __builtin_amdgcn_readfirstlane(tab[e]) - pm * 256; u.ldc = rem < 256 ? rem : 256; }
        return true;
    }
};
typedef SchedMoeT<false> SchedMoe;

constexpr int ML_QS = 0, ML_KS = 34816, ML_PS = 69632, ML_SC = 104448;
constexpr int SC_U = 0, SC_T = 512, SC_WST = 1024, SC_CL = 1536, SC_EV = 2048, SC_LF = 2560, SC_LI = 3072, SC_N0 = 3584, SC_DENP = 4096, SC_QNP = 6144, SC_NPART = 8192, SC_MISC = 10240;
DI unsigned off_b(unsigned row, unsigned ch) { return 272u * row + 16u * ch; }
DI float softcap(float x) { return 15.0f * tanhf(x * (1.0f / 15.0f)); }
DI float logsigmoid(float y) { return fminf(y, 0.f) - log1pf(__expf(-fabsf(y))); }
#define MFMA32(a, b, c) __builtin_amdgcn_mfma_f32_32x32x16_bf16((a), (b), (c), 0, 0, 0)

template <bool PASS2, int DIRT>
DI void mlstm_item(const Params& P, LAS unsigned char* lds, int st, int g) {
    const int wid = wave_in_wg();
    int tid = (wid << 6) | lane_id(), lane = tid & 63, r = lane & 31, hh = lane >> 5;
    constexpr int dir = DIRT; const int b = (st >> 2) & 1, h = st & 3;
    LAS unsigned char* QS = lds + ML_QS; LAS unsigned char* KS = lds + ML_KS; LAS unsigned char* PS = lds + ML_PS;
    LAS float* SC = (LAS float*)(lds + ML_SC);
    LAS float* sU = SC + SC_U / 4; LAS float* sT = SC + SC_T / 4; LAS float* sWST = SC + SC_WST / 4; LAS float* sCL = SC + SC_CL / 4; LAS float* sEV = SC + SC_EV / 4;
    LAS float* sLF = SC + SC_LF / 4; LAS float* sLI = SC + SC_LI / 4; LAS float* sN0 = SC + SC_N0 / 4; LAS float* sDENP = SC + SC_DENP / 4; LAS float* sQNP = SC + SC_QNP / 4;
    LAS float* sNPART = SC + SC_NPART / 4; LAS float* sMISC = SC + SC_MISC / 4;
    const bf16_t* Qg = (const bf16_t*)(P.ws + WS_Q); const bf16_t* Kg = (const bf16_t*)(P.ws + WS_K); const bf16_t* VT = (const bf16_t*)(P.ws + WS_VT);
    const float* gates = (const float*)(P.ws + WS_GATES);
    const int ctx_item = (!PASS2 && g == 0); const int nchunks = ctx_item ? 2 : 8; const int seg = PASS2 ? g : g - 1;
    f32x16 C[4];
#pragma unroll
    for (int i = 0; i < 4; ++i)
#pragma unroll
        for (int e = 0; e < 16; ++e) C[i][e] = 0.f;
    __syncthreads();
    if (PASS2) {
        const float* ec = (const float*)(P.ws + WS_ENTC) + ((size_t)st * 16 + g) * 32768;
#pragma unroll
        for (int dkt = 0; dkt < 4; ++dkt)
#pragma unroll
            for (int e = 0; e < 16; ++e) C[dkt][e] = ec[(32 * dkt + (e & 3) + 8 * (e >> 2) + 4 * hh) * 256 + 32 * wid + r];
        if (tid < 128) sN0[tid] = ((const float*)(P.ws + WS_ENTN))[((size_t)st * 16 + g) * 128 + tid];
        if (tid == 0) sMISC[1] = ((const float*)(P.ws + WS_ENTN + 512 * 1024))[st * 16 + g];
    } else {
        if (tid < 128) sN0[tid] = 0.f;
        if (tid == 0) sMISC[1] = -1e30f;
    }
    LAS float* sALL = SC + 10496 / 4;
    LAS float* sCH = sALL + 8 * 3 * 128;
    auto chunk_tok0 = [&](int ci) -> int { if (ctx_item) return T + b * CTXL + (dir ? (1 - ci) : ci) * 128;
        const int cp = seg * 8 + ci; const int chunk = dir ? (NCHUNK - 1 - cp) : cp; return b * SEQ + chunk * 128; };
    if (wid < nchunks) { const int t0c = chunk_tok0(wid);
        const int p0 = dir ? 127 - 2 * lane : 2 * lane, p1 = dir ? 126 - 2 * lane : 2 * lane + 1;
        const float* g0 = gates + (size_t)(t0c + p0) * 16; const float* g1 = gates + (size_t)(t0c + p1) * 16;
        const float li0 = softcap(g0[dir * 8 + h]), li1 = softcap(g1[dir * 8 + h]); const float lf0 = logsigmoid(softcap(g0[dir * 8 + 4 + h])), lf1 = logsigmoid(softcap(g1[dir * 8 + 4 + h]));
        float sm = lf0 + lf1;
#pragma unroll
        for (int o = 1; o < 64; o <<= 1) { const float t = __shfl_up(sm, o); if (lane >= o) sm += t; }
        const float b0 = sm - lf1, b1 = sm;
        const float u0 = li0 - b0, u1 = li1 - b1;
        float mx = fmaxf(u0, u1);
#pragma unroll
        for (int o = 1; o < 64; o <<= 1) { const float t = __shfl_up(mx, o); if (lane >= o) mx = fmaxf(mx, t); }
        float pe = __shfl_up(mx, 1); if (lane == 0) pe = -3.0e38f;
        const float pm0 = fmaxf(pe, u0), pm1 = mx;
        LAS float* A = sALL + wid * 384;
        A[p0] = u0; A[p1] = u1; A[128 + p0] = pm0; A[128 + p1] = pm1; A[256 + p0] = b0; A[256 + p1] = b1;
        if (lane == 63) { sCH[wid * 4 + 0] = sm; sCH[wid * 4 + 1] = mx; }
    }
    __syncthreads();
    if (tid == 0) { float m0 = sMISC[1], bsum = 0.f;
        for (int c = 0; c < nchunks; ++c) { const float Bt = sCH[c * 4 + 0], U = sCH[c * 4 + 1]; const float Mp = fmaxf(m0, U); sCH[c * 4 + 2] = m0; sCH[c * 4 + 3] = Mp; m0 = Bt + Mp; bsum += Bt; }
        sMISC[1] = m0; sMISC[2] = bsum; }
    u32x4 kq[8];
    { const int tok0 = chunk_tok0(0);
#pragma unroll
      for (int i = 0; i < 4; ++i) { const int n = tid + 512 * i, row = n >> 4, ch = n & 15; kq[i] = *(const u32x4*)(Kg + (size_t)(tok0 + row) * 512 + h * 128 + ch * 8);
          if (PASS2) kq[4 + i] = *(const u32x4*)(Qg + (size_t)(tok0 + row) * 512 + h * 128 + ch * 8); } }
    __syncthreads();
    for (int ci = 0; ci < nchunks; ++ci) {
        tid = (wid << 6) | lane_id(); asm volatile("" : "+v"(tid)); lane = tid & 63; r = lane & 31; hh = lane >> 5;
        const int tok0 = chunk_tok0(ci);
#pragma unroll
        for (int i = 0; i < 4; ++i) { const int n = tid + 512 * i, row = n >> 4, ch = n & 15;
            *(LAS u32x4*)(KS + off_b(row, ch)) = kq[i];
            if (PASS2) *(LAS u32x4*)(QS + off_b(row, ch)) = kq[4 + i]; }
        bf16x8 vf[8];
#pragma unroll
        for (int ks = 0; ks < 8; ++ks) vf[ks] = *(const bf16x8*)(VT + (size_t)(h * 256 + 32 * wid + r) * MT + tok0 + 16 * ks + 8 * hh);
        if (tid < 128) { const LAS float* A = sALL + ci * 384; const float u = A[tid], m0 = sCH[ci * 4 + 2], Mp = sCH[ci * 4 + 3];
            sU[tid] = u; sEV[tid] = __expf(u - Mp);
            if (PASS2) { const float t = fmaxf(m0, A[128 + tid]); sT[tid] = t; sWST[tid] = __expf(m0 - t); sCL[tid] = __expf(-(A[256 + tid] + t)); }
            if (tid == 0) sMISC[0] = __expf(m0 - Mp); }
        __syncthreads();
        f32x16 num[4];
        if (PASS2) {
            const int stt = wid >> 1;
#pragma unroll
            for (int i = 0; i < 2; ++i) { const int jt = 2 * (wid & 1) + i; const bool skip = dir ? (stt < jt) : (stt > jt); const int j = 32 * jt + r;
                if (!skip) {
                    f32x16 acc;
#pragma unroll
                    for (int e = 0; e < 16; ++e) acc[e] = 0.f;
#pragma unroll
                    for (int ks = 0; ks < 8; ++ks) { const bf16x8 a = *(const LAS bf16x8*)(KS + off_b(32 * stt + r, 2 * ks + hh)); const bf16x8 bq = *(const LAS bf16x8*)(QS + off_b(j, 2 * ks + hh)); acc = MFMA32(a, bq, acc); if ((ks & 3) == 3) asm volatile("" : "+v"(acc) :: "memory"); }
                    const float tj = sT[j]; float rs = 0.f;
#pragma unroll
                    for (int gq = 0; gq < 4; ++gq) { const f32x4 us = *(const LAS f32x4*)(sU + 32 * stt + 8 * gq + 4 * hh); float pv[4];
#pragma unroll
                        for (int e = 0; e < 4; ++e) { const int s = 32 * stt + 8 * gq + 4 * hh + e; const bool ok = dir ? (s >= j) : (s <= j); const float p = ok ? acc[4 * gq + e] * __expf(us[e] - tj) : 0.f; rs += p; pv[e] = p; }
                        u32x2 w; w.x = pk2(pv[0], pv[1]); w.y = pk2(pv[2], pv[3]); *(LAS u32x2*)(PS + off_b(j, 4 * stt + gq) + 8 * hh) = w; }
                    rs += __shfl_xor(rs, 32); if (hh == 0) sDENP[stt * 128 + j] = rs;
                } else if (hh == 0) sDENP[stt * 128 + j] = 0.f;
            }
            { const int j = tid & 127, part = tid >> 7; float s = 0.f;
#pragma unroll
              for (int cc = 0; cc < 4; ++cc) { const u32x4 q8 = *(const LAS u32x4*)(QS + off_b(j, 4 * part + cc)); const f32x4 n0a = *(const LAS f32x4*)(sN0 + 32 * part + 8 * cc), n0b = *(const LAS f32x4*)(sN0 + 32 * part + 8 * cc + 4);
                  s += bf_lo(q8.x) * n0a[0] + bf_hi(q8.x) * n0a[1] + bf_lo(q8.y) * n0a[2] + bf_hi(q8.y) * n0a[3] + bf_lo(q8.z) * n0b[0] + bf_hi(q8.z) * n0b[1] + bf_lo(q8.w) * n0b[2] + bf_hi(q8.w) * n0b[3]; }
              sQNP[part * 128 + j] = s; }
            tid = (wid << 6) | lane_id(); asm volatile("" : "+v"(tid)); lane = tid & 63; r = lane & 31; hh = lane >> 5;
#pragma unroll
            for (int jt = 0; jt < 4; ++jt)
#pragma unroll
                for (int e = 0; e < 16; ++e) num[jt][e] = 0.f;
            {
                bf16x8 qf[2][4];
                auto ldq = [&](int g_, bf16x8 (&qb)[4]) { const int dkt = g_ >> 1, s2 = g_ & 1;
#pragma unroll
                    for (int jt = 0; jt < 4; ++jt) { const s16x4 lo = *(const LAS s16x4*)(QS + off_b(32 * jt + r, 4 * dkt + 2 * s2) + 8 * hh); const s16x4 hi = *(const LAS s16x4*)(QS + off_b(32 * jt + r, 4 * dkt + 2 * s2 + 1) + 8 * hh);
                        qb[jt] = __builtin_shufflevector(lo, hi, 0, 1, 2, 3, 4, 5, 6, 7); } };
                ldq(0, qf[0]);
#pragma unroll
                for (int g_ = 0; g_ < 8; ++g_) { const int dkt = g_ >> 1, s2 = g_ & 1;
                    if (g_ + 1 < 8) ldq(g_ + 1, qf[(g_ + 1) & 1]);
                    __builtin_amdgcn_sched_barrier(0);
                    u32x4 xp; xp.x = pk2(C[dkt][8 * s2 + 0], C[dkt][8 * s2 + 1]); xp.y = pk2(C[dkt][8 * s2 + 2], C[dkt][8 * s2 + 3]); xp.z = pk2(C[dkt][8 * s2 + 4], C[dkt][8 * s2 + 5]); xp.w = pk2(C[dkt][8 * s2 + 6], C[dkt][8 * s2 + 7]);
                    const bf16x8 xs = __builtin_bit_cast(bf16x8, xp);
#pragma unroll
                    for (int jt = 0; jt < 4; ++jt) num[jt] = MFMA32(xs, qf[g_ & 1][jt], num[jt]);
                    __builtin_amdgcn_sched_barrier(0);
                    if (s2 == 1) asm volatile("" : "+v"(num[0]), "+v"(num[1]), "+v"(num[2]), "+v"(num[3]) :: "memory"); }
            }
#pragma unroll
            for (int jt = 0; jt < 4; ++jt) { const float ws_ = sWST[32 * jt + r];
#pragma unroll
                for (int e = 0; e < 16; ++e) num[jt][e] *= ws_; }
            __syncthreads();
            tid = (wid << 6) | lane_id(); asm volatile("" : "+v"(tid)); lane = tid & 63; r = lane & 31; hh = lane >> 5;
            {
                bf16x8 pf[2][4];
                auto ldp = [&](int ks, bf16x8 (&pb)[4]) {
#pragma unroll
                    for (int jt = 0; jt < 4; ++jt) { const bool on = dir ? (ks >= 2 * jt) : (ks <= 2 * jt + 1); if (on) pb[jt] = *(const LAS bf16x8*)(PS + off_b(32 * jt + r, 2 * ks + hh)); } };
                ldp(0, pf[0]);
#pragma unroll
                for (int ks = 0; ks < 8; ++ks) {
                    if (ks + 1 < 8) ldp(ks + 1, pf[(ks + 1) & 1]);
                    __builtin_amdgcn_sched_barrier(0);
#pragma unroll
                    for (int jt = 0; jt < 4; ++jt) { const bool on = dir ? (ks >= 2 * jt) : (ks <= 2 * jt + 1); if (on) num[jt] = MFMA32(vf[ks], pf[ks & 1][jt], num[jt]); }
                    __builtin_amdgcn_sched_barrier(0); }
                asm volatile("" : "+v"(num[0]), "+v"(num[1]), "+v"(num[2]), "+v"(num[3]) :: "memory");
            }
            bf16_t* Hd = (bf16_t*)(P.ws + (dir ? WS_HB : WS_HF));
#pragma unroll
            for (int jt = 0; jt < 4; ++jt) { const int j = 32 * jt + r;
                const float den = (sDENP[j] + sDENP[128 + j]) + (sDENP[256 + j] + sDENP[384 + j]) + sWST[j] * ((sQNP[j] + sQNP[128 + j]) + (sQNP[256 + j] + sQNP[384 + j]));
                const float inv = 1.0f / fmaxf(fabsf(den), sCL[j]);
                bf16_t* hp = Hd + (size_t)(tok0 + j) * 1024 + h * 256 + 32 * wid + 4 * hh;
#pragma unroll
                for (int gq = 0; gq < 4; ++gq) { u32x2 w; w.x = pk2(num[jt][4 * gq] * inv, num[jt][4 * gq + 1] * inv); w.y = pk2(num[jt][4 * gq + 2] * inv, num[jt][4 * gq + 3] * inv); *(u32x2*)(hp + 8 * gq) = w; } }
        }
        tid = (wid << 6) | lane_id(); asm volatile("" : "+v"(tid)); lane = tid & 63; r = lane & 31; hh = lane >> 5;
        { const int tokn = chunk_tok0(ci + 1 < nchunks ? ci + 1 : ci);
#pragma unroll
            for (int i = 0; i < 4; ++i) { const int n = tid + 512 * i, row = n >> 4, ch = n & 15; kq[i] = *(const u32x4*)(Kg + (size_t)(tokn + row) * 512 + h * 128 + ch * 8);
                if (PASS2) kq[4 + i] = *(const u32x4*)(Qg + (size_t)(tokn + row) * 512 + h * 128 + ch * 8); } }
        const float a = sMISC[0];
#pragma unroll
        for (int dkt = 0; dkt < 4; ++dkt)
#pragma unroll
            for (int e = 0; e < 16; ++e) C[dkt][e] *= a;
#pragma unroll
        for (int ks = 0; ks < 8; ++ks) { const f32x4 e0 = *(const LAS f32x4*)(sEV + 16 * ks + 8 * hh), e1 = *(const LAS f32x4*)(sEV + 16 * ks + 8 * hh + 4);
            u32x4 v = __builtin_bit_cast(u32x4, vf[ks]);
            v.x = pk2(bf_lo(v.x) * e0[0], bf_hi(v.x) * e0[1]); v.y = pk2(bf_lo(v.y) * e0[2], bf_hi(v.y) * e0[3]); v.z = pk2(bf_lo(v.z) * e1[0], bf_hi(v.z) * e1[1]); v.w = pk2(bf_lo(v.w) * e1[2], bf_hi(v.w) * e1[3]);
            vf[ks] = __builtin_bit_cast(bf16x8, v); }
        { const unsigned blk = (lane >> 4) & 1, q = (lane & 15) >> 2, p = lane & 3;
          bf16x8 kf[2][4];
          auto ldk = [&](int ks, bf16x8 (&kb)[4]) {
#pragma unroll
              for (int dkt = 0; dkt < 4; ++dkt) {
                  const s16x4 lo = __builtin_amdgcn_ds_read_tr16_b64_v4i16((LAS s16x4*)(KS + off_b(16 * ks + 8 * hh + q, 4 * dkt + 2 * blk + (p >> 1)) + 8 * (p & 1)));
                  const s16x4 hi = __builtin_amdgcn_ds_read_tr16_b64_v4i16((LAS s16x4*)(KS + off_b(16 * ks + 8 * hh + 4 + q, 4 * dkt + 2 * blk + (p >> 1)) + 8 * (p & 1)));
                  kb[dkt] = __builtin_shufflevector(lo, hi, 0, 1, 2, 3, 4, 5, 6, 7); } };
          ldk(0, kf[0]);
#pragma unroll
          for (int ks = 0; ks < 8; ++ks) {
              if (ks + 1 < 8) ldk(ks + 1, kf[(ks + 1) & 1]);
              __builtin_amdgcn_sched_barrier(0);
#pragma unroll
              for (int dkt = 0; dkt < 4; ++dkt) C[dkt] = MFMA32(kf[ks & 1][dkt], vf[ks], C[dkt]);
              __builtin_amdgcn_sched_barrier(0); }
          asm volatile("" : "+v"(C[0]), "+v"(C[1]), "+v"(C[2]), "+v"(C[3]) :: "memory"); }
        { const int dk = tid & 127, part = tid >> 7; float s = 0.f;
#pragma unroll 8
          for (int i = 0; i < 32; ++i) { const int sp = 32 * part + i; s += sEV[sp] * bf2f(*(const LAS unsigned short*)(KS + off_b(sp, dk >> 3) + (dk & 7) * 2)); }
          sNPART[part * 128 + dk] = s; }
        __syncthreads();
        if (tid < 128) sN0[tid] = a * sN0[tid] + ((sNPART[tid] + sNPART[128 + tid]) + (sNPART[256 + tid] + sNPART[384 + tid]));
        __syncthreads();
    }
    if (!PASS2) {
        float* tc = (float*)(P.ws + WS_TUPC) + ((size_t)st * 16 + g) * 32768;
#pragma unroll
        for (int dkt = 0; dkt < 4; ++dkt)
#pragma unroll
            for (int e = 0; e < 16; ++e) tc[(32 * dkt + (e & 3) + 8 * (e >> 2) + 4 * hh) * 256 + 32 * wid + r] = C[dkt][e];
        if (tid < 128) ((float*)(P.ws + WS_TUPN))[((size_t)st * 16 + g) * 128 + tid] = sN0[tid];
        if (tid == 0) { float* ts = (float*)(P.ws + WS_TUPN + 512 * 1024) + ((size_t)st * 16 + g) * 2; ts[0] = sMISC[2]; ts[1] = sMISC[1]; }
    }
    __syncthreads();
}
DI void mlstm_pass1(const Params& P, LAS unsigned char* lds, int st, int g) {
    const int wid = wave_in_wg();
    int tid = (wid << 6) | lane_id(), lane = tid & 63, r = lane & 31, hh = lane >> 5;
    const int dir = st >> 3, b = (st >> 2) & 1, h = st & 3;
    LAS float* SC = (LAS float*)(lds + ML_SC);
    LAS float* sEVA = SC;
    LAS float* sNPART = SC + SC_NPART / 4; LAS float* sMISC = SC + SC_MISC / 4;
    LAS float* sALL = SC + 10496 / 4; LAS float* sCH = sALL + 8 * 3 * 128; LAS float* sA = sCH + 40;
    const bf16_t* Kg = (const bf16_t*)(P.ws + WS_K); const bf16_t* VT = (const bf16_t*)(P.ws + WS_VT);
    const float* gates = (const float*)(P.ws + WS_GATES);
    const int ctx_item = (g == 0); const int nchunks = ctx_item ? 2 : 8; const int seg = g - 1;
    f32x16 C[4];
#pragma unroll
    for (int i = 0; i < 4; ++i)
#pragma unroll
        for (int e = 0; e < 16; ++e) C[i][e] = 0.f;
    __syncthreads();
    auto chunk_tok0 = [&](int ci) -> int { if (ctx_item) return T + b * CTXL + (dir ? (1 - ci) : ci) * 128;
        const int cp = seg * 8 + ci; const int chunk = dir ? (NCHUNK - 1 - cp) : cp; return b * SEQ + chunk * 128; };
    if (wid < nchunks) { const int t0c = chunk_tok0(wid);
        const int p0 = dir ? 127 - 2 * lane : 2 * lane, p1 = dir ? 126 - 2 * lane : 2 * lane + 1;
        const float* g0 = gates + (size_t)(t0c + p0) * 16; const float* g1 = gates + (size_t)(t0c + p1) * 16;
        const float li0 = softcap(g0[dir * 8 + h]), li1 = softcap(g1[dir * 8 + h]); const float lf0 = logsigmoid(softcap(g0[dir * 8 + 4 + h])), lf1 = logsigmoid(softcap(g1[dir * 8 + 4 + h]));
        float sm = lf0 + lf1;
#pragma unroll
        for (int o = 1; o < 64; o <<= 1) { const float t = __shfl_up(sm, o); if (lane >= o) sm += t; }
        const float b0 = sm - lf1, b1 = sm;
        const float u0 = li0 - b0, u1 = li1 - b1;
        float mx = fmaxf(u0, u1);
#pragma unroll
        for (int o = 1; o < 64; o <<= 1) { const float t = __shfl_up(mx, o); if (lane >= o) mx = fmaxf(mx, t); }
        LAS float* A = sALL + wid * 384;
        A[p0] = u0; A[p1] = u1;
        if (lane == 63) { sCH[wid * 4 + 0] = sm; sCH[wid * 4 + 1] = mx; }
    }
    __syncthreads();
    if (tid == 0) { float m0 = -1e30f, bsum = 0.f;
        for (int c = 0; c < nchunks; ++c) { const float Bt = sCH[c * 4 + 0], U = sCH[c * 4 + 1]; const float Mp = fmaxf(m0, U); sCH[c * 4 + 3] = Mp; sA[c] = __expf(m0 - Mp); m0 = Bt + Mp; bsum += Bt; }
        sMISC[1] = m0; sMISC[2] = bsum; }
    u32x4 kq[4]; bf16x8 vf[8], vfn[8];
    { const int tok0 = chunk_tok0(0);
#pragma unroll
      for (int i = 0; i < 4; ++i) { const int n = tid + 512 * i, row = n >> 4, ch = n & 15; kq[i] = *(const u32x4*)(Kg + (size_t)(tok0 + row) * 512 + h * 128 + ch * 8); }
#pragma unroll
      for (int ks = 0; ks < 8; ++ks) vfn[ks] = *(const bf16x8*)(VT + (size_t)(h * 256 + 32 * wid + r) * MT + tok0 + 16 * ks + 8 * hh); }
    __syncthreads();
    for (int i = tid; i < nchunks * 128; i += 512) { const int c = i >> 7; sEVA[i] = __expf(sALL[c * 384 + (i & 127)] - sCH[c * 4 + 3]); }
    float nacc = 0.f;
    for (int ci = 0; ci < nchunks; ++ci) {
        tid = (wid << 6) | lane_id(); asm volatile("" : "+v"(tid)); lane = tid & 63; r = lane & 31; hh = lane >> 5;
        LAS unsigned char* KB = lds + ((ci & 1) ? ML_PS : ML_KS);
#pragma unroll
        for (int i = 0; i < 4; ++i) { const int n = tid + 512 * i, row = n >> 4, ch = n & 15; *(LAS u32x4*)(KB + off_b(row, ch)) = kq[i]; }
#pragma unroll
        for (int ks = 0; ks < 8; ++ks) vf[ks] = vfn[ks];
        { const int tokn = chunk_tok0(ci + 1 < nchunks ? ci + 1 : ci);
#pragma unroll
            for (int i = 0; i < 4; ++i) { const int n = tid + 512 * i, row = n >> 4, ch = n & 15; kq[i] = *(const u32x4*)(Kg + (size_t)(tokn + row) * 512 + h * 128 + ch * 8); }
#pragma unroll
            for (int ks = 0; ks < 8; ++ks) vfn[ks] = *(const bf16x8*)(VT + (size_t)(h * 256 + 32 * wid + r) * MT + tokn + 16 * ks + 8 * hh); }
        __syncthreads();
        const LAS float* sEV = sEVA + ci * 128;
        const float a = sA[ci];
#pragma unroll
        for (int dkt = 0; dkt < 4; ++dkt)
#pragma unroll
            for (int e = 0; e < 16; ++e) C[dkt][e] *= a;
#pragma unroll
        for (int ks = 0; ks < 8; ++ks) { const f32x4 e0 = *(const LAS f32x4*)(sEV + 16 * ks + 8 * hh), e1 = *(const LAS f32x4*)(sEV + 16 * ks + 8 * hh + 4);
            u32x4 v = __builtin_bit_cast(u32x4, vf[ks]);
            v.x = pk2(bf_lo(v.x) * e0[0], bf_hi(v.x) * e0[1]); v.y = pk2(bf_lo(v.y) * e0[2], bf_hi(v.y) * e0[3]); v.z = pk2(bf_lo(v.z) * e1[0], bf_hi(v.z) * e1[1]); v.w = pk2(bf_lo(v.w) * e1[2], bf_hi(v.w) * e1[3]);
            vf[ks] = __builtin_bit_cast(bf16x8, v); }
        { const unsigned blk = (lane >> 4) & 1, q = (lane & 15) >> 2, p = lane & 3;
          bf16x8 kf[2][4];
          auto ldk = [&](int ks, bf16x8 (&kb)[4]) {
#pragma unroll
              for (int dkt = 0; dkt < 4; ++dkt) {
                  const s16x4 lo = __builtin_amdgcn_ds_read_tr16_b64_v4i16((LAS s16x4*)(KB + off_b(16 * ks + 8 * hh + q, 4 * dkt + 2 * blk + (p >> 1)) + 8 * (p & 1)));
                  const s16x4 hi = __builtin_amdgcn_ds_read_tr16_b64_v4i16((LAS s16x4*)(KB + off_b(16 * ks + 8 * hh + 4 + q, 4 * dkt + 2 * blk + (p >> 1)) + 8 * (p & 1)));
                  kb[dkt] = __builtin_shufflevector(lo, hi, 0, 1, 2, 3, 4, 5, 6, 7); } };
          ldk(0, kf[0]);
#pragma unroll
          for (int ks = 0; ks < 8; ++ks) {
              if (ks + 1 < 8) ldk(ks + 1, kf[(ks + 1) & 1]);
              __builtin_amdgcn_sched_barrier(0);
#pragma unroll
              for (int dkt = 0; dkt < 4; ++dkt) C[dkt] = MFMA32(kf[ks & 1][dkt], vf[ks], C[dkt]);
              __builtin_amdgcn_sched_barrier(0); }
          asm volatile("" : "+v"(C[0]), "+v"(C[1]), "+v"(C[2]), "+v"(C[3]) :: "memory"); }
        { const int dk = tid & 127, part = tid >> 7; float s_ = 0.f;
#pragma unroll 8
          for (int i = 0; i < 32; ++i) { const int sp = 32 * part + i; s_ += sEV[sp] * bf2f(*(const LAS unsigned short*)(KB + off_b(sp, dk >> 3) + (dk & 7) * 2)); }
          nacc = a * nacc + s_; }
    }
    tid = (wid << 6) | lane_id(); asm volatile("" : "+v"(tid)); lane = tid & 63; r = lane & 31; hh = lane >> 5;
    float* tc = (float*)(P.ws + WS_TUPC) + ((size_t)st * 16 + g) * 32768;
#pragma unroll
    for (int dkt = 0; dkt < 4; ++dkt)
#pragma unroll
        for (int e = 0; e < 16; ++e) tc[(32 * dkt + (e & 3) + 8 * (e >> 2) + 4 * hh) * 256 + 32 * wid + r] = C[dkt][e];
    sNPART[tid] = nacc;
    __syncthreads();
    if (tid < 128) ((float*)(P.ws + WS_TUPN))[((size_t)st * 16 + g) * 128 + tid] = (sNPART[tid] + sNPART[128 + tid]) + (sNPART[256 + tid] + sNPART[384 + tid]);
    if (tid == 0) { float* ts = (float*)(P.ws + WS_TUPN + 512 * 1024) + ((size_t)st * 16 + g) * 2; ts[0] = sMISC[2]; ts[1] = sMISC[1]; }
    __syncthreads();
}
DI void p4_scan(const Params& P, int G, int bid) {
    const int tid = my_tid();
    for (int it = bid; it < 256; it += G) { const int st = it >> 4, sl = it & 15;
        const float* tc = (const float*)(P.ws + WS_TUPC) + (size_t)st * 16 * 32768 + sl * 2048 + tid * 4;
        float* ec = (float*)(P.ws + WS_ENTC) + (size_t)st * 16 * 32768 + sl * 2048 + tid * 4;
        const float* tn = (const float*)(P.ws + WS_TUPN) + (size_t)st * 16 * 128; const float* ts = (const float*)(P.ws + WS_TUPN + 512 * 1024) + (size_t)st * 16 * 2;
        float* en = (float*)(P.ws + WS_ENTN) + (size_t)st * 16 * 128; float* em = (float*)(P.ws + WS_ENTN + 512 * 1024) + st * 16;
        f32x4 Cv = {0.f, 0.f, 0.f, 0.f}; float nv = 0.f, m = 0.f;
        f32x4 Ctv[16];
#pragma unroll
        for (int g = 0; g < 16; ++g) Ctv[g] = *(const f32x4*)(tc + (size_t)g * 32768);
        f32x4 tsv[8]; float tnv[16]; const bool nrow = (sl == 0 && tid < 128);
#pragma unroll
        for (int g = 0; g < 8; ++g) tsv[g] = *(const f32x4*)(ts + 4 * g);
#pragma unroll
        for (int g = 0; g < 16; ++g) tnv[g] = nrow ? tn[g * 128 + tid] : 0.f;
#pragma unroll
        for (int g = 0; g < 16; ++g) { const float Bt = tsv[g >> 1][2 * (g & 1)], mt = tsv[g >> 1][2 * (g & 1) + 1]; const float mn = fmaxf(Bt + m, mt); const float a = __expf(Bt + m - mn), gg = __expf(mt - mn);
            const f32x4 Ct = Ctv[g]; Cv = Cv * a + Ct * gg; *(f32x4*)(ec + (size_t)g * 32768) = Cv;
            if (nrow) { nv = a * nv + gg * tnv[g]; en[g * 128 + tid] = nv; }
            m = mn; if (sl == 0 && tid == 0) em[g] = m; }
    }
}

DI void p6_merge(const Params& P, int G, int bid) {
    const int tid = my_tid(), wid = __builtin_amdgcn_readfirstlane(tid >> 6), lane = tid & 63;
    const bf16_t* HF = (const bf16_t*)(P.ws + WS_HF); const bf16_t* HB = (const bf16_t*)(P.ws + WS_HB); const bf16_t* OB = (const bf16_t*)(P.ws + WS_O);
    const bf16_t* CB = (const bf16_t*)(P.ws + WS_CB); const bf16_t* CP = (const bf16_t*)(P.ws + WS_CC);
    unsigned char* A2 = (unsigned char*)(P.ws + WS_A2); float* asc = (float*)(P.ws + WS_ASC); const float* ng = P.in[I_NORMG]; const float* cw = P.in[I_CONVW];
    const int c0 = lane * 16;
    float ngv[16], cwv[3][16];
#pragma unroll
    for (int i = 0; i < 16; ++i) { ngv[i] = ng[c0 + i]; cwv[0][i] = cw[c0 + i]; cwv[1][i] = cw[1024 + c0 + i]; cwv[2][i] = cw[2048 + c0 + i]; }
    u32x4 L[14], N[14];
    const int dl = lane < 32 ? 1 : 64;
    auto issue = [&](int row, u32x4 (&R)[14]) {
        R[0] = *(const u32x4*)(HF + (size_t)row * 1024 + c0); R[1] = *(const u32x4*)(HF + (size_t)row * 1024 + c0 + 8);
        R[2] = *(const u32x4*)(HB + (size_t)row * 1024 + c0); R[3] = *(const u32x4*)(HB + (size_t)row * 1024 + c0 + 8);
        R[4] = *(const u32x4*)(OB + (size_t)row * 1024 + c0); R[5] = *(const u32x4*)(OB + (size_t)row * 1024 + c0 + 8);
        const int s_ = row & (SEQ - 1); const bool okl = lane < 32 ? ((s_ & 63) != 0) : (s_ >= 64); const bool okr = lane < 32 ? ((s_ & 63) != 63) : (s_ < SEQ - 64);
#pragma unroll
        for (int tpos = 0; tpos < 3; ++tpos) { const bool ok = tpos == 0 ? okl : (tpos == 2 ? okr : true);
            const size_t rr = (size_t)(row + (ok ? (tpos - 1) * dl : 0)) * 1024 + c0; R[6 + 2 * tpos] = *(const u32x4*)(CP + rr); R[7 + 2 * tpos] = *(const u32x4*)(CP + rr + 8); }
        R[12] = *(const u32x4*)(CB + (size_t)row * 1024 + c0); R[13] = *(const u32x4*)(CB + (size_t)row * 1024 + c0 + 8); };
    int row = bid * 8 + wid;
    if (row < T) issue(row, L);
    for (; row < T; row += G * 8) {
        const int nrow = row + G * 8;
        issue(nrow < T ? nrow : row, N);
        asm volatile("" ::: "memory");
        float y[16], z[16];
        { const u32x4 f0 = L[0], f1 = L[1], b0 = L[2], b1 = L[3], o0 = L[4], o1 = L[5];
          float hv[16], ov[16];
#pragma unroll
          for (int i = 0; i < 4; ++i) { hv[2 * i] = bf_lo(f0[i]) + bf_lo(b0[i]); hv[2 * i + 1] = bf_hi(f0[i]) + bf_hi(b0[i]); hv[8 + 2 * i] = bf_lo(f1[i]) + bf_lo(b1[i]); hv[8 + 2 * i + 1] = bf_hi(f1[i]) + bf_hi(b1[i]);
              ov[2 * i] = bf_lo(o0[i]); ov[2 * i + 1] = bf_hi(o0[i]); ov[8 + 2 * i] = bf_lo(o1[i]); ov[8 + 2 * i + 1] = bf_hi(o1[i]); }
          float ss = 0.f;
#pragma unroll
          for (int i = 0; i < 16; ++i) ss += hv[i] * hv[i];
          ss = row16_sum(ss);
          const float rs = 1.0f / sqrtf(ss * (1.0f / 256.0f) + EPS);
#pragma unroll
          for (int i = 0; i < 16; ++i) y[i] = hv[i] * rs * ngv[i] * (1.0f / (1.0f + __expf(-ov[i]))); }
        { const int s_ = row & (SEQ - 1); const bool okl = lane < 32 ? ((s_ & 63) != 0) : (s_ >= 64); const bool okr = lane < 32 ? ((s_ & 63) != 63) : (s_ < SEQ - 64);
          float acc[16];
#pragma unroll
          for (int i = 0; i < 16; ++i) acc[i] = 0.f;
#pragma unroll
          for (int tpos = 0; tpos < 3; ++tpos) { const u32x4 a0 = L[6 + 2 * tpos], a1 = L[7 + 2 * tpos]; const float m = tpos == 0 ? (okl ? 1.0f : 0.0f) : (tpos == 2 ? (okr ? 1.0f : 0.0f) : 1.0f);
#pragma unroll
              for (int i = 0; i < 4; ++i) { acc[2 * i] += m * cwv[tpos][2 * i] * bf_lo(a0[i]); acc[2 * i + 1] += m * cwv[tpos][2 * i + 1] * bf_hi(a0[i]);
                  acc[8 + 2 * i] += m * cwv[tpos][8 + 2 * i] * bf_lo(a1[i]); acc[8 + 2 * i + 1] += m * cwv[tpos][8 + 2 * i + 1] * bf_hi(a1[i]); } }
          const u32x4 g0 = L[12], g1 = L[13];
#pragma unroll
          for (int i = 0; i < 4; ++i) { z[2 * i] = acc[2 * i] * bf_lo(g0[i]); z[2 * i + 1] = acc[2 * i + 1] * bf_hi(g0[i]); z[8 + 2 * i] = acc[8 + 2 * i] * bf_lo(g1[i]); z[8 + 2 * i + 1] = acc[8 + 2 * i + 1] * bf_hi(g1[i]); } }
        float mx = 0.f;
#pragma unroll
        for (int i = 0; i < 16; ++i) mx = fmaxf(mx, fmaxf(fabsf(y[i]), fabsf(z[i])));
        mx = wave_max(mx);
        const float inv = mx > 0.f ? 127.0f / mx : 0.f;
        if (lane == 0) asc[row] = mx > 0.f ? mx * (1.0f / 127.0f) : 1.0f;
        u32x4 w0, w1;
        w0.x = pk4i8(__builtin_rintf(y[0] * inv), __builtin_rintf(y[1] * inv), __builtin_rintf(y[2] * inv), __builtin_rintf(y[3] * inv)); w0.y = pk4i8(__builtin_rintf(y[4] * inv), __builtin_rintf(y[5] * inv), __builtin_rintf(y[6] * inv), __builtin_rintf(y[7] * inv));
        w0.z = pk4i8(__builtin_rintf(y[8] * inv), __builtin_rintf(y[9] * inv), __builtin_rintf(y[10] * inv), __builtin_rintf(y[11] * inv)); w0.w = pk4i8(__builtin_rintf(y[12] * inv), __builtin_rintf(y[13] * inv), __builtin_rintf(y[14] * inv), __builtin_rintf(y[15] * inv));
        w1.x = pk4i8(__builtin_rintf(z[0] * inv), __builtin_rintf(z[1] * inv), __builtin_rintf(z[2] * inv), __builtin_rintf(z[3] * inv)); w1.y = pk4i8(__builtin_rintf(z[4] * inv), __builtin_rintf(z[5] * inv), __builtin_rintf(z[6] * inv), __builtin_rintf(z[7] * inv));
        w1.z = pk4i8(__builtin_rintf(z[8] * inv), __builtin_rintf(z[9] * inv), __builtin_rintf(z[10] * inv), __builtin_rintf(z[11] * inv)); w1.w = pk4i8(__builtin_rintf(z[12] * inv), __builtin_rintf(z[13] * inv), __builtin_rintf(z[14] * inv), __builtin_rintf(z[15] * inv));
        *(u32x4*)(A2 + (size_t)row * D + c0) = w0; *(u32x4*)(A2 + (size_t)row * D + 1024 + c0) = w1;
#pragma unroll
        for (int i = 0; i < 14; ++i) L[i] = N[i];
    }
}

DI void topk_block256(const Params& P, LAS unsigned char* lds, int row0) {
    const int tid = my_tid();
    LAS unsigned* lc = (LAS unsigned*)lds; LAS unsigned* lbase = lc + 32;
    const float* logits = (const float*)(P.ws + WS_LOGITS); unsigned* gc = (unsigned*)(P.ws + WS_CTL) + CW_GCNT;
    int* list = (int*)(P.ws + WS_LIST); float* listw = (float*)(P.ws + WS_LISTW);
    if (tid < 32) lc[tid] = 0u;
    __syncthreads();
    const bool act = tid < 256; const int tok = row0 + (act ? tid : 0);
    float v[32];
#pragma unroll
    for (int i = 0; i < 8; ++i) { const f32x4 t = *(const f32x4*)(logits + (size_t)tok * NE + 4 * i); v[4 * i] = t[0]; v[4 * i + 1] = t[1]; v[4 * i + 2] = t[2]; v[4 * i + 3] = t[3]; }
    int idx[4]; float val[4];
#pragma unroll
    for (int k = 0; k < 4; ++k) { float best = -3.0e38f; int bi = 0;
#pragma unroll
        for (int e = 0; e < 32; ++e) { const bool taken = (k > 0 && idx[0] == e) || (k > 1 && idx[1] == e) || (k > 2 && idx[2] == e); if (!taken && v[e] > best) { best = v[e]; bi = e; } }
        idx[k] = bi; val[k] = best; }
    float w[4]; float sum = 0.f;
#pragma unroll
    for (int k = 0; k < 4; ++k) { w[k] = __expf(val[k] - val[0]); sum += w[k]; }
    const float inv = 1.0f / sum;
    unsigned rank[4] = {0u, 0u, 0u, 0u};
    if (act) {
#pragma unroll
        for (int k = 0; k < 4; ++k) rank[k] = atomicAdd((unsigned*)&lc[idx[k]], 1u); }
    __syncthreads();
    if (tid < 32) lbase[tid] = __hip_atomic_fetch_add(gc + tid, lc[tid], __ATOMIC_RELAXED, __HIP_MEMORY_SCOPE_AGENT);
    __syncthreads();
    if (act) {
#pragma unroll
        for (int k = 0; k < 4; ++k) { const unsigned pos = lbase[idx[k]] + rank[k]; list[(size_t)idx[k] * T + pos] = tok * 4 + k; listw[(size_t)idx[k] * T + pos] = w[k] * inv; } }
    __syncthreads();
}
DI void p8_topk(const Params& P, LAS unsigned char* lds, int G, int bid) {
    const int tid = my_tid();
    LAS unsigned* lc = (LAS unsigned*)lds; LAS unsigned* lbase = lc + 32;
    const float* logits = (const float*)(P.ws + WS_LOGITS); unsigned* gc = (unsigned*)(P.ws + WS_CTL) + CW_GCNT;
    int* list = (int*)(P.ws + WS_LIST); float* listw = (float*)(P.ws + WS_LISTW);
    for (int blk = bid; blk < T / 512; blk += G) {
        __syncthreads();
        if (tid < 32) lc[tid] = 0u;
        __syncthreads();
        const int tok = blk * 512 + tid;
        float v[32];
#pragma unroll
        for (int i = 0; i < 8; ++i) { const f32x4 t = *(const f32x4*)(logits + (size_t)tok * NE + 4 * i); v[4 * i] = t[0]; v[4 * i + 1] = t[1]; v[4 * i + 2] = t[2]; v[4 * i + 3] = t[3]; }
        int idx[4]; float val[4];
#pragma unroll
        for (int k = 0; k < 4; ++k) { float best = -3.0e38f; int bi = 0;
#pragma unroll
            for (int e = 0; e < 32; ++e) { const bool taken = (k > 0 && idx[0] == e) || (k > 1 && idx[1] == e) || (k > 2 && idx[2] == e); if (!taken && v[e] > best) { best = v[e]; bi = e; } }
            idx[k] = bi; val[k] = best; }
        float w[4]; float sum = 0.f;
#pragma unroll
        for (int k = 0; k < 4; ++k) { w[k] = __expf(val[k] - val[0]); sum += w[k]; }
        const float inv = 1.0f / sum;
        unsigned rank[4];
#pragma unroll
        for (int k = 0; k < 4; ++k) rank[k] = atomicAdd((unsigned*)&lc[idx[k]], 1u);
        __syncthreads();
        if (tid < 32) lbase[tid] = __hip_atomic_fetch_add(gc + tid, lc[tid], __ATOMIC_RELAXED, __HIP_MEMORY_SCOPE_AGENT);
        __syncthreads();
#pragma unroll
        for (int k = 0; k < 4; ++k) { const unsigned pos = lbase[idx[k]] + rank[k]; list[(size_t)idx[k] * T + pos] = tok * 4 + k; listw[(size_t)idx[k] * T + pos] = w[k] * inv; }
    }
    __syncthreads();
}
DI void p8_gather(const Params& P, LAS unsigned char* lds, int G, int bid) {
    const int tid = my_tid(), wid = __builtin_amdgcn_readfirstlane(tid >> 6), lane = tid & 63;
    const LAS int* tab = (const LAS int*)(lds + LDS_CTL_OFF + 64);
    const unsigned char* XN2 = (const unsigned char*)(P.ws + WS_XN8); unsigned char* XG = (unsigned char*)(P.ws + WS_XG); const int* list = (const int*)(P.ws + WS_LIST);
    const int nrows = __builtin_amdgcn_readfirstlane(tab[64]) * 256; const int nw = G * 8; const int per = (((nrows + nw - 1) / nw) + 7) & ~7;
    const int r0 = (bid * 8 + wid) * per; const int r1 = (r0 + per) < nrows ? (r0 + per) : nrows;
#pragma unroll 1
    for (int R0 = r0; R0 < r1; R0 += 64) {
        const int R = R0 + lane; int tokv = 0;
        if (R < r1) { const int tile = R >> 8; int e = 0;
            for (int k = 1; k < 32; ++k) if (tile >= tab[32 + k]) e = k;
            const int pos = R - tab[32 + e] * 256; tokv = pos < tab[e] ? (list[(size_t)e * T + pos] >> 2) : 0; }
        const int nr = (r1 - R0) < 64 ? (r1 - R0) : 64;
#pragma unroll 1
        for (int rb = 0; rb < nr; rb += 8) { u32x4 v[8][2];
#pragma unroll
            for (int q = 0; q < 8; ++q) { const int tok = __shfl(tokv, rb + q); const u32x4* src = (const u32x4*)(XN2 + (size_t)tok * D); v[q][0] = src[lane]; v[q][1] = src[lane + 64]; }
#pragma unroll
            for (int q = 0; q < 8; ++q) { u32x4* dst = (u32x4*)(XG + (size_t)(R0 + rb + q) * D); dst[lane] = v[q][0]; dst[lane + 64] = v[q][1]; } }
    }
}

DI void p11_final(const Params& P, int G, int bid) {
    const int tid = my_tid(), wid = __builtin_amdgcn_readfirstlane(tid >> 6), lane = tid & 63;
    const bf16_t* X1 = (const bf16_t*)(P.ws + WS_X1); const unsigned char* YS = (const unsigned char*)(P.ws + WS_YS); const float* modf = (const float*)(P.ws + WS_MODF); const float* gfin = P.in[I_GFIN];
    for (int row = bid * 8 + wid; row < T; row += G * 8) {
        const float* gt = modf + (size_t)(row / SEQ) * NMOD + 5 * D;
        f32x4 v[8]; float ss = 0.f;
#pragma unroll
        for (int j = 0; j < 4; ++j) { const int c = 512 * j + 8 * lane; f32x4 m0 = {0.f, 0.f, 0.f, 0.f}, m1 = m0;
#pragma unroll
            for (int k = 0; k < 4; ++k) { const u32x2 y = *(const u32x2*)(YS + ((size_t)row * 4 + k) * D + c);
                const f32x2 a = __builtin_amdgcn_cvt_pk_f32_fp8((int)y.x, false), b = __builtin_amdgcn_cvt_pk_f32_fp8((int)y.x, true), cc = __builtin_amdgcn_cvt_pk_f32_fp8((int)y.y, false), d = __builtin_amdgcn_cvt_pk_f32_fp8((int)y.y, true);
                m0[0] += a[0]; m0[1] += a[1]; m0[2] += b[0]; m0[3] += b[1]; m1[0] += cc[0]; m1[1] += cc[1]; m1[2] += d[0]; m1[3] += d[1]; }
            f32x4 x0, x1v; unpack8(*(const u32x4*)(X1 + (size_t)row * D + c), x0, x1v);
            v[2 * j] = x0 + *(const f32x4*)(gt + c) * m0; v[2 * j + 1] = x1v + *(const f32x4*)(gt + c + 4) * m1;
            ss += (v[2 * j][0] * v[2 * j][0] + v[2 * j][1] * v[2 * j][1]) + (v[2 * j][2] * v[2 * j][2] + v[2 * j][3] * v[2 * j][3]) + (v[2 * j + 1][0] * v[2 * j + 1][0] + v[2 * j + 1][1] * v[2 * j + 1][1]) + (v[2 * j + 1][2] * v[2 * j + 1][2] + v[2 * j + 1][3] * v[2 * j + 1][3]); }
        const float rs = 1.0f / sqrtf(wave_sum(ss) * (1.0f / D) + EPS);
#pragma unroll
        for (int j = 0; j < 4; ++j) { const int c = 512 * j + 8 * lane; *(f32x4*)(P.out + (size_t)row * D + c) = v[2 * j] * rs * *(const f32x4*)(gfin + c); *(f32x4*)(P.out + (size_t)row * D + c + 4) = v[2 * j + 1] * rs * *(const f32x4*)(gfin + c + 4); }
    }
}

__global__ void __launch_bounds__(512, 2) hymba_fwd(Params P) {
    LAS unsigned char* lds = (LAS unsigned char*)lds_raw;
    const int G = gridDim.x, bid = blockIdx.x;
    { const int t0 = threadIdx.x;
      for (int u = t0; u < 256; u += 512) ((LAS unsigned*)(lds + LDS_CTL_OFF))[u] = 0u;
      if ((t0 & 63) == 0) ((LAS int*)(lds + LDS_CTL_OFF + 1024))[hw_wave_slot()] = t0 >> 6; }
    __syncthreads();
#if MK_ONE_LAUNCH
    (void)xcd_barrier_post((unsigned*)(P.ws + WS_CTL) + CW_BAR, (volatile LAS unsigned*)(lds + LDS_CTL_OFF));
#define GRID_BAR() do { XcdBarrier b_; b_.bar = (unsigned*)(P.ws + WS_CTL) + CW_BAR; b_.x = xb_xcc_id(); b_.st = (volatile LAS unsigned*)(lds + LDS_CTL_OFF); xcd_barrier(b_); } while (0)
#else
#define GRID_BAR() do {} while (0)
#endif
    const int lo = P.ph_lo, hi = P.ph_hi;
#ifndef PH_MASK
#define PH_MASK 0x1fff
#endif
#define IN(k) (((PH_MASK >> (k)) & 1) && lo <= (k) && (k) < hi)
#define SEAM(k) do { if (IN(k) && IN((k) + 1)) GRID_BAR(); } while (0)

#ifndef REP_MASK
#define REP_MASK 0
#endif
#define PHASE(k, ...) do { if (IN(k)) { __VA_ARGS__ if ((REP_MASK >> (k)) & 1) { GRID_BAR(); __VA_ARGS__ } } SEAM(k); } while (0)
    const bool slots = (G == 256); constexpr int NG_IN = 176;
    PHASE(0, { p0_adaln(P, lds, G, bid); p0_small_rows(P, G, bid); p0_w_int8<true>(P, lds, G, bid, 0); p0_w_int8<false>(P, lds, G, bid, G >= 256 ? 192 : 0); __syncthreads(); if (!slots) conv_experts(P, lds, bid * 8 + wave_in_wg(), G * 8, 0, CV_ITEMS); });
    PHASE(1, { p1_modulate(P, lds, G, bid); });
    PHASE(2, { const int ng = slots ? NG_IN : G;
               if (bid < ng) { SchedIn S{P.ws, ng, bid}; pg8::EpiStore E{P.in[I_BIF], (const float*)(P.ws + WS_XSC), (const float*)(P.ws + WS_WSC)}; pg8::gemm_phase<pg8::EpiStore, SchedIn, true, true, 2>(lds, P.ws, D, S, E); }
               if (slots) conv_pool(P, lds, 0, 0, CV_NBLK_A); });
    PHASE(3, { for (int it = bid; it < 256; it += G) mlstm_pass1(P, lds, it >> 4, it & 15); });
    PHASE(4, { p4_scan(P, G, bid); });
    PHASE(5, { for (int it = bid; it < 256; it += G) { if (it >> 7) mlstm_item<true, 1>(P, lds, it >> 4, it & 15); else mlstm_item<true, 0>(P, lds, it >> 4, it & 15); } });
    PHASE(6, { p6_merge(P, G, bid); });
    PHASE(7, { SchedOut S{P.ws, G, bid}; pg8::EpiX1q E{P.in[I_X], (bf16_t*)(P.ws + WS_X1), (const float*)(P.ws + WS_MODF), (const float*)(P.ws + WS_ASC), (const float*)(P.ws + WS_WOSC)}; pg8::gemm_phase<pg8::EpiX1q, SchedOut, true, true, 2>(lds, P.ws, D, S, E); });
    PHASE(8, { p8_modulate(P, lds, G, bid); });
    PHASE(9, { SchedRouter S{P.ws, G, bid}; pg8::EpiLogits E{P.in[I_BR], (const float*)(P.ws + WS_RSTD), (const float*)(P.ws + WS_CBR)}; pg8::gemm_phase<pg8::EpiLogits, SchedRouter, true, true>(lds, P.ws, 2 * D, S, E);
               if (slots && bid >= 128) conv_pool(P, lds, 1, CV_NBLK_A, CV_NBLK_ALL);
               asm volatile("s_waitcnt vmcnt(0)" ::: "memory"); __syncthreads();
               for (int L = bid; L < 128; L += G) topk_block256(P, lds, L * 256); });
    PHASE(10, { moe_tables(P, lds, 16, G, bid); SchedMoeT<true> S{P.ws, (const LAS int*)(lds + LDS_CTL_OFF + 64), 0}; pg8::EpiAct E{P.in[I_BGU]}; pg8::gemm_phase<pg8::EpiAct, SchedMoeT<true>, true, true, 1>(lds, P.ws, D, S, E); });
    PHASE(11, { moe_tables(P, lds, 8, G, bid); SchedMoe S{P.ws, (const LAS int*)(lds + LDS_CTL_OFF + 64), 1}; pg8::EpiDown E{P.in[I_BDN], (unsigned char*)(P.ws + WS_YS)}; pg8::gemm_phase<pg8::EpiDown, SchedMoe, true, true, 1>(lds, P.ws, D, S, E); });
    PHASE(12, { p11_final(P, G, bid); });
#undef PHASE
#undef IN
#undef SEAM
}

extern "C" void kernel_launch(void* const* d_in, const int* in_sizes, int n_in, void* d_out, int out_size, void* d_ws, size_t ws_size, hipStream_t stream) {
    static int grid = 0;
    if (grid == 0) {
        if (n_in != 20 || out_size != T * D || ws_size < WS_END) { fprintf(stderr, "kernel_launch: unexpected shapes (n_in %d, out %d, ws %zu < %zu)\n", n_in, out_size, ws_size, (size_t)WS_END); grid = -1; return; }
        int dev = 0, cus = 0, per_cu = 0;
        if (hipGetDevice(&dev) != hipSuccess || hipDeviceGetAttribute(&cus, hipDeviceAttributeMultiprocessorCount, dev) != hipSuccess) { grid = -1; return; }
        if (hipFuncSetAttribute((const void*)hymba_fwd, hipFuncAttributeMaxDynamicSharedMemorySize, LDS_BYTES) != hipSuccess) { fprintf(stderr, "kernel_launch: hipFuncSetAttribute failed\n"); grid = -1; return; }
        if (hipOccupancyMaxActiveBlocksPerMultiprocessor(&per_cu, (const void*)hymba_fwd, 512, LDS_BYTES) != hipSuccess || per_cu < 1) fprintf(stderr, "kernel_launch: occupancy query reports %d\n", per_cu);
        (void)hipGetLastError();
        grid = cus;
    }
    if (grid < 0) return;
    (void)hipMemsetAsync((char*)d_ws + WS_CTL, 0, CTL_ZERO_BYTES, stream);
    Params p{};
    for (int i = 0; i < 20; ++i) p.in[i] = (const float*)d_in[i];
    p.out = (float*)d_out; p.ws = (unsigned char*)d_ws;
#if MK_ONE_LAUNCH
    p.ph_lo = 0; p.ph_hi = NPH;
    hipLaunchKernelGGL(hymba_fwd, dim3(grid), dim3(512), LDS_BYTES, stream, p);
#else
    for (int k = 0; k < NPH; ++k) { p.ph_lo = k; p.ph_hi = k + 1; hipLaunchKernelGGL(hymba_fwd, dim3(grid), dim3(512), LDS_BYTES, stream, p); }
#endif
}
```

```cpp
#include <hip/hip_runtime.h>
#include <cstdio>
#include <cstdint>

#ifndef MK_ONE_LAUNCH
#define MK_ONE_LAUNCH 1
#endif

#define DI __device__ __forceinline__
#define LAS __attribute__((address_space(3)))
typedef unsigned short bf16_t;
typedef short bf16x8 __attribute__((ext_vector_type(8)));
typedef short s16x4 __attribute__((ext_vector_type(4)));
typedef float f32x4 __attribute__((ext_vector_type(4)));
typedef float f32x2 __attribute__((ext_vector_type(2)));
typedef float f32x16 __attribute__((ext_vector_type(16)));
typedef unsigned u32x4 __attribute__((ext_vector_type(4)));
typedef unsigned u32x2 __attribute__((ext_vector_type(2)));
typedef __bf16 bf16x2_t __attribute__((ext_vector_type(2)));

constexpr int LDS_CTL_OFF = 147456;
constexpr int LDS_BYTES = LDS_CTL_OFF + 6144;
extern __shared__ __attribute__((aligned(16))) unsigned char lds_raw[];
DI int lane_id() { int l; asm volatile("v_mbcnt_lo_u32_b32 %0, -1, 0\n\tv_mbcnt_hi_u32_b32 %0, -1, %0" : "=v"(l)); return l; }
DI unsigned hw_wave_slot() { return (unsigned)__builtin_amdgcn_s_getreg((5 << 11) | 4) & 63u; }
DI int wave_in_wg() { return __builtin_amdgcn_readfirstlane(((const LAS int*)((LAS unsigned char*)lds_raw + LDS_CTL_OFF + 1024))[hw_wave_slot()]); }
DI int my_tid() { return wave_in_wg() * 64 + lane_id(); }
DI unsigned pk2(float a, float b) { f32x2 f = {a, b}; bf16x2_t h = __builtin_convertvector(f, bf16x2_t); return __builtin_bit_cast(unsigned, h); }
constexpr float WSCALE = 512.0f, WSCALE_INV = 1.0f / 512.0f;
DI unsigned pk4f8(float a, float b, float c, float d) { int p = __builtin_amdgcn_cvt_pk_fp8_f32(a, b, 0, false); p = __builtin_amdgcn_cvt_pk_fp8_f32(c, d, p, true); return (unsigned)p; }
DI unsigned pk4i8(float a, float b, float c, float d) {
    const int qa = (int)a, qb = (int)b, qc = (int)c, qd = (int)d; return (unsigned)(qa & 255) | ((unsigned)(qb & 255) << 8) | ((unsigned)(qc & 255) << 16) | ((unsigned)qd << 24); }
DI float bf_lo(unsigned w) { return __uint_as_float(w << 16); }
DI float bf_hi(unsigned w) { return __uint_as_float(w & 0xffff0000u); }
DI float bf2f(unsigned short s) { return __uint_as_float(((unsigned)s) << 16); }

constexpr int D = 2048, NB = 2, SEQ = 16384, T = NB * SEQ, CTXL = 256, TC = NB * CTXL, MT = T + TC;
constexpr int P_IN = 6160, GATE_COL0 = 3072, NMOD = 6 * D;
constexpr int NE = 32, TOPK = 4;
constexpr int NCHUNK = SEQ / 128;
constexpr float EPS = 1e-6f;
constexpr int NPH = 13;

constexpr size_t MiB = 1u << 20;
constexpr size_t WS_CTL = 0, CTL_ZERO_BYTES = 1 * MiB;
constexpr size_t WS_MODP = 1 * MiB;
constexpr size_t WS_MODF = WS_MODP + 768 * 1024;
constexpr size_t WS_WIN = 2 * MiB;
constexpr size_t WS_WOUT = 27 * MiB;
constexpr size_t WS_WR = 35 * MiB;
constexpr size_t WS_WGU = 36 * MiB;
constexpr size_t WS_WDN = 292 * MiB;
constexpr size_t WS_XN = 420 * MiB;
constexpr size_t WS_GATES = 550 * MiB;
constexpr size_t WS_XSC = WS_GATES + 3 * MiB;
constexpr size_t WS_WSC = WS_GATES + 3 * MiB + 256 * 1024;
constexpr size_t WS_Q = 554 * MiB;
constexpr size_t WS_K = 586 * MiB;
constexpr size_t WS_VT = 619 * MiB;
constexpr size_t WS_O = 684 * MiB;
constexpr size_t WS_CB = 748 * MiB, WS_CC = 812 * MiB, WS_CX = 876 * MiB;
constexpr size_t WS_TUPC = 940 * MiB;
constexpr size_t WS_TUPN = 972 * MiB;
constexpr size_t WS_ENTC = 973 * MiB;
constexpr size_t WS_ENTN = 1005 * MiB;
constexpr size_t WS_HF = 1006 * MiB, WS_HB = 1070 * MiB;
constexpr size_t WS_A2 = 1134 * MiB;
constexpr size_t WS_XG = 1262 * MiB;
constexpr size_t WS_BGU = WS_XG, WS_BDN = WS_XG + 1 * MiB;
constexpr size_t WS_ACT = 1534 * MiB;
constexpr size_t WS_XN8 = 1806 * MiB;
constexpr size_t WS_X1 = 1870 * MiB;
constexpr size_t WS_LOGITS = 2126 * MiB;
constexpr size_t WS_LIST = 2000 * MiB;
constexpr size_t WS_LISTW = 2004 * MiB;
constexpr size_t WS_YS = 2138 * MiB;
constexpr size_t WS_END = 2394 * MiB;
static_assert(WS_ACT + (size_t)139264 * 2048 <= WS_XN8 && WS_XN8 < ((size_t)1 << 31) && WS_X1 + (size_t)T * D * 2 <= WS_LIST && WS_LISTW + 4 * MiB <= ((size_t)1 << 31), "GEMM operands and token lists below 2 GiB");
constexpr int CW_BAR = 4096;
constexpr int CW_GCNT = 16384;
constexpr size_t WS_WOSC = WS_WSC + 32768, WS_ASC = WS_WSC + 262144;
constexpr size_t WS_WR2 = WS_XG + 4 * MiB, WS_RSTD = WS_XG + 8 * MiB, WS_CBR = WS_XG + 9 * MiB;
constexpr int CW_POOL = 20480;


#define XB_TMO      128
#define XB_XCNT(j)  (256  + 64 * (j))
#define XB_XSUB(j)  (1280 + 64 * (j))
#define XB_XGEN(j)  (2304 + 64 * (j))
#define XB_TOP      3328
#define XB_TOPGEN   3392
#define XCD_BAR_WORDS 3456
#define XB_SPIN_CAP (1u << 21)
__device__ __forceinline__ unsigned xb_ld(unsigned* p)              { return __hip_atomic_load(p, __ATOMIC_RELAXED, __HIP_MEMORY_SCOPE_AGENT); }
__device__ __forceinline__ unsigned xb_add(unsigned* p, unsigned v) { return __hip_atomic_fetch_add(p, v, __ATOMIC_RELAXED, __HIP_MEMORY_SCOPE_AGENT); }
__device__ __forceinline__ unsigned xb_xcc_id() { return (unsigned)__builtin_amdgcn_s_getreg((3 << 11) | 20) & 0xFu; }
#define XB_SPIN(cond, bar) do { unsigned _sp = 0; while (cond) { __builtin_amdgcn_s_sleep(1); \
    if ((++_sp & 255u) == 0u) { if (xb_ld(&(bar)[XB_TMO])) break; if (_sp > XB_SPIN_CAP) { atomicAdd(&(bar)[XB_TMO], 1u); break; } } } } while (0)
struct XcdBarrier { unsigned* bar; unsigned x; volatile LAS unsigned* st; };
__device__ __forceinline__ XcdBarrier xcd_barrier_post(unsigned* bar, volatile LAS unsigned* st) {
    XcdBarrier b; b.bar = bar; b.x = xb_xcc_id(); b.st = st;
    if (my_tid() == 0) (void)xb_add(&bar[XB_XCNT(b.x)], 1u);
    return b;
}
__device__ __forceinline__ void xcd_barrier_complete(unsigned* bar, unsigned x, unsigned& nloc, unsigned& nx) {
    const unsigned G = gridDim.x * gridDim.y * gridDim.z;
    unsigned sum, cnt, mine, sp = 0u;
    for (;;) {
        sum = 0u; cnt = 0u; mine = 0u;
#pragma unroll
        for (unsigned j = 0; j < 16; ++j) { const unsigned c = xb_ld(&bar[XB_XCNT(j)]); sum += c; cnt += (c > 0u) ? 1u : 0u; mine = (j == x) ? c : mine; }
        if (sum == G) break;
        __builtin_amdgcn_s_sleep(1);
        if ((++sp & 255u) == 0u) { if (xb_ld(&bar[XB_TMO])) break; if (sp > XB_SPIN_CAP) { atomicAdd(&bar[XB_TMO], 1u); break; } }
    }
    nloc = mine > 0u ? mine : 1u; nx = cnt > 0u ? cnt : 1u;
}
__device__ __forceinline__ void xcd_barrier(const XcdBarrier& b) {
    asm volatile("s_waitcnt vmcnt(0)" ::: "memory");
    __syncthreads();
    if (my_tid() == 0) {
        unsigned* bar = b.bar;
        __builtin_amdgcn_s_waitcnt(0);
        unsigned nloc = b.st[0], nx = b.st[1];
        if (nloc == 0u) { xcd_barrier_complete(bar, b.x, nloc, nx); b.st[0] = nloc; b.st[1] = nx; }
        const unsigned old = xb_add(&bar[XB_XSUB(b.x)], 1u);
        const unsigned gen = old / nloc;
        if (old + 1u == (gen + 1u) * nloc) {
            __builtin_amdgcn_fence(__ATOMIC_RELEASE, "agent");
            asm volatile("s_waitcnt vmcnt(0)" ::: "memory");
            const unsigned og = xb_add(&bar[XB_TOP], 1u);
            const unsigned tg = og / nx;
            if (og + 1u == (tg + 1u) * nx) xb_add(&bar[XB_TOPGEN], 1u);
            else XB_SPIN(xb_ld(&bar[XB_TOPGEN]) == tg, bar);
            __builtin_amdgcn_fence(__ATOMIC_ACQUIRE, "agent");
            xb_add(&bar[XB_XGEN(b.x)], 1u);
            asm volatile("s_waitcnt vmcnt(0)" ::: "memory");
        } else {
            XB_SPIN(xb_ld(&bar[XB_XGEN(b.x)]) == gen, bar);
            __builtin_amdgcn_fence(__ATOMIC_ACQUIRE, "agent");
            asm volatile("s_waitcnt vmcnt(0)" ::: "memory");
        }
    }
    __syncthreads();
}

namespace pg8 {
constexpr int BM = 256, BK = 64, HALF = 128, HTB = HALF * BK * 2, STAGE_BYTES = 8 * HTB, NXCD = 8, WGM = 8;
__host__ __device__ __forceinline__ int lds_byte(int r, int c) { const int st = (r >> 4) * 2 + (c >> 5), rr = r & 15, cc = c & 31, ob = rr * 64 + cc * 2; return st * 1024 + (ob ^ (((ob >> 9) & 1) << 5)); }
__host__ __device__ __forceinline__ void stage_rc(int b, int& R, int& C) { const int st = b / 1024, sb = b % 1024, swz = sb ^ (((sb >> 9) & 1) << 5); R = (st >> 1) * 16 + swz / 64; C = (st & 1) * 32 + (swz % 64) / 2; }
__host__ __device__ __forceinline__ int perm32(int rho) { const int n = rho >> 4, i = rho & 15; return 8 * (i >> 2) + 4 * n + (i & 3); }

struct Unit { unsigned A; unsigned B; char* O; int ldc; int a0; int a1; int buf; };

__device__ __forceinline__ void tile_order(int wgid, int nwg, int nM, int nN, int& pm, int& pn) {
    const int nig = WGM * nN, gid = wgid / nig, fm = gid * WGM, gsz = (nM - fm) < WGM ? (nM - fm) : WGM;
    pm = fm + ((wgid % nig) % gsz); pn = (wgid % nig) / gsz;
}
__device__ __forceinline__ int xcd_remap(int L, int nwg) { const int q = nwg / NXCD, r = nwg % NXCD, xcd = L % NXCD, off = L / NXCD; return (xcd < r ? xcd * (q + 1) : r * (q + 1) + (xcd - r) * q) + off; }

typedef int i32x4_t __attribute__((ext_vector_type(4)));
typedef int i32x8_t __attribute__((ext_vector_type(8)));
__device__ __forceinline__ i32x8_t cat8(bf16x8 a, bf16x8 b) { return __builtin_shufflevector(__builtin_bit_cast(i32x4_t, a), __builtin_bit_cast(i32x4_t, b), 0, 1, 2, 3, 4, 5, 6, 7); }
template <class Epi, class Sched, bool ALIGN_EPI, bool SP2, int DT = 0  >
__device__ __forceinline__ void gemm_phase(LAS unsigned char* lds, const void* wsbase, const int KB, const Sched& S, const Epi& E) {
    constexpr bool F8 = (DT == 1), I8 = (DT == 2);
    const __amdgpu_buffer_rsrc_t rsrc = __builtin_amdgcn_make_buffer_rsrc((void*)wsbase, 0, -1, 0x00020000);
    const int tid = my_tid(), wid = __builtin_amdgcn_readfirstlane(tid >> 6), lane = tid & 63, wr = wid >> 2, wc = wid & 3, fr = lane & 15, fq = lane >> 4;
    const int nt = KB / 128;
    unsigned voffA[2], voffB[2];
#pragma unroll
    for (int i = 0; i < 2; ++i) { int R, C;
        { const int b = tid * 16 + i * 8192; const int p = (b >> 7) & 15, fr_ = ((p & 1) << 3) | (p >> 1); R = (b >> 11) * 16 + fr_; C = ((((b >> 4) & 7) ^ (fr_ & 7))) * 16; }
        const int Rb = Epi::PERM ? ((R & ~31) + perm32(R & 31)) : R;
        voffA[i] = (unsigned)(R * KB + C); voffB[i] = (unsigned)(Rb * KB + C); }
    constexpr bool GATHER = Sched::GATHER;
    unsigned vG[2][2];
    auto load_rows = [&](int buf, int nvalid) { const int t_ = (wid << 6) | lane_id();
#pragma unroll
        for (int i = 0; i < 2; ++i) { const int b = t_ * 16 + i * 8192; const int p = (b >> 7) & 15, fr_ = ((p & 1) << 3) | (p >> 1); const int R = (b >> 11) * 16 + fr_, C = ((((b >> 4) & 7) ^ (fr_ & 7))) * 16;
#pragma unroll
            for (int hh_ = 0; hh_ < 2; ++hh_) { const int rr = hh_ * 128 + R; const unsigned slot = ((const LAS unsigned*)(lds + LDS_CTL_OFF + 2048))[buf * 256 + rr];
                vG[hh_][i] = (rr < nvalid ? (slot >> 2) * (unsigned)KB : 0u) + (unsigned)C; } } };
    constexpr bool ETAB = Sched::ETAB;
    auto dma_etab = [&](const Unit& u_, int buf) {
        if constexpr (ETAB) { if ((wid & ~1) == 4) __builtin_amdgcn_raw_ptr_buffer_load_lds(rsrc, (LAS void*)(lds + LDS_CTL_OFF + 2048 + (wid - 4) * 2048 + buf * 1024), 16, lane_id() * 16, (int)S.etab_off(u_, wid - 4), 0, 0); } };
    constexpr bool BIAS = Sched::BIAS;
    auto dma_bias = [&](const Unit& u_, int buf) {
        if constexpr (BIAS) { if ((wid == 6 || wid == 7) && lane_id() < 32) __builtin_amdgcn_raw_ptr_buffer_load_lds(rsrc, (LAS void*)(lds + LDS_CTL_OFF + 4096 + buf * 1024 + (wid - 6) * 512), 16, lane_id() * 16, (int)S.bias_off(u_, wid - 6), 0, 0); } };
    auto dma_list = [&](unsigned goff, int buf) {
        if (wid == 4) __builtin_amdgcn_raw_ptr_buffer_load_lds(rsrc, (LAS void*)(lds + LDS_CTL_OFF + 2048 + buf * 1024), 16, lane_id() * 16, (int)goff, 0, 0); };
    const unsigned kstep = 128u;
    const unsigned hstep = (unsigned)(HALF * KB);
    const unsigned ldsw = (unsigned)wid * 1024u;
    int aoff[2], boff[2];
#pragma unroll
    for (int x = 0; x < 2; ++x) { const int ch = F8 ? (2 * fq + x) : (fq + 4 * x); const int o = ((((fr & 7) << 1) | (fr >> 3)) << 7) + ((ch ^ (fr & 7)) << 4); aoff[x] = wr * 8192 + o; boff[x] = wc * 4096 + o; }
#define PG8_SA(b, h) (((b) * 2 + (h)) * HTB)
#define PG8_SB(b, h) ((4 + (b) * 2 + (h)) * HTB)
#define PG8_STAGE(bufoff, gbase, voff) do { _Pragma("unroll") for (int _i = 0; _i < 2; ++_i) \
        __builtin_amdgcn_raw_ptr_buffer_load_lds(rsrc, (LAS void*)(lds + (bufoff) + ldsw + _i * 8192), 16, (int)(voff)[_i], (int)(gbase), 0, 0); } while (0)
#define PG8_STAGE_A(bufoff, h, goff) do { if constexpr (GATHER) { PG8_STAGE(bufoff, goff, vG[h]); } else { PG8_STAGE(bufoff, (goff) + (h) * hstep, voffA); } } while (0)
#define PG8_LDA(dst, b, h) do { _Pragma("unroll") for (int m = 0; m < 4; ++m) { \
        if constexpr (F8) dst##8[m] = cat8(*(const LAS bf16x8*)(lds + PG8_SA(b, h) + aoff[0] + m * 2048), *(const LAS bf16x8*)(lds + PG8_SA(b, h) + aoff[1] + m * 2048)); \
        else { _Pragma("unroll") for (int k = 0; k < 2; ++k) dst[m][k] = *(const LAS bf16x8*)(lds + PG8_SA(b, h) + aoff[k] + m * 2048); } } } while (0)
#define PG8_LDB(dst, b, h) do { _Pragma("unroll") for (int n = 0; n < 2; ++n) { \
        if constexpr (F8) dst##8[n] = cat8(*(const LAS bf16x8*)(lds + PG8_SB(b, h) + boff[0] + n * 2048), *(const LAS bf16x8*)(lds + PG8_SB(b, h) + boff[1] + n * 2048)); \
        else { _Pragma("unroll") for (int k = 0; k < 2; ++k) dst[n][k] = *(const LAS bf16x8*)(lds + PG8_SB(b, h) + boff[k] + n * 2048); } } } while (0)
#define PG8_MMA(ai, bj, At, Bt) do { __builtin_amdgcn_s_setprio(1); _Pragma("unroll") for (int m = 0; m < 4; ++m) _Pragma("unroll") for (int n = 0; n < 2; ++n) { \
        if constexpr (F8) { acc[ai][bj][m][n] = __builtin_amdgcn_mfma_scale_f32_16x16x128_f8f6f4(Bt##8[n], At##8[m], acc[ai][bj][m][n], 0, 0, 0, 0, 0, 0); }     \
        else if constexpr (I8) { _Pragma("unroll") for (int k = 0; k < 2; ++k) acc[ai][bj][m][n] = __builtin_bit_cast(f32x4, __builtin_amdgcn_mfma_i32_16x16x64_i8(__builtin_bit_cast(i32x4_t, Bt[n][k]), __builtin_bit_cast(i32x4_t, At[m][k]), __builtin_bit_cast(i32x4_t, acc[ai][bj][m][n]), 0, 0, 0)); } \
        else { _Pragma("unroll") for (int k = 0; k < 2; ++k) acc[ai][bj][m][n] = __builtin_amdgcn_mfma_f32_16x16x32_bf16(Bt[n][k], At[m][k], acc[ai][bj][m][n], 0, 0, 0); } } \
        __builtin_amdgcn_s_setprio(0); } while (0)
#define PG8_WAIT_V(n) asm volatile("s_waitcnt vmcnt(" #n ")" ::: "memory")
#define PG8_WAIT_L(n) asm volatile("s_waitcnt lgkmcnt(" #n ")" ::: "memory")
#define PG8_BAR __builtin_amdgcn_s_barrier()
#define PG8_SCHED __builtin_amdgcn_sched_barrier(0)
    Unit cur, nxt; int ui = 0;
    if (!S.next(0, cur)) return;
    f32x4 acc[2][2][4][2];
#pragma unroll
    for (int a = 0; a < 2; ++a)
#pragma unroll
        for (int b = 0; b < 2; ++b)
#pragma unroll
            for (int m = 0; m < 4; ++m)
#pragma unroll
                for (int n = 0; n < 2; ++n) acc[a][b][m][n] = (f32x4){0.f, 0.f, 0.f, 0.f};
    bf16x8 At[4][2], B0[2][2], B1[2][2]; i32x8_t At8[4], B08[2], B18[2];
    unsigned cA = cur.A, cB = cur.B;
    if constexpr (BIAS) { dma_bias(cur, 0); }
    if constexpr (ETAB) { dma_etab(cur, 0); asm volatile("s_waitcnt vmcnt(0)" ::: "memory"); __builtin_amdgcn_s_barrier(); }
    if constexpr (GATHER) { dma_list(S.list_off(cur), 0); asm volatile("s_waitcnt vmcnt(0)" ::: "memory"); __builtin_amdgcn_s_barrier(); load_rows(0, S.row_cnt(cur)); }
    if constexpr (SP2) {
        PG8_STAGE(PG8_SB(0, 0), cB, voffB); PG8_STAGE(PG8_SB(0, 1), cB + hstep, voffB); PG8_STAGE_A(PG8_SA(0, 0), 0, cA); PG8_STAGE_A(PG8_SA(0, 1), 1, cA);
        if (wr == 1) PG8_BAR;
        PG8_WAIT_V(2); PG8_BAR;
        PG8_STAGE(PG8_SB(1, 0), cB + kstep, voffB); PG8_STAGE_A(PG8_SA(1, 0), 0, cA + kstep); PG8_STAGE(PG8_SB(1, 1), cB + hstep + kstep, voffB);
        PG8_WAIT_V(6); PG8_BAR;
    } else {
        PG8_STAGE(PG8_SB(0, 0), cB, voffB); PG8_STAGE(PG8_SA(0, 0), cA, voffA); PG8_STAGE(PG8_SB(0, 1), cB + hstep, voffB); PG8_STAGE(PG8_SA(0, 1), cA + hstep, voffA);
        if (wr == 1) PG8_BAR;
        PG8_WAIT_V(4); PG8_BAR;
        PG8_STAGE(PG8_SB(1, 0), cB + kstep, voffB); PG8_STAGE(PG8_SA(1, 0), cA + kstep, voffA); PG8_STAGE(PG8_SB(1, 1), cB + hstep + kstep, voffB);
        PG8_WAIT_V(6); PG8_BAR;
    }
    for (;;) {
        const bool has_next = S.next(ui + 1, nxt);
        if constexpr (GATHER) { if (has_next) dma_list(S.list_off(nxt), (ui + 1) & 1); }
        if constexpr (ETAB) { if (has_next) dma_etab(nxt, (ui + 1) & 1); }
        if constexpr (BIAS) { if (has_next) dma_bias(nxt, (ui + 1) & 1); }
        const unsigned nA = has_next ? nxt.A : cA, nB = has_next ? nxt.B : cB;
        for (int t = 0; t < nt; t += 2) {
            const bool last = (t == nt - 2);
            const unsigned a1 = cA + (unsigned)(t + 1) * kstep;
            const unsigned a2 = last ? nA : cA + (unsigned)(t + 2) * kstep, b2 = last ? nB : cB + (unsigned)(t + 2) * kstep;
            const unsigned a3 = a2 + kstep, b3 = b2 + kstep;
            if constexpr (SP2) {
            PG8_LDB(B0, 0, 0); PG8_LDB(B1, 0, 1); PG8_SCHED; PG8_LDA(At, 0, 0); PG8_STAGE_A(PG8_SA(1, 1), 1, a1);
            if constexpr (GATHER) { if (last && has_next) load_rows((ui + 1) & 1, S.row_cnt(nxt)); }
            PG8_WAIT_V(8); PG8_WAIT_L(0); PG8_BAR; PG8_MMA(0, 0, At, B0); PG8_MMA(0, 1, At, B1); PG8_BAR; PG8_SCHED;
            PG8_LDA(At, 0, 1); PG8_STAGE(PG8_SB(0, 0), b2, voffB); PG8_STAGE(PG8_SB(0, 1), b2 + hstep, voffB); PG8_STAGE_A(PG8_SA(0, 0), 0, a2);
            PG8_WAIT_V(8); PG8_WAIT_L(0); PG8_BAR; PG8_MMA(1, 0, At, B0); PG8_MMA(1, 1, At, B1); PG8_BAR; PG8_SCHED;
            PG8_LDB(B0, 1, 0); PG8_LDB(B1, 1, 1); PG8_SCHED; PG8_LDA(At, 1, 0); PG8_STAGE_A(PG8_SA(0, 1), 1, a2);
            PG8_WAIT_V(8); PG8_WAIT_L(0); PG8_BAR; PG8_MMA(0, 0, At, B0); PG8_MMA(0, 1, At, B1); PG8_BAR; PG8_SCHED;
            PG8_LDA(At, 1, 1); PG8_STAGE(PG8_SB(1, 0), b3, voffB); PG8_STAGE(PG8_SB(1, 1), b3 + hstep, voffB); PG8_STAGE_A(PG8_SA(1, 0), 0, a3);
            PG8_WAIT_V(8); PG8_WAIT_L(0); PG8_BAR; PG8_MMA(1, 0, At, B0); PG8_MMA(1, 1, At, B1); PG8_BAR; PG8_SCHED;
            } else {
            PG8_LDB(B0, 0, 0); PG8_SCHED; PG8_LDA(At, 0, 0); PG8_STAGE(PG8_SA(1, 1), a1 + hstep, voffA);
            PG8_WAIT_L(8); PG8_BAR; PG8_WAIT_L(0); PG8_MMA(0, 0, At, B0); PG8_BAR; PG8_SCHED;
            PG8_LDB(B1, 0, 1); PG8_STAGE(PG8_SB(0, 0), b2, voffB);
            PG8_BAR; PG8_WAIT_L(0); PG8_MMA(0, 1, At, B1); PG8_BAR;
            PG8_LDA(At, 0, 1); PG8_STAGE(PG8_SA(0, 0), a2, voffA);
            PG8_BAR; PG8_WAIT_L(0); PG8_MMA(1, 0, At, B0); PG8_BAR; PG8_SCHED;
            PG8_STAGE(PG8_SB(0, 1), b2 + hstep, voffB);
            PG8_WAIT_V(6); PG8_BAR; PG8_MMA(1, 1, At, B1); PG8_BAR;
            PG8_LDB(B0, 1, 0); PG8_SCHED; PG8_LDA(At, 1, 0); PG8_STAGE(PG8_SA(0, 1), a2 + hstep, voffA);
            PG8_WAIT_L(8); PG8_BAR; PG8_WAIT_L(0); PG8_MMA(0, 0, At, B0); PG8_BAR; PG8_SCHED;
            PG8_LDB(B1, 1, 1); PG8_STAGE(PG8_SB(1, 0), b3, voffB);
            PG8_BAR; PG8_WAIT_L(0); PG8_MMA(0, 1, At, B1); PG8_BAR;
            PG8_LDA(At, 1, 1); PG8_STAGE(PG8_SA(1, 0), a3, voffA);
            PG8_BAR; PG8_WAIT_L(0); PG8_MMA(1, 0, At, B0); PG8_BAR; PG8_SCHED;
            PG8_STAGE(PG8_SB(1, 1), b3 + hstep, voffB);
            PG8_WAIT_V(6); PG8_BAR; PG8_MMA(1, 1, At, B1); PG8_BAR;
            }
        }
        if constexpr (ALIGN_EPI) { if (wr == 0) PG8_BAR; }
        { int l2 = lane_id(); asm volatile("" : "+v"(l2)); cur.buf = ui & 1; E(acc, cur, wr, wc, l2 & 15, l2 >> 4); }
        if (!has_next) break;
#pragma unroll
        for (int a = 0; a < 2; ++a)
#pragma unroll
            for (int b = 0; b < 2; ++b)
#pragma unroll
                for (int m = 0; m < 4; ++m)
#pragma unroll
                    for (int n = 0; n < 2; ++n) acc[a][b][m][n] = (f32x4){0.f, 0.f, 0.f, 0.f};
        cur = nxt; cA = nA; cB = nB; ++ui;
        if constexpr (ALIGN_EPI) { if (wr == 1) PG8_BAR; }
    }
    PG8_WAIT_V(0);
    if constexpr (!ALIGN_EPI) { if (wr == 0) PG8_BAR; }
    PG8_BAR;
#undef PG8_SA
#undef PG8_SB
#undef PG8_STAGE
#undef PG8_LDA
#undef PG8_STAGE_A
#undef PG8_LDB
#undef PG8_MMA
#undef PG8_WAIT_V
#undef PG8_WAIT_L
#undef PG8_BAR
#undef PG8_SCHED
}

struct EpiStore {
    static constexpr bool PERM = true;
    const float* bif; const float* xsc; const float* wsc;
    __device__ __forceinline__ void operator()(const f32x4 (&acc)[2][2][4][2], const Unit& u, int wr, int wc, int fr, int fq) const {
        const bool swapped = (u.a1 >= 4 && u.a1 < 8);
        const float* sA = swapped ? wsc + u.a1 * BM : xsc + u.a0 * BM; const float* sB = swapped ? xsc + u.a0 * BM : wsc + u.a1 * BM;
        const int row0 = wr * 64 + fr, col0 = wc * 32 + 8 * fq;
        if (u.ldc == 0) {
            if (wc == 0 && fq < 2) { float* g = (float*)u.O; const f32x4 b0 = *(const f32x4*)(bif + 8 * fq), b1 = *(const f32x4*)(bif + 8 * fq + 4); const f32x4 s0 = *(const f32x4*)(sB + 8 * fq), s1 = *(const f32x4*)(sB + 8 * fq + 4);
#pragma unroll
                for (int ai = 0; ai < 2; ++ai)
#pragma unroll
                    for (int m = 0; m < 4; ++m) { const int r = row0 + ai * HALF + m * 16; const float sr = sA[r]; float* rp = g + (size_t)r * 16 + 8 * fq;
                        const i32x4_t a0 = __builtin_bit_cast(i32x4_t, acc[ai][0][m][0]), a1 = __builtin_bit_cast(i32x4_t, acc[ai][0][m][1]);
                        *(f32x4*)rp = __builtin_convertvector(a0, f32x4) * sr * s0 + b0; *(f32x4*)(rp + 4) = __builtin_convertvector(a1, f32x4) * sr * s1 + b1; } }
            return; }
        bf16_t* base = (bf16_t*)u.O; const int ldc = u.ldc;
        f32x4 sb[2][2];
#pragma unroll
        for (int bj = 0; bj < 2; ++bj)
#pragma unroll
            for (int n = 0; n < 2; ++n) sb[bj][n] = *(const f32x4*)(sB + col0 + bj * HALF + 4 * n);
        if (u.a1 >= 16) {
#pragma unroll
            for (int ai = 0; ai < 2; ++ai)
#pragma unroll
                for (int m = 0; m < 4; ++m) { const int r = row0 + ai * HALF + m * 16; const float sr = sA[r];
                    const f32x4 p0 = (__builtin_convertvector(__builtin_bit_cast(i32x4_t, acc[ai][0][m][0]), f32x4) * sr * sb[0][0]) * (__builtin_convertvector(__builtin_bit_cast(i32x4_t, acc[ai][1][m][0]), f32x4) * sr * sb[1][0]);
                    const f32x4 p1 = (__builtin_convertvector(__builtin_bit_cast(i32x4_t, acc[ai][0][m][1]), f32x4) * sr * sb[0][1]) * (__builtin_convertvector(__builtin_bit_cast(i32x4_t, acc[ai][1][m][1]), f32x4) * sr * sb[1][1]);
                    u32x4 w; w.x = pk2(p0[0], p0[1]); w.y = pk2(p0[2], p0[3]); w.z = pk2(p1[0], p1[1]); w.w = pk2(p1[2], p1[3]);
                    *(u32x4*)(base + (size_t)r * ldc + col0) = w; }
            return; }
#pragma unroll
        for (int ai = 0; ai < 2; ++ai)
#pragma unroll
            for (int m = 0; m < 4; ++m) { const int r = row0 + ai * HALF + m * 16; const float sr = sA[r]; bf16_t* rowp = base + (size_t)r * ldc + col0;
#pragma unroll
                for (int bj = 0; bj < 2; ++bj) { const f32x4 v0 = __builtin_convertvector(__builtin_bit_cast(i32x4_t, acc[ai][bj][m][0]), f32x4) * sr * sb[bj][0], v1 = __builtin_convertvector(__builtin_bit_cast(i32x4_t, acc[ai][bj][m][1]), f32x4) * sr * sb[bj][1];
                    u32x4 w; w.x = pk2(v0[0], v0[1]); w.y = pk2(v0[2], v0[3]); w.z = pk2(v1[0], v1[1]); w.w = pk2(v1[2], v1[3]);
                    *(u32x4*)(rowp + bj * HALF) = w; } }
    }
};
struct EpiLogits {
    static constexpr bool PERM = true;
    const float* br; const float* rstd; const float* cbr;
    __device__ __forceinline__ void operator()(const f32x4 (&acc)[2][2][4][2], const Unit& u, int wr, int wc, int fr, int fq) const {
        if (wc != 0) return;
        const float* cb = cbr + (u.a0 >= 64 ? 32 : 0);
        float* lg = (float*)u.O; const f32x4 b0 = *(const f32x4*)(br + 8 * fq) + *(const f32x4*)(cb + 8 * fq), b1 = *(const f32x4*)(br + 8 * fq + 4) + *(const f32x4*)(cb + 8 * fq + 4);
#pragma unroll
        for (int ai = 0; ai < 2; ++ai)
#pragma unroll
            for (int m = 0; m < 4; ++m) { const int rl = wr * 64 + fr + ai * HALF + m * 16; const float sr = rstd[u.a0 * BM + rl]; float* rp = lg + (size_t)rl * NE + 8 * fq; *(f32x4*)rp = acc[ai][0][m][0] * sr + b0; *(f32x4*)(rp + 4) = acc[ai][0][m][1] * sr + b1; }
    }
};
struct EpiX1 {
    static constexpr bool PERM = false;
    const float* x; bf16_t* x1; const float* modf;
    __device__ __forceinline__ void operator()(const f32x4 (&acc)[2][2][4][2], const Unit& u, int wr, int wc, int fr, int fq) const {
        const int row0 = u.a0 * BM + wr * 64 + fr, col0 = u.a1 * BM + wc * 32 + 4 * fq;
        const int b = (u.a0 * BM) / SEQ; const float* gt = modf + (size_t)b * NMOD + 2 * D;
        f32x4 gv[2][2];
#pragma unroll
        for (int bj = 0; bj < 2; ++bj)
#pragma unroll
            for (int n = 0; n < 2; ++n) gv[bj][n] = *(const f32x4*)(gt + col0 + bj * HALF + n * 16);
#pragma unroll
        for (int ai = 0; ai < 2; ++ai)
#pragma unroll
            for (int m = 0; m < 4; ++m) { const size_t off = (size_t)(row0 + ai * HALF + m * 16) * D + col0;
#pragma unroll
                for (int bj = 0; bj < 2; ++bj)
#pragma unroll
                    for (int n = 0; n < 2; ++n) { const f32x4 xv = *(const f32x4*)(x + off + bj * HALF + n * 16); const f32x4 r = xv + gv[bj][n] * acc[ai][bj][m][n];
                        u32x2 w; w.x = pk2(r[0], r[1]); w.y = pk2(r[2], r[3]); *(u32x2*)(x1 + off + bj * HALF + n * 16) = w; } }
    }
};
struct EpiX1q {
    static constexpr bool PERM = false;
    const float* x; bf16_t* x1; const float* modf; const float* asc; const float* wosc;
    __device__ __forceinline__ void operator()(const f32x4 (&acc)[2][2][4][2], const Unit& u, int wr, int wc, int fr, int fq) const {
        const int row0 = u.a0 * BM + wr * 64 + fr, col0 = u.a1 * BM + wc * 32 + 4 * fq;
        const int b = (u.a0 * BM) / SEQ; const float* gt = modf + (size_t)b * NMOD + 2 * D;
        f32x4 gv[2][2];
#pragma unroll
        for (int bj = 0; bj < 2; ++bj)
#pragma unroll
            for (int n = 0; n < 2; ++n) gv[bj][n] = *(const f32x4*)(gt + col0 + bj * HALF + n * 16) * *(const f32x4*)(wosc + col0 + bj * HALF + n * 16);
#pragma unroll
        for (int ai = 0; ai < 2; ++ai)
#pragma unroll
            for (int m = 0; m < 4; ++m) { const int row = row0 + ai * HALF + m * 16; const float sr = asc[row]; const size_t off = (size_t)row * D + col0;
#pragma unroll
                for (int bj = 0; bj < 2; ++bj)
#pragma unroll
                    for (int n = 0; n < 2; ++n) { const f32x4 xv = *(const f32x4*)(x + off + bj * HALF + n * 16); const f32x4 r = xv + gv[bj][n] * (__builtin_convertvector(__builtin_bit_cast(i32x4_t, acc[ai][bj][m][n]), f32x4) * sr);
                        u32x2 w; w.x = pk2(r[0], r[1]); w.y = pk2(r[2], r[3]); *(u32x2*)(x1 + off + bj * HALF + n * 16) = w; } }
    }
};
struct EpiAct {
    static constexpr bool PERM = true;
    const float* bgu;
    __device__ __forceinline__ void operator()(const f32x4 (&acc)[2][2][4][2], const Unit& u, int wr, int wc, int fr, int fq) const {
        unsigned char* base = (unsigned char*)u.O; const int acol = u.a1 * 128 + wc * 32 + 8 * fq;
        const LAS float* bt = (const LAS float*)((LAS unsigned char*)lds_raw + LDS_CTL_OFF + 4096 + u.buf * 1024) + wc * 32 + 8 * fq;
        const int row0 = wr * 64 + fr;
        f32x4 bgv[2], buv[2];
#pragma unroll
        for (int n = 0; n < 2; ++n) { bgv[n] = *(const LAS f32x4*)(bt + 4 * n); buv[n] = *(const LAS f32x4*)(bt + 128 + 4 * n); }
#pragma unroll
        for (int ai = 0; ai < 2; ++ai)
#pragma unroll
            for (int m = 0; m < 4; ++m) {
                float o[8];
#pragma unroll
                for (int n = 0; n < 2; ++n) { const f32x4 g4 = acc[ai][0][m][n] * WSCALE_INV + bgv[n], u4 = acc[ai][1][m][n] * WSCALE_INV + buv[n];
#pragma unroll
                    for (int e = 0; e < 4; e += 2) {
                        f32x2 g = {fminf(g4[e], 7.0f), fminf(g4[e + 1], 7.0f)}; const f32x2 up = {fminf(fmaxf(u4[e], -7.0f), 7.0f), fminf(fmaxf(u4[e + 1], -7.0f), 7.0f)};
                        const f32x2 z = g * (-2.4554669595930157f); f32x2 ex; ex.x = __builtin_amdgcn_exp2f(z.x); ex.y = __builtin_amdgcn_exp2f(z.y);
                        const f32x2 den = ex + 1.0f; f32x2 sg; sg.x = __builtin_amdgcn_rcpf(den.x); sg.y = __builtin_amdgcn_rcpf(den.y);
                        const f32x2 r = (up + 1.0f) * g * sg; o[4 * n + e] = r.x; o[4 * n + e + 1] = r.y; } }
                u32x2 w; w.x = pk4f8(o[0], o[1], o[2], o[3]); w.y = pk4f8(o[4], o[5], o[6], o[7]);
                *(u32x2*)(base + (size_t)(row0 + ai * HALF + m * 16) * 2048 + acol) = w; __builtin_amdgcn_sched_barrier(0); }
    }
};
struct EpiDown {
    static constexpr bool PERM = true;
    const float* bdn; unsigned char* ys;
    __device__ __forceinline__ void operator()(const f32x4 (&acc)[2][2][4][2], const Unit& u, int wr, int wc, int fr, int fq) const {
        const LAS int* slots = (const LAS int*)((LAS unsigned char*)lds_raw + LDS_CTL_OFF + 2048 + u.buf * 1024); const LAS float* wts = (const LAS float*)((LAS unsigned char*)lds_raw + LDS_CTL_OFF + 4096 + u.buf * 1024); const int valid = u.ldc;
        const int col0 = u.a1 * BM + wc * 32 + 8 * fq; const float* bp = bdn + (size_t)u.a0 * D + col0;
        f32x4 bv[2][2];
#pragma unroll
        for (int bj = 0; bj < 2; ++bj)
#pragma unroll
            for (int n = 0; n < 2; ++n) bv[bj][n] = *(const f32x4*)(bp + bj * HALF + 4 * n);
        const int row0 = wr * 64 + fr;
#pragma unroll
        for (int ai = 0; ai < 2; ++ai)
#pragma unroll
            for (int m = 0; m < 4; ++m) { const int r = row0 + ai * HALF + m * 16;
                if (r < valid) { const int slot = slots[r]; const float w = wts[r]; unsigned char* rowp = ys + (size_t)slot * D + col0;
#pragma unroll
                    for (int bj = 0; bj < 2; ++bj) { const f32x4 v0 = (acc[ai][bj][m][0] * WSCALE_INV + bv[bj][0]) * w, v1 = (acc[ai][bj][m][1] * WSCALE_INV + bv[bj][1]) * w;
                        u32x2 o; o.x = pk4f8(v0[0], v0[1], v0[2], v0[3]); o.y = pk4f8(v1[0], v1[1], v1[2], v1[3]);
                        *(u32x2*)(rowp + bj * HALF) = o; } } }
    }
};
}

struct Params { const float* in[20]; float* out; unsigned char* ws; int ph_lo, ph_hi; };
enum { I_X = 0, I_C, I_CTX, I_CCTX, I_WADA, I_BADA, I_GMIX, I_WIN, I_BIF, I_CONVW, I_NORMG, I_WOUT, I_GFFN, I_WR, I_BR, I_WGU, I_BGU, I_WDN, I_BDN, I_GFIN };

template <int CTRL, int ROWMASK> DI float dpp_f(float v) { return __builtin_bit_cast(float, __builtin_amdgcn_update_dpp(0, __builtin_bit_cast(int, v), CTRL, ROWMASK, 0xF, false)); }
DI float row16_sum(float v) {
    v += dpp_f<0xB1, 0xF>(v); v += dpp_f<0x4E, 0xF>(v); v += dpp_f<0x124, 0xF>(v); v += dpp_f<0x128, 0xF>(v); return v; }
DI float wave_sum(float v) {
    v = row16_sum(v);
    v += dpp_f<0x142, 0xA>(v); v += dpp_f<0x143, 0xC>(v);
    return __builtin_bit_cast(float, __builtin_amdgcn_readlane(__builtin_bit_cast(int, v), 63));
}
DI float wave_max(float v) {
    v = fmaxf(v, dpp_f<0xB1, 0xF>(v)); v = fmaxf(v, dpp_f<0x4E, 0xF>(v)); v = fmaxf(v, dpp_f<0x124, 0xF>(v)); v = fmaxf(v, dpp_f<0x128, 0xF>(v));
    v = fmaxf(v, dpp_f<0x142, 0xA>(v)); v = fmaxf(v, dpp_f<0x143, 0xC>(v));
    return __builtin_bit_cast(float, __builtin_amdgcn_readlane(__builtin_bit_cast(int, v), 63));
}
DI float silu(float x) { return x / (1.0f + __expf(-x)); }

DI void p0_adaln(const Params& P, LAS unsigned char* lds, int G, int bid) {
    const int tid = my_tid(), wid = __builtin_amdgcn_readfirstlane(tid >> 6), lane = tid & 63;
    LAS float* sc = (LAS float*)lds;
    LAS float* red = (LAS float*)(lds + 8192);
    const float* w_ada = P.in[I_WADA];
    float* modp = (float*)(P.ws + WS_MODP);
    for (int it = bid; it < 48 * 4; it += G) {
        const int nb = it % 48, ks = it / 48;
        __syncthreads();
        for (int i = tid; i < 3 * 512; i += 512) { const int r = i / 512, k = i % 512; const float cv = (r < 2) ? P.in[I_C][r * D + ks * 512 + k] : P.in[I_CCTX][ks * 512 + k]; sc[i] = silu(cv); }
        __syncthreads();
        f32x4 a0 = {0, 0, 0, 0}, a1 = a0, a2 = a0;
        const float* wp = w_ada + (size_t)(ks * 512 + wid * 64) * NMOD + nb * 256 + lane * 4;
#pragma unroll 8
        for (int k = 0; k < 64; ++k) { const f32x4 w = *(const f32x4*)(wp + (size_t)k * NMOD); const int kk = wid * 64 + k;
            a0 += w * sc[kk]; a1 += w * sc[512 + kk]; a2 += w * sc[1024 + kk]; }
        *(LAS f32x4*)(red + (wid * 3 + 0) * 256 + lane * 4) = a0; *(LAS f32x4*)(red + (wid * 3 + 1) * 256 + lane * 4) = a1; *(LAS f32x4*)(red + (wid * 3 + 2) * 256 + lane * 4) = a2;
        __syncthreads();
        for (int i = tid; i < 768; i += 512) { const int r = i / 256, c = i % 256; float s = 0.f;
#pragma unroll
            for (int w = 0; w < 8; ++w) s += red[(w * 3 + r) * 256 + c];
            modp[((size_t)ks * 3 + r) * NMOD + nb * 256 + c] = s; }
    }
    __syncthreads();
}
DI void p0_transpose_item(const float* W, int K, int N, bf16_t* WT, int kind, LAS float* scr, int item, int lane) {
    const int nblk = (N + 31) / 32, kb = item / nblk, nb = item % nblk, k0 = 64 * kb, n0 = 32 * nb;
    { const int c4 = (lane & 7) * 4, r8 = lane >> 3; const bool okc = (n0 + c4) < N;
      f32x4 v[8];
#pragma unroll
      for (int i = 0; i < 8; ++i) v[i] = okc ? *(const f32x4*)(W + (size_t)(k0 + 8 * i + r8) * N + n0 + c4) : (f32x4){0.f, 0.f, 0.f, 0.f};
#pragma unroll
      for (int i = 0; i < 8; ++i) { LAS float* d = scr + (8 * i + r8) * 33 + c4; d[0] = v[i][0]; d[1] = v[i][1]; d[2] = v[i][2]; d[3] = v[i][3]; } }
    asm volatile("s_waitcnt lgkmcnt(0)" ::: "memory");
    const int c = lane & 7;
#pragma unroll
    for (int j = 0; j < 4; ++j) { const int n = (lane >> 3) + 8 * j; const int src = n0 + n; int dst = src; float scale = 1.0f;
        if (kind == 0) { if (src < 512) scale = 0.08838834764831845f; if (src >= GATE_COL0) dst = (src < GATE_COL0 + 16 || src >= P_IN) ? -1 : src - 16; }
        else if (kind == 2) { const int jj = src & 2047; dst = (jj >> 7) * 256 + (src >> 11) * 128 + (jj & 127); }
        const LAS float* s = scr + (8 * c) * 33 + n;
        u32x4 o; o.x = pk2(s[0 * 33] * scale, s[1 * 33] * scale); o.y = pk2(s[2 * 33] * scale, s[3 * 33] * scale); o.z = pk2(s[4 * 33] * scale, s[5 * 33] * scale); o.w = pk2(s[6 * 33] * scale, s[7 * 33] * scale);
        if (dst >= 0) *(u32x4*)(WT + (size_t)dst * K + k0 + 8 * c) = o; }
    asm volatile("s_waitcnt lgkmcnt(0)" ::: "memory");
}
DI void p0_transpose_item8(const float* W, int N, unsigned char* WT, int kind, LAS float* scr, int item, int lane) {
    const int nblk = N / 32, kb = item / nblk, nb = item % nblk, k0 = 128 * kb, n0 = 32 * nb;
    { const int c4 = (lane & 7) * 4, r8 = lane >> 3;
      f32x4 v[16];
#pragma unroll
      for (int i = 0; i < 16; ++i) v[i] = *(const f32x4*)(W + (size_t)(k0 + 8 * i + r8) * N + n0 + c4);
#pragma unroll
      for (int i = 0; i < 16; ++i) { LAS float* d = scr + (8 * i + r8) * 33 + c4; d[0] = v[i][0]; d[1] = v[i][1]; d[2] = v[i][2]; d[3] = v[i][3]; } }
    asm volatile("s_waitcnt lgkmcnt(0)" ::: "memory");
    const int c = lane & 7;
#pragma unroll
    for (int j = 0; j < 4; ++j) { const int n = (lane >> 3) + 8 * j; const int src = n0 + n; int dst = src;
        if (kind == 2) { const int jj = src & 2047; dst = (jj >> 7) * 256 + (src >> 11) * 128 + (jj & 127); }
        const LAS float* sp = scr + (16 * c) * 33 + n;
        u32x4 o; o.x = pk4f8(sp[0 * 33] * WSCALE, sp[1 * 33] * WSCALE, sp[2 * 33] * WSCALE, sp[3 * 33] * WSCALE); o.y = pk4f8(sp[4 * 33] * WSCALE, sp[5 * 33] * WSCALE, sp[6 * 33] * WSCALE, sp[7 * 33] * WSCALE);
        o.z = pk4f8(sp[8 * 33] * WSCALE, sp[9 * 33] * WSCALE, sp[10 * 33] * WSCALE, sp[11 * 33] * WSCALE); o.w = pk4f8(sp[12 * 33] * WSCALE, sp[13 * 33] * WSCALE, sp[14 * 33] * WSCALE, sp[15 * 33] * WSCALE);
        *(u32x4*)(WT + (size_t)dst * D + k0 + 16 * c) = o; }
    asm volatile("s_waitcnt lgkmcnt(0)" ::: "memory");
}
DI void p0_small_rows(const Params& P, int G, int bid) {
    const int t = my_tid();
    for (int i = bid * 512 + t; i < NE * 4096 / 4; i += G * 512) ((f32x4*)(P.ws + WS_BGU))[i] = ((const f32x4*)P.in[I_BGU])[i];
    for (int i = bid * 512 + t; i < NE * D / 4; i += G * 512) ((f32x4*)(P.ws + WS_BDN))[i] = ((const f32x4*)P.in[I_BDN])[i];
    for (int r = bid; r < 512; r += G) {
        if (r < 256) { const int rr = r; if (rr >= 16) { *(unsigned*)((unsigned char*)(P.ws + WS_WIN) + (size_t)(6144 + rr) * D + 4 * t) = 0u; if (t == 0) ((float*)(P.ws + WS_WSC))[6144 + rr] = 1.0f; } }
        else { const int rr = r - 256; u32x2 z; z.x = 0u; z.y = 0u;
            *(u32x2*)((bf16_t*)(P.ws + WS_WR2) + (size_t)rr * D + 4 * t) = z; *(u32x2*)((bf16_t*)(P.ws + WS_WR2) + (size_t)(256 + rr) * D + 4 * t) = z; } }
}
DI int win_dst(int src) { int dst = src < GATE_COL0 ? src : (src < GATE_COL0 + 16 ? 6144 + (src - GATE_COL0) : (src < P_IN ? src - 16 : -1));
    if (dst >= 4096 && dst < 6144) { const int c = (dst - 4096) & 1023; dst = 4096 + (c >> 7) * 256 + (dst >= 5120 ? 128 : 0) + (c & 127); }
    return dst; }
template <bool WIN>
DI void p0_w_int8(const Params& P, LAS unsigned char* lds, int G, int bid, int item0) {
    const int tid = my_tid(), wid = __builtin_amdgcn_readfirstlane(tid >> 6), lane = tid & 63;
    LAS float* scr = (LAS float*)(lds + wid * 16896); LAS float* part = (LAS float*)(lds + 135168); LAS float* sinv = part + 256;
    const float* W = WIN ? P.in[I_WIN] : P.in[I_WOUT]; unsigned char* WT = (unsigned char*)(P.ws + (WIN ? WS_WIN : WS_WOUT)); float* wsc = (float*)(P.ws + (WIN ? WS_WSC : WS_WOSC));
    constexpr int NCOL = WIN ? P_IN : D, NITEM = WIN ? 193 : 64;
    const int c4 = (lane & 7) * 4, r8 = lane >> 3;
    for (int item = bid - item0; item < NITEM; item += G) { if (item < 0) continue; const int n0 = 32 * item; const bool okc = (n0 + c4) < NCOL;
        f32x4 mx = {0.f, 0.f, 0.f, 0.f};
#pragma unroll 8
        for (int i = 0; i < 32; ++i) { const f32x4 v = okc ? *(const f32x4*)(W + (size_t)(256 * wid + 8 * i + r8) * NCOL + n0 + c4) : (f32x4){0.f, 0.f, 0.f, 0.f};
            mx[0] = fmaxf(mx[0], fabsf(v[0])); mx[1] = fmaxf(mx[1], fabsf(v[1])); mx[2] = fmaxf(mx[2], fabsf(v[2])); mx[3] = fmaxf(mx[3], fabsf(v[3])); }
#pragma unroll
        for (int e = 0; e < 4; ++e) { mx[e] = fmaxf(mx[e], __shfl_xor(mx[e], 8)); mx[e] = fmaxf(mx[e], __shfl_xor(mx[e], 16)); mx[e] = fmaxf(mx[e], __shfl_xor(mx[e], 32)); }
        if (lane < 8) *(LAS f32x4*)(part + wid * 32 + c4) = mx;
        __syncthreads();
        if (tid < 32) { float cm = 0.f;
#pragma unroll
            for (int w = 0; w < 8; ++w) cm = fmaxf(cm, part[w * 32 + tid]);
            const int src = n0 + tid; const int dst = !WIN ? src : win_dst(src);
            sinv[tid] = cm > 0.f ? 127.0f / cm : 0.f;
            if (dst >= 0) wsc[dst] = (cm > 0.f ? cm * (1.0f / 127.0f) : 1.0f) * ((WIN && dst < 512) ? 0.08838834764831845f : 1.0f); }
        __syncthreads();
        const f32x4 iv = *(const LAS f32x4*)(sinv + c4);
#pragma unroll 1
        for (int sb = 0; sb < 2; ++sb) { const int k0 = 256 * wid + 128 * sb;
            f32x4 v[16];
#pragma unroll
            for (int i = 0; i < 16; ++i) v[i] = okc ? *(const f32x4*)(W + (size_t)(k0 + 8 * i + r8) * NCOL + n0 + c4) : (f32x4){0.f, 0.f, 0.f, 0.f};
#pragma unroll
            for (int i = 0; i < 16; ++i) { LAS float* d = scr + (8 * i + r8) * 33 + c4; d[0] = __builtin_rintf(v[i][0] * iv[0]); d[1] = __builtin_rintf(v[i][1] * iv[1]); d[2] = __builtin_rintf(v[i][2] * iv[2]); d[3] = __builtin_rintf(v[i][3] * iv[3]); }
            asm volatile("s_waitcnt lgkmcnt(0)" ::: "memory");
            const int c = lane & 7;
#pragma unroll
            for (int j = 0; j < 4; ++j) { const int n = (lane >> 3) + 8 * j; const int src = n0 + n; const int dst = !WIN ? src : win_dst(src);
                const LAS float* sp = scr + (16 * c) * 33 + n;
                u32x4 o; o.x = pk4i8(sp[0 * 33], sp[1 * 33], sp[2 * 33], sp[3 * 33]); o.y = pk4i8(sp[4 * 33], sp[5 * 33], sp[6 * 33], sp[7 * 33]);
                o.z = pk4i8(sp[8 * 33], sp[9 * 33], sp[10 * 33], sp[11 * 33]); o.w = pk4i8(sp[12 * 33], sp[13 * 33], sp[14 * 33], sp[15 * 33]);
                if (dst >= 0) *(u32x4*)(WT + (size_t)dst * D + k0 + 16 * c) = o; }
            asm volatile("s_waitcnt lgkmcnt(0)" ::: "memory"); }
        __syncthreads();
    }
}
DI void p0_convert(const Params& P, LAS unsigned char* lds, int G, int bid) {
    const int tid = my_tid(), wid = __builtin_amdgcn_readfirstlane(tid >> 6), lane = tid & 63;
    LAS float* scr = (LAS float*)(lds + wid * 16896);
    const int gw = bid * 8 + wid, NGW = G * 8;
    for (int it = gw; it < 32 * 64; it += NGW) p0_transpose_item(P.in[I_WOUT], D, D, (bf16_t*)(P.ws + WS_WOUT), 1, scr, it, lane);
}
constexpr int CV_GU1 = 16 * 128, CV_DN1 = 16 * 64, CV_ITEMS = NE * (CV_GU1 + CV_DN1);
struct CvItem { const float* W; unsigned char* WT; int N, kind, k0, n0; };
DI CvItem cv_decode(const Params& P, int it) { CvItem c; int item;
    if (it < NE * CV_GU1) { const int e = it / CV_GU1; c.W = P.in[I_WGU] + (size_t)e * D * 4096; c.N = 4096; c.WT = (unsigned char*)(P.ws + WS_WGU) + (size_t)e * 4096 * D; c.kind = 2; item = it % CV_GU1; }
    else { const int r = it - NE * CV_GU1; const int e = r / CV_DN1; c.W = P.in[I_WDN] + (size_t)e * D * D; c.N = D; c.WT = (unsigned char*)(P.ws + WS_WDN) + (size_t)e * D * D; c.kind = 3; item = r % CV_DN1; }
    const int nblk = c.N / 32, kb = item / nblk, nb = item % nblk; c.k0 = 128 * kb; c.n0 = 32 * nb; return c; }
DI void cv_issue(const CvItem& c, int lane, f32x4 (&v)[16]) { const int c4 = (lane & 7) * 4, r8 = lane >> 3;
#pragma unroll
    for (int i = 0; i < 16; ++i) v[i] = *(const f32x4*)(c.W + (size_t)(c.k0 + 8 * i + r8) * c.N + c.n0 + c4); }
DI void cv_finish(const CvItem& cc, int lane, LAS float* scr, const f32x4 (&v)[16]) {
    { const int c4 = (lane & 7) * 4, r8 = lane >> 3;
#pragma unroll
      for (int i = 0; i < 16; ++i) { LAS float* d = scr + (8 * i + r8) * 33 + c4; d[0] = v[i][0]; d[1] = v[i][1]; d[2] = v[i][2]; d[3] = v[i][3]; } }
    asm volatile("s_waitcnt lgkmcnt(0)" ::: "memory");
    const int c = lane & 7;
#pragma unroll
    for (int j = 0; j < 4; ++j) { const int n = (lane >> 3) + 8 * j; const int src = cc.n0 + n; int dst = src;
        if (cc.kind == 2) { const int jj = src & 2047; dst = (jj >> 7) * 256 + (src >> 11) * 128 + (jj & 127); }
        const LAS float* sp = scr + (16 * c) * 33 + n;
        u32x4 o; o.x = pk4f8(sp[0 * 33] * WSCALE, sp[1 * 33] * WSCALE, sp[2 * 33] * WSCALE, sp[3 * 33] * WSCALE); o.y = pk4f8(sp[4 * 33] * WSCALE, sp[5 * 33] * WSCALE, sp[6 * 33] * WSCALE, sp[7 * 33] * WSCALE);
        o.z = pk4f8(sp[8 * 33] * WSCALE, sp[9 * 33] * WSCALE, sp[10 * 33] * WSCALE, sp[11 * 33] * WSCALE); o.w = pk4f8(sp[12 * 33] * WSCALE, sp[13 * 33] * WSCALE, sp[14 * 33] * WSCALE, sp[15 * 33] * WSCALE);
        *(u32x4*)(cc.WT + (size_t)dst * D + cc.k0 + 16 * c) = o; }
    asm volatile("s_waitcnt lgkmcnt(0)" ::: "memory");
}
DI void conv_experts(const Params& P, LAS unsigned char* lds, int gw, int nw, int lo, int hi) {
    const int wid = wave_in_wg(), lane = lane_id();
    LAS float* scr = (LAS float*)(lds + wid * 16896);
    int it = lo + gw; if (it >= hi) return;
    CvItem cur = cv_decode(P, it); f32x4 v[16]; cv_issue(cur, lane, v);
    for (;;) { const int nx = it + nw; const bool more = nx < hi;
        const CvItem nxt = cv_decode(P, more ? nx : it); f32x4 vn[16]; cv_issue(nxt, lane, vn);
        asm volatile("" ::: "memory");
        cv_finish(cur, lane, scr, v);
        if (!more) break;
#pragma unroll
        for (int i = 0; i < 16; ++i) v[i] = vn[i];
        cur = nxt; it = nx; }
}
constexpr int CV_BLK = 8, CV_NBLK_ALL = CV_ITEMS / CV_BLK, CV_NBLK_A = (CV_NBLK_ALL / 100) * 94;
DI void conv_pool(const Params& P, LAS unsigned char* lds, int pool, int blk_lo, int blk_hi) {
    const int wid = wave_in_wg(), lane = lane_id();
    LAS float* scr = (LAS float*)(lds + wid * 16896);
    unsigned* ctr = (unsigned*)(P.ws + WS_CTL) + CW_POOL + pool * 64;
    const int CV_NBLK = blk_hi;
    auto claim = [&]() -> int { unsigned v_ = 0u; if (lane == 0) v_ = __hip_atomic_fetch_add(ctr, 1u, __ATOMIC_RELAXED, __HIP_MEMORY_SCOPE_AGENT); return blk_lo + (int)__builtin_amdgcn_readfirstlane(v_); };
    const int blk = claim(); if (blk >= CV_NBLK) return;
    int it = blk * CV_BLK, left = CV_BLK;
    CvItem cur = cv_decode(P, it); f32x4 v[16]; cv_issue(cur, lane, v);
    for (;;) { int nx = it + 1; bool more = true;
        if (left > 1) --left; else { const int nb = claim(); if (nb >= CV_NBLK) { more = false; nx = it; } else { nx = nb * CV_BLK; left = CV_BLK; } }
        const CvItem nxt = cv_decode(P, nx); f32x4 vn[16]; cv_issue(nxt, lane, vn);
        asm volatile("" ::: "memory");
        cv_finish(cur, lane, scr, v);
        if (!more) break;
#pragma unroll
        for (int i = 0; i < 16; ++i) v[i] = vn[i];
        cur = nxt; it = nx; }
}

DI void nm_fill_mod(LAS unsigned char* lds, const Params& P, int cond, int chunk_shift, int chunk_scale, const float* g) {
    LAS float* av = (LAS float*)lds; LAS float* bv = (LAS float*)(lds + 8192);
    const float* modp = (const float*)(P.ws + WS_MODP); const float* bada = P.in[I_BADA];
    const int t = my_tid(); float shv[4], scv[4], gv[4];
#pragma unroll
    for (int u = 0; u < 4; ++u) { const int i = t + 512 * u; float sh = bada[chunk_shift * D + i], sc = bada[chunk_scale * D + i];
#pragma unroll
        for (int ks = 0; ks < 4; ++ks) { sh += modp[((size_t)ks * 3 + cond) * NMOD + chunk_shift * D + i]; sc += modp[((size_t)ks * 3 + cond) * NMOD + chunk_scale * D + i]; }
        shv[u] = sh; scv[u] = sc; gv[u] = g[i]; }
#pragma unroll
    for (int u = 0; u < 4; ++u) { const int i = t + 512 * u; av[i] = gv[u] * (1.0f + scv[u]); bv[i] = shv[u]; }
}
DI void unpack8(const u32x4 r, f32x4& lo, f32x4& hi) { lo = (f32x4){bf_lo(r.x), bf_hi(r.x), bf_lo(r.y), bf_hi(r.y)}; hi = (f32x4){bf_lo(r.z), bf_hi(r.z), bf_lo(r.w), bf_hi(r.w)}; }
template <int OUT, bool SRCBF>
DI void nm_rowpair(LAS unsigned char* lds, const void* src0v, const void* src1v, bf16_t* b0, bf16_t* b1, unsigned char* q0, unsigned char* q1, int lane, float* sc0 = nullptr) {
    const LAS float* av = (const LAS float*)lds; const LAS float* bv = (const LAS float*)(lds + 8192);
    f32x4 xa[8], xb[8]; float sa = 0.f, sb = 0.f;
    if constexpr (SRCBF) { const bf16_t* s0 = (const bf16_t*)src0v; const bf16_t* s1 = (const bf16_t*)src1v; u32x4 ra_[4], rb_[4];
#pragma unroll
        for (int j = 0; j < 4; ++j) { const int c = 512 * j + 8 * lane; ra_[j] = *(const u32x4*)(s0 + c); rb_[j] = *(const u32x4*)(s1 + c); }
#pragma unroll
        for (int j = 0; j < 4; ++j) { unpack8(ra_[j], xa[2 * j], xa[2 * j + 1]); unpack8(rb_[j], xb[2 * j], xb[2 * j + 1]); }
    } else { const float* src0 = (const float*)src0v; const float* src1 = (const float*)src1v;
#pragma unroll
    for (int j = 0; j < 4; ++j) { const int c = 512 * j + 8 * lane; xa[2 * j] = *(const f32x4*)(src0 + c); xa[2 * j + 1] = *(const f32x4*)(src0 + c + 4); xb[2 * j] = *(const f32x4*)(src1 + c); xb[2 * j + 1] = *(const f32x4*)(src1 + c + 4); } }
#pragma unroll
    for (int j = 0; j < 8; ++j) { sa += (xa[j][0] * xa[j][0] + xa[j][1] * xa[j][1]) + (xa[j][2] * xa[j][2] + xa[j][3] * xa[j][3]); sb += (xb[j][0] * xb[j][0] + xb[j][1] * xb[j][1]) + (xb[j][2] * xb[j][2] + xb[j][3] * xb[j][3]); }
    const float ra = 1.0f / sqrtf(wave_sum(sa) * (1.0f / D) + EPS), rb = 1.0f / sqrtf(wave_sum(sb) * (1.0f / D) + EPS);
    if constexpr (OUT == 2) {
        float ma = 0.f, mb = 0.f;
#pragma unroll
        for (int j = 0; j < 4; ++j) { const int c = 512 * j + 8 * lane;
            const f32x4 A0 = *(const LAS f32x4*)(av + c), A1 = *(const LAS f32x4*)(av + c + 4), B0 = *(const LAS f32x4*)(bv + c), B1 = *(const LAS f32x4*)(bv + c + 4);
            xa[2 * j] = xa[2 * j] * ra * A0 + B0; xa[2 * j + 1] = xa[2 * j + 1] * ra * A1 + B1; xb[2 * j] = xb[2 * j] * rb * A0 + B0; xb[2 * j + 1] = xb[2 * j + 1] * rb * A1 + B1;
#pragma unroll
            for (int e = 0; e < 4; ++e) { ma = fmaxf(ma, fmaxf(fabsf(xa[2 * j][e]), fabsf(xa[2 * j + 1][e]))); mb = fmaxf(mb, fmaxf(fabsf(xb[2 * j][e]), fabsf(xb[2 * j + 1][e]))); } }
        ma = wave_max(ma); mb = wave_max(mb);
        const float ia = ma > 0.f ? 127.0f / ma : 0.f, ib = mb > 0.f ? 127.0f / mb : 0.f;
        if (lane == 0) { sc0[0] = ma > 0.f ? ma * (1.0f / 127.0f) : 1.0f; sc0[1] = mb > 0.f ? mb * (1.0f / 127.0f) : 1.0f; }
#pragma unroll
        for (int j = 0; j < 4; ++j) { const int c = 512 * j + 8 * lane;
            u32x2 qa; qa.x = pk4i8(__builtin_rintf(xa[2 * j][0] * ia), __builtin_rintf(xa[2 * j][1] * ia), __builtin_rintf(xa[2 * j][2] * ia), __builtin_rintf(xa[2 * j][3] * ia));
            qa.y = pk4i8(__builtin_rintf(xa[2 * j + 1][0] * ia), __builtin_rintf(xa[2 * j + 1][1] * ia), __builtin_rintf(xa[2 * j + 1][2] * ia), __builtin_rintf(xa[2 * j + 1][3] * ia)); *(u32x2*)(q0 + c) = qa;
            u32x2 qb; qb.x = pk4i8(__builtin_rintf(xb[2 * j][0] * ib), __builtin_rintf(xb[2 * j][1] * ib), __builtin_rintf(xb[2 * j][2] * ib), __builtin_rintf(xb[2 * j][3] * ib));
            qb.y = pk4i8(__builtin_rintf(xb[2 * j + 1][0] * ib), __builtin_rintf(xb[2 * j + 1][1] * ib), __builtin_rintf(xb[2 * j + 1][2] * ib), __builtin_rintf(xb[2 * j + 1][3] * ib)); *(u32x2*)(q1 + c) = qb; }
        return; }
    constexpr bool F8OUT = (OUT == 1 || OUT == 3), BFOUT = (OUT != 3);
    if constexpr (OUT == 3) { if (lane == 0) { sc0[0] = ra; sc0[1] = rb; } }
#pragma unroll
    for (int j = 0; j < 4; ++j) { const int c = 512 * j + 8 * lane;
        const f32x4 A0 = *(const LAS f32x4*)(av + c), A1 = *(const LAS f32x4*)(av + c + 4), B0 = *(const LAS f32x4*)(bv + c), B1 = *(const LAS f32x4*)(bv + c + 4);
        const f32x4 ya0 = xa[2 * j] * ra * A0 + B0, ya1 = xa[2 * j + 1] * ra * A1 + B1, yb0 = xb[2 * j] * rb * A0 + B0, yb1 = xb[2 * j + 1] * rb * A1 + B1;
        if constexpr (BFOUT) { u32x4 w; w.x = pk2(ya0[0], ya0[1]); w.y = pk2(ya0[2], ya0[3]); w.z = pk2(ya1[0], ya1[1]); w.w = pk2(ya1[2], ya1[3]); *(u32x4*)(b0 + c) = w;
        u32x4 v; v.x = pk2(yb0[0], yb0[1]); v.y = pk2(yb0[2], yb0[3]); v.z = pk2(yb1[0], yb1[1]); v.w = pk2(yb1[2], yb1[3]); *(u32x4*)(b1 + c) = v; }
        if constexpr (F8OUT) { u32x2 qa; qa.x = pk4f8(ya0[0], ya0[1], ya0[2], ya0[3]); qa.y = pk4f8(ya1[0], ya1[1], ya1[2], ya1[3]); *(u32x2*)(q0 + c) = qa;
                               u32x2 qb; qb.x = pk4f8(yb0[0], yb0[1], yb0[2], yb0[3]); qb.y = pk4f8(yb1[0], yb1[1], yb1[2], yb1[3]); *(u32x2*)(q1 + c) = qb; }
    }
}
DI void p1_modulate(const Params& P, LAS unsigned char* lds, int G, int bid) {
    const int tid = my_tid(), wid = __builtin_amdgcn_readfirstlane(tid >> 6), lane = tid & 63;
    unsigned char* XN = (unsigned char*)(P.ws + WS_XN); float* xsc = (float*)(P.ws + WS_XSC);
    {
        const float* modp = (const float*)(P.ws + WS_MODP); float* modf = (float*)(P.ws + WS_MODF);
        for (int i = bid * 512 + tid; i < 3 * NMOD; i += G * 512) { const int r = i / NMOD, c = i % NMOD; float s = P.in[I_BADA][c];
#pragma unroll
            for (int ks = 0; ks < 4; ++ks) s += modp[((size_t)ks * 3 + r) * NMOD + c];
            modf[i] = s; }
    }
    int cur_cond = -1;
    for (int blk = bid; blk < 256; blk += G) {
        const int cond = blk < 128 ? 0 : 1;
        if (cond != cur_cond) { __syncthreads(); nm_fill_mod(lds, P, cond, 0, 1, P.in[I_GMIX]); cur_cond = cond; }
        __syncthreads();
#pragma unroll 1
        for (int pr = 0; pr < 8; ++pr) { const int row = blk * 128 + wid * 16 + pr * 2; const float* s0 = P.in[I_X] + (size_t)row * D;
            nm_rowpair<2, false>(lds, s0, s0 + D, nullptr, nullptr, XN + (size_t)row * D, XN + (size_t)(row + 1) * D, lane, xsc + row); }
    }
    __syncthreads(); nm_fill_mod(lds, P, 2, 0, 1, P.in[I_GMIX]); __syncthreads();
#pragma unroll 1
    for (int pr = bid * 8 + wid; pr < TC / 2; pr += G * 8) { const int row = T + pr * 2; const float* s0 = P.in[I_CTX] + (size_t)(pr * 2) * D;
        nm_rowpair<2, false>(lds, s0, s0 + D, nullptr, nullptr, XN + (size_t)row * D, XN + (size_t)(row + 1) * D, lane, xsc + row); }
    __syncthreads();
}
DI void p8_modulate(const Params& P, LAS unsigned char* lds, int G, int bid) {
    const int tid = my_tid(), wid = __builtin_amdgcn_readfirstlane(tid >> 6), lane = tid & 63;
    unsigned char* XN8 = (unsigned char*)(P.ws + WS_XN8); const bf16_t* X1 = (const bf16_t*)(P.ws + WS_X1); float* rstd = (float*)(P.ws + WS_RSTD);
    { const float* modf = (const float*)(P.ws + WS_MODF); const float* gf = P.in[I_GFFN]; const float* wr_ = P.in[I_WR]; LAS float* red = (LAS float*)(lds + 16384);
      for (int item = bid; item < 64; item += G) { const int b = item >> 5, rr = item & 31; const float* mf = modf + (size_t)b * NMOD;
          float v[4], part = 0.f;
#pragma unroll
          for (int i = 0; i < 4; ++i) { const int k = 4 * tid + i; const float w = wr_[(size_t)k * NE + rr]; v[i] = w * (gf[k] * (1.0f + mf[4 * D + k])); part += w * mf[3 * D + k]; }
          u32x2 o; o.x = pk2(v[0], v[1]); o.y = pk2(v[2], v[3]); *(u32x2*)((bf16_t*)(P.ws + WS_WR2) + (size_t)(b * 256 + rr) * D + 4 * tid) = o;
          part = wave_sum(part);
          __syncthreads(); if (lane == 0) red[wid] = part; __syncthreads();
          if (tid == 0) ((float*)(P.ws + WS_CBR))[b * 32 + rr] = ((red[0] + red[1]) + (red[2] + red[3])) + ((red[4] + red[5]) + (red[6] + red[7])); } }
    int cur_cond = -1;
    for (int blk = bid; blk < 256; blk += G) {
        const int cond = blk < 128 ? 0 : 1;
        if (cond != cur_cond) { __syncthreads(); nm_fill_mod(lds, P, cond, 3, 4, P.in[I_GFFN]); cur_cond = cond; }
        __syncthreads();
#pragma unroll 1
        for (int pr = 0; pr < 8; ++pr) { const int row = blk * 128 + wid * 16 + pr * 2; const bf16_t* s0 = X1 + (size_t)row * D;
            nm_rowpair<3, true>(lds, s0, s0 + D, nullptr, nullptr, XN8 + (size_t)row * D, XN8 + (size_t)(row + 1) * D, lane, rstd + row); }
    }
    __syncthreads();
}

struct SchedIn { static constexpr bool GATHER = false, ETAB = false, BIAS = false;
    unsigned char* ws; int G, c;
    DI bool next(int i, pg8::Unit& u) const {
        const int L = i * G + c; if (L >= 3200 + 14) return false;
        int pm, pn;
        if (L < 3200) pg8::tile_order(pg8::xcd_remap(L, 3200), 3200, 128, 25, pm, pn);
        else { const int j = L - 3200; pm = 128 + j / 7; pn = (j % 7) < 6 ? 2 + (j % 7) : 24; }
        const unsigned xrow = (unsigned)(WS_XN + (size_t)pm * 256 * D), wrow = (unsigned)(WS_WIN + (size_t)pn * 256 * D);
        u.a0 = pm; u.a1 = pn;
        if (pn >= 4 && pn < 8) { u.A = wrow; u.B = xrow; u.ldc = MT; u.O = (char*)(ws + WS_VT) + ((size_t)(pn - 4) * 256 * MT + (size_t)pm * 256) * 2; }
        else if (pn == 24) { u.A = xrow; u.B = wrow; u.ldc = 0; u.O = (char*)(ws + WS_GATES) + (size_t)pm * 256 * 16 * 4; }
        else { u.A = xrow; u.B = wrow;
            size_t base; int ldc, pc;
            if (pn < 2) { base = WS_Q; ldc = 512; pc = pn; } else if (pn < 4) { base = WS_K; ldc = 512; pc = pn - 2; }
            else if (pn < 12) { base = WS_O; ldc = 1024; pc = pn - 8; } else if (pn < 16) { base = WS_CB; ldc = 1024; pc = pn - 12; }
            else { base = WS_CC; ldc = 1024; pc = pn - 16; }
            u.ldc = ldc; u.O = (char*)(ws + base) + ((size_t)pm * 256 * ldc + (size_t)pc * (pn >= 16 ? 128 : 256)) * 2; }
        return true;
    }
};
struct SchedRouter { static constexpr bool GATHER = false, ETAB = false, BIAS = false;
    unsigned char* ws; int G, c;
    DI bool next(int i, pg8::Unit& u) const {
        const int L = i * G + c; if (L >= 128) return false;
        u.A = (unsigned)(WS_X1 + (size_t)L * 256 * D * 2); u.B = (unsigned)(WS_WR2 + (size_t)(L >= 64 ? 1 : 0) * 256 * D * 2); u.O = (char*)(ws + WS_LOGITS) + (size_t)L * 256 * NE * 4; u.ldc = 0; u.a0 = L; u.a1 = 0; return true;
    }
};
struct SchedOut { static constexpr bool GATHER = false, ETAB = false, BIAS = false;
    unsigned char* ws; int G, c;
    DI bool next(int i, pg8::Unit& u) const {
        const int L = i * G + c; if (L >= 1024) return false;
        int pm, pn; pg8::tile_order(pg8::xcd_remap(L, 1024), 1024, 128, 8, pm, pn);
        u.A = (unsigned)(WS_A2 + (size_t)pm * 256 * D); u.B = (unsigned)(WS_WOUT + (size_t)pn * 256 * D); u.O = nullptr; u.ldc = 0; u.a0 = pm; u.a1 = pn; return true;
    }
};
DI void moe_tables(const Params& P, LAS unsigned char* lds, int npn, int G, int bid) {
    LAS int* tab = (LAS int*)(lds + LDS_CTL_OFF + 64); LAS int* ul = (LAS int*)(lds + LDS_CTL_OFF + 384);
    __syncthreads();
    if (my_tid() == 0) { const unsigned* gc = (const unsigned*)(P.ws + WS_CTL) + CW_GCNT; int pre = 0;
        for (int e = 0; e < NE; ++e) { const int cn = (int)__hip_atomic_load(gc + e, __ATOMIC_RELAXED, __HIP_MEMORY_SCOPE_AGENT); tab[e] = cn; tab[32 + e] = pre; pre += (cn + 255) >> 8; }
        tab[64] = pre; }
    __syncthreads();
    if (npn > 0 && my_tid() < 64) { const int i = my_tid(); const int nwg = tab[64] * npn; const int L = i * G + bid; int d0 = -1, d1 = 0;
        if (L < nwg) { const int wg = pg8::xcd_remap(L, nwg); int e = 0;
            for (int k = 1; k < 32; ++k) if (wg >= tab[32 + k] * npn) e = k;
            const int t0 = tab[32 + e], nM = tab[32 + e + 1] - t0, w = wg - t0 * npn; int pm, pn; pg8::tile_order(w, nM * npn, nM, npn, pm, pn);
            d0 = e | (pn << 8) | (pm << 16); d1 = t0; }
        ul[2 * i] = d0; ul[2 * i + 1] = d1; }
    __syncthreads();
}
template <bool GATHER_> struct SchedMoeT { static constexpr bool GATHER = GATHER_, ETAB = !GATHER_, BIAS = GATHER_;
    DI unsigned etab_off(const pg8::Unit& u, int which) const { return (unsigned)((const unsigned char*)u.O - ws) + (which ? (unsigned)(WS_LISTW - WS_LIST) : 0u); }
    unsigned char* ws; const LAS int* tab; int down;
    DI unsigned bias_off(const pg8::Unit& u, int which) const { return down ? (unsigned)(WS_BDN + ((size_t)u.a0 * D + (size_t)u.a1 * 256 + which * 128) * 4) : (unsigned)(WS_BGU + ((size_t)u.a0 * 4096 + (size_t)u.a1 * 128 + which * 2048) * 4); }
    DI unsigned list_off(const pg8::Unit& u) const { return (unsigned)(WS_LIST + ((size_t)u.a0 * T + (size_t)u.ldc) * 4); }
    DI int row_cnt(const pg8::Unit& u) const { return __builtin_amdgcn_readfirstlane(tab[u.a0]) - u.ldc; }
    DI bool next(int i, pg8::Unit& u) const {
        if (i >= 64) return false;
        const LAS int* ul = tab + 80;
        const int d0 = __builtin_amdgcn_readfirstlane(ul[2 * i]); if (d0 < 0) return false;
        const int t0 = __builtin_amdgcn_readfirstlane(ul[2 * i + 1]); const int e = d0 & 255, pn = (d0 >> 8) & 255, pm = d0 >> 16;
        const size_t row0 = (size_t)(t0 + pm) * 256;
        u.a0 = e; u.a1 = pn;
        if (!down) { u.A = GATHER_ ? (unsigned)WS_XN8 : (unsigned)(WS_XG + row0 * D); u.B = (unsigned)(WS_WGU + ((size_t)e * 4096 + (size_t)pn * 256) * D); u.O = (char*)(ws + WS_ACT) + row0 * D; u.ldc = pm * 256; }
        else { u.A = (unsigned)(WS_ACT + row0 * D); u.B = (unsigned)(WS_WDN + ((size_t)e * D + (size_t)pn * 256) * D);
               u.O = (char*)(ws + WS_LIST) + ((size_t)e * T + (size_t)pm * 256) * 4; const int rem = __builtin_amdgcn_readfirstlane(tab[e]) - pm * 256; u.ldc = rem < 256 ? rem : 256; }
        return true;
    }
};
typedef SchedMoeT<false> SchedMoe;

constexpr int ML_QS = 0, ML_KS = 34816, ML_PS = 69632, ML_SC = 104448;
constexpr int SC_U = 0, SC_T = 512, SC_WST = 1024, SC_CL = 1536, SC_EV = 2048, SC_LF = 2560, SC_LI = 3072, SC_N0 = 3584, SC_DENP = 4096, SC_QNP = 6144, SC_NPART = 8192, SC_MISC = 10240;
DI unsigned off_b(unsigned row, unsigned ch) { return 272u * row + 16u * ch; }
DI float softcap(float x) { return 15.0f * tanhf(x * (1.0f / 15.0f)); }
DI float logsigmoid(float y) { return fminf(y, 0.f) - log1pf(__expf(-fabsf(y))); }
#define MFMA32(a, b, c) __builtin_amdgcn_mfma_f32_32x32x16_bf16((a), (b), (c), 0, 0, 0)

template <bool PASS2, int DIRT>
DI void mlstm_item(const Params& P, LAS unsigned char* lds, int st, int g) {
    const int wid = wave_in_wg();
    int tid = (wid << 6) | lane_id(), lane = tid & 63, r = lane & 31, hh = lane >> 5;
    constexpr int dir = DIRT; const int b = (st >> 2) & 1, h = st & 3;
    LAS unsigned char* QS = lds + ML_QS; LAS unsigned char* KS = lds + ML_KS; LAS unsigned char* PS = lds + ML_PS;
    LAS float* SC = (LAS float*)(lds + ML_SC);
    LAS float* sU = SC + SC_U / 4; LAS float* sT = SC + SC_T / 4; LAS float* sWST = SC + SC_WST / 4; LAS float* sCL = SC + SC_CL / 4; LAS float* sEV = SC + SC_EV / 4;
    LAS float* sLF = SC + SC_LF / 4; LAS float* sLI = SC + SC_LI / 4; LAS float* sN0 = SC + SC_N0 / 4; LAS float* sDENP = SC + SC_DENP / 4; LAS float* sQNP = SC + SC_QNP / 4;
    LAS float* sNPART = SC + SC_NPART / 4; LAS float* sMISC = SC + SC_MISC / 4;
    const bf16_t* Qg = (const bf16_t*)(P.ws + WS_Q); const bf16_t* Kg = (const bf16_t*)(P.ws + WS_K); const bf16_t* VT = (const bf16_t*)(P.ws + WS_VT);
    const float* gates = (const float*)(P.ws + WS_GATES);
    const int ctx_item = (!PASS2 && g == 0); const int nchunks = ctx_item ? 2 : 8; const int seg = PASS2 ? g : g - 1;
    f32x16 C[4];
#pragma unroll
    for (int i = 0; i < 4; ++i)
#pragma unroll
        for (int e = 0; e < 16; ++e) C[i][e] = 0.f;
    __syncthreads();
    if (PASS2) {
        const float* ec = (const float*)(P.ws + WS_ENTC) + ((size_t)st * 16 + g) * 32768;
#pragma unroll
        for (int dkt = 0; dkt < 4; ++dkt)
#pragma unroll
            for (int e = 0; e < 16; ++e) C[dkt][e] = ec[(32 * dkt + (e & 3) + 8 * (e >> 2) + 4 * hh) * 256 + 32 * wid + r];
        if (tid < 128) sN0[tid] = ((const float*)(P.ws + WS_ENTN))[((size_t)st * 16 + g) * 128 + tid];
        if (tid == 0) sMISC[1] = ((const float*)(P.ws + WS_ENTN + 512 * 1024))[st * 16 + g];
    } else {
        if (tid < 128) sN0[tid] = 0.f;
        if (tid == 0) sMISC[1] = -1e30f;
    }
    LAS float* sALL = SC + 10496 / 4;
    LAS float* sCH = sALL + 8 * 3 * 128;
    auto chunk_tok0 = [&](int ci) -> int { if (ctx_item) return T + b * CTXL + (dir ? (1 - ci) : ci) * 128;
        const int cp = seg * 8 + ci; const int chunk = dir ? (NCHUNK - 1 - cp) : cp; return b * SEQ + chunk * 128; };
    if (wid < nchunks) { const int t0c = chunk_tok0(wid);
        const int p0 = dir ? 127 - 2 * lane : 2 * lane, p1 = dir ? 126 - 2 * lane : 2 * lane + 1;
        const float* g0 = gates + (size_t)(t0c + p0) * 16; const float* g1 = gates + (size_t)(t0c + p1) * 16;
        const float li0 = softcap(g0[dir * 8 + h]), li1 = softcap(g1[dir * 8 + h]); const float lf0 = logsigmoid(softcap(g0[dir * 8 + 4 + h])), lf1 = logsigmoid(softcap(g1[dir * 8 + 4 + h]));
        float sm = lf0 + lf1;
#pragma unroll
        for (int o = 1; o < 64; o <<= 1) { const float t = __shfl_up(sm, o); if (lane >= o) sm += t; }
        const float b0 = sm - lf1, b1 = sm;
        const float u0 = li0 - b0, u1 = li1 - b1;
        float mx = fmaxf(u0, u1);
#pragma unroll
        for (int o = 1; o < 64; o <<= 1) { const float t = __shfl_up(mx, o); if (lane >= o) mx = fmaxf(mx, t); }
        float pe = __shfl_up(mx, 1); if (lane == 0) pe = -3.0e38f;
        const float pm0 = fmaxf(pe, u0), pm1 = mx;
        LAS float* A = sALL + wid * 384;
        A[p0] = u0; A[p1] = u1; A[128 + p0] = pm0; A[128 + p1] = pm1; A[256 + p0] = b0; A[256 + p1] = b1;
        if (lane == 63) { sCH[wid * 4 + 0] = sm; sCH[wid * 4 + 1] = mx; }
    }
    __syncthreads();
    if (tid == 0) { float m0 = sMISC[1], bsum = 0.f;
        for (int c = 0; c < nchunks; ++c) { const float Bt = sCH[c * 4 + 0], U = sCH[c * 4 + 1]; const float Mp = fmaxf(m0, U); sCH[c * 4 + 2] = m0; sCH[c * 4 + 3] = Mp; m0 = Bt + Mp; bsum += Bt; }
        sMISC[1] = m0; sMISC[2] = bsum; }
    u32x4 kq[8];
    { const int tok0 = chunk_tok0(0);
#pragma unroll
      for (int i = 0; i < 4; ++i) { const int n = tid + 512 * i, row = n >> 4, ch = n & 15; kq[i] = *(const u32x4*)(Kg + (size_t)(tok0 + row) * 512 + h * 128 + ch * 8);
          if (PASS2) kq[4 + i] = *(const u32x4*)(Qg + (size_t)(tok0 + row) * 512 + h * 128 + ch * 8); } }
    __syncthreads();
    for (int ci = 0; ci < nchunks; ++ci) {
        tid = (wid << 6) | lane_id(); asm volatile("" : "+v"(tid)); lane = tid & 63; r = lane & 31; hh = lane >> 5;
        const int tok0 = chunk_tok0(ci);
#pragma unroll
        for (int i = 0; i < 4; ++i) { const int n = tid + 512 * i, row = n >> 4, ch = n & 15;
            *(LAS u32x4*)(KS + off_b(row, ch)) = kq[i];
            if (PASS2) *(LAS u32x4*)(QS + off_b(row, ch)) = kq[4 + i]; }
        bf16x8 vf[8];
#pragma unroll
        for (int ks = 0; ks < 8; ++ks) vf[ks] = *(const bf16x8*)(VT + (size_t)(h * 256 + 32 * wid + r) * MT + tok0 + 16 * ks + 8 * hh);
        if (tid < 128) { const LAS float* A = sALL + ci * 384; const float u = A[tid], m0 = sCH[ci * 4 + 2], Mp = sCH[ci * 4 + 3];
            sU[tid] = u; sEV[tid] = __expf(u - Mp);
            if (PASS2) { const float t = fmaxf(m0, A[128 + tid]); sT[tid] = t; sWST[tid] = __expf(m0 - t); sCL[tid] = __expf(-(A[256 + tid] + t)); }
            if (tid == 0) sMISC[0] = __expf(m0 - Mp); }
        __syncthreads();
        f32x16 num[4];
        if (PASS2) {
            const int stt = wid >> 1;
#pragma unroll
            for (int i = 0; i < 2; ++i) { const int jt = 2 * (wid & 1) + i; const bool skip = dir ? (stt < jt) : (stt > jt); const int j = 32 * jt + r;
                if (!skip) {
                    f32x16 acc;
#pragma unroll
                    for (int e = 0; e < 16; ++e) acc[e] = 0.f;
#pragma unroll
                    for (int ks = 0; ks < 8; ++ks) { const bf16x8 a = *(const LAS bf16x8*)(KS + off_b(32 * stt + r, 2 * ks + hh)); const bf16x8 bq = *(const LAS bf16x8*)(QS + off_b(j, 2 * ks + hh)); acc = MFMA32(a, bq, acc); if ((ks & 3) == 3) asm volatile("" : "+v"(acc) :: "memory"); }
                    const float tj = sT[j]; float rs = 0.f;
#pragma unroll
                    for (int gq = 0; gq < 4; ++gq) { const f32x4 us = *(const LAS f32x4*)(sU + 32 * stt + 8 * gq + 4 * hh); float pv[4];
#pragma unroll
                        for (int e = 0; e < 4; ++e) { const int s = 32 * stt + 8 * gq + 4 * hh + e; const bool ok = dir ? (s >= j) : (s <= j); const float p = ok ? acc[4 * gq + e] * __expf(us[e] - tj) : 0.f; rs += p; pv[e] = p; }
                        u32x2 w; w.x = pk2(pv[0], pv[1]); w.y = pk2(pv[2], pv[3]); *(LAS u32x2*)(PS + off_b(j, 4 * stt + gq) + 8 * hh) = w; }
                    rs += __shfl_xor(rs, 32); if (hh == 0) sDENP[stt * 128 + j] = rs;
                } else if (hh == 0) sDENP[stt * 128 + j] = 0.f;
            }
            { const int j = tid & 127, part = tid >> 7; float s = 0.f;
#pragma unroll
              for (int cc = 0; cc < 4; ++cc) { const u32x4 q8 = *(const LAS u32x4*)(QS + off_b(j, 4 * part + cc)); const f32x4 n0a = *(const LAS f32x4*)(sN0 + 32 * part + 8 * cc), n0b = *(const LAS f32x4*)(sN0 + 32 * part + 8 * cc + 4);
                  s += bf_lo(q8.x) * n0a[0] + bf_hi(q8.x) * n0a[1] + bf_lo(q8.y) * n0a[2] + bf_hi(q8.y) * n0a[3] + bf_lo(q8.z) * n0b[0] + bf_hi(q8.z) * n0b[1] + bf_lo(q8.w) * n0b[2] + bf_hi(q8.w) * n0b[3]; }
              sQNP[part * 128 + j] = s; }
            tid = (wid << 6) | lane_id(); asm volatile("" : "+v"(tid)); lane = tid & 63; r = lane & 31; hh = lane >> 5;
#pragma unroll
            for (int jt = 0; jt < 4; ++jt)
#pragma unroll
                for (int e = 0; e < 16; ++e) num[jt][e] = 0.f;
            {
                bf16x8 qf[2][4];
                auto ldq = [&](int g_, bf16x8 (&qb)[4]) { const int dkt = g_ >> 1, s2 = g_ & 1;
#pragma unroll
                    for (int jt = 0; jt < 4; ++jt) { const s16x4 lo = *(const LAS s16x4*)(QS + off_b(32 * jt + r, 4 * dkt + 2 * s2) + 8 * hh); const s16x4 hi = *(const LAS s16x4*)(QS + off_b(32 * jt + r, 4 * dkt + 2 * s2 + 1) + 8 * hh);
                        qb[jt] = __builtin_shufflevector(lo, hi, 0, 1, 2, 3, 4, 5, 6, 7); } };
                ldq(0, qf[0]);
#pragma unroll
                for (int g_ = 0; g_ < 8; ++g_) { const int dkt = g_ >> 1, s2 = g_ & 1;
                    if (g_ + 1 < 8) ldq(g_ + 1, qf[(g_ + 1) & 1]);
                    __builtin_amdgcn_sched_barrier(0);
                    u32x4 xp; xp.x = pk2(C[dkt][8 * s2 + 0], C[dkt][8 * s2 + 1]); xp.y = pk2(C[dkt][8 * s2 + 2], C[dkt][8 * s2 + 3]); xp.z = pk2(C[dkt][8 * s2 + 4], C[dkt][8 * s2 + 5]); xp.w = pk2(C[dkt][8 * s2 + 6], C[dkt][8 * s2 + 7]);
                    const bf16x8 xs = __builtin_bit_cast(bf16x8, xp);
#pragma unroll
                    for (int jt = 0; jt < 4; ++jt) num[jt] = MFMA32(xs, qf[g_ & 1][jt], num[jt]);
                    __builtin_amdgcn_sched_barrier(0);
                    if (s2 == 1) asm volatile("" : "+v"(num[0]), "+v"(num[1]), "+v"(num[2]), "+v"(num[3]) :: "memory"); }
            }
#pragma unroll
            for (int jt = 0; jt < 4; ++jt) { const float ws_ = sWST[32 * jt + r];
#pragma unroll
                for (int e = 0; e < 16; ++e) num[jt][e] *= ws_; }
            __syncthreads();
            tid = (wid << 6) | lane_id(); asm volatile("" : "+v"(tid)); lane = tid & 63; r = lane & 31; hh = lane >> 5;
            {
                bf16x8 pf[2][4];
                auto ldp = [&](int ks, bf16x8 (&pb)[4]) {
#pragma unroll
                    for (int jt = 0; jt < 4; ++jt) { const bool on = dir ? (ks >= 2 * jt) : (ks <= 2 * jt + 1); if (on) pb[jt] = *(const LAS bf16x8*)(PS + off_b(32 * jt + r, 2 * ks + hh)); } };
                ldp(0, pf[0]);
#pragma unroll
                for (int ks = 0; ks < 8; ++ks) {
                    if (ks + 1 < 8) ldp(ks + 1, pf[(ks + 1) & 1]);
                    __builtin_amdgcn_sched_barrier(0);
#pragma unroll
                    for (int jt = 0; jt < 4; ++jt) { const bool on = dir ? (ks >= 2 * jt) : (ks <= 2 * jt + 1); if (on) num[jt] = MFMA32(vf[ks], pf[ks & 1][jt], num[jt]); }
                    __builtin_amdgcn_sched_barrier(0); }
                asm volatile("" : "+v"(num[0]), "+v"(num[1]), "+v"(num[2]), "+v"(num[3]) :: "memory");
            }
            bf16_t* Hd = (bf16_t*)(P.ws + (dir ? WS_HB : WS_HF));
#pragma unroll
            for (int jt = 0; jt < 4; ++jt) { const int j = 32 * jt + r;
                const float den = (sDENP[j] + sDENP[128 + j]) + (sDENP[256 + j] + sDENP[384 + j]) + sWST[j] * ((sQNP[j] + sQNP[128 + j]) + (sQNP[256 + j] + sQNP[384 + j]));
                const float inv = 1.0f / fmaxf(fabsf(den), sCL[j]);
                bf16_t* hp = Hd + (size_t)(tok0 + j) * 1024 + h * 256 + 32 * wid + 4 * hh;
#pragma unroll
                for (int gq = 0; gq < 4; ++gq) { u32x2 w; w.x = pk2(num[jt][4 * gq] * inv, num[jt][4 * gq + 1] * inv); w.y = pk2(num[jt][4 * gq + 2] * inv, num[jt][4 * gq + 3] * inv); *(u32x2*)(hp + 8 * gq) = w; } }
        }
        tid = (wid << 6) | lane_id(); asm volatile("" : "+v"(tid)); lane = tid & 63; r = lane & 31; hh = lane >> 5;
        if (ci + 1 < nchunks) { const int tokn = chunk_tok0(ci + 1);
#pragma unroll
            for (int i = 0; i < 4; ++i) { const int n = tid + 512 * i, row = n >> 4, ch = n & 15; kq[i] = *(const u32x4*)(Kg + (size_t)(tokn + row) * 512 + h * 128 + ch * 8);
                if (PASS2) kq[4 + i] = *(const u32x4*)(Qg + (size_t)(tokn + row) * 512 + h * 128 + ch * 8); } }
        const float a = sMISC[0];
#pragma unroll
        for (int dkt = 0; dkt < 4; ++dkt)
#pragma unroll
            for (int e = 0; e < 16; ++e) C[dkt][e] *= a;
#pragma unroll
        for (int ks = 0; ks < 8; ++ks) { const f32x4 e0 = *(const LAS f32x4*)(sEV + 16 * ks + 8 * hh), e1 = *(const LAS f32x4*)(sEV + 16 * ks + 8 * hh + 4);
            u32x4 v = __builtin_bit_cast(u32x4, vf[ks]);
            v.x = pk2(bf_lo(v.x) * e0[0], bf_hi(v.x) * e0[1]); v.y = pk2(bf_lo(v.y) * e0[2], bf_hi(v.y) * e0[3]); v.z = pk2(bf_lo(v.z) * e1[0], bf_hi(v.z) * e1[1]); v.w = pk2(bf_lo(v.w) * e1[2], bf_hi(v.w) * e1[3]);
            vf[ks] = __builtin_bit_cast(bf16x8, v); }
        { const unsigned blk = (lane >> 4) & 1, q = (lane & 15) >> 2, p = lane & 3;
          bf16x8 kf[2][4];
          auto ldk = [&](int ks, bf16x8 (&kb)[4]) {
#pragma unroll
              for (int dkt = 0; dkt < 4; ++dkt) {
                  const s16x4 lo = __builtin_amdgcn_ds_read_tr16_b64_v4i16((LAS s16x4*)(KS + off_b(16 * ks + 8 * hh + q, 4 * dkt + 2 * blk + (p >> 1)) + 8 * (p & 1)));
                  const s16x4 hi = __builtin_amdgcn_ds_read_tr16_b64_v4i16((LAS s16x4*)(KS + off_b(16 * ks + 8 * hh + 4 + q, 4 * dkt + 2 * blk + (p >> 1)) + 8 * (p & 1)));
                  kb[dkt] = __builtin_shufflevector(lo, hi, 0, 1, 2, 3, 4, 5, 6, 7); } };
          ldk(0, kf[0]);
#pragma unroll
          for (int ks = 0; ks < 8; ++ks) {
              if (ks + 1 < 8) ldk(ks + 1, kf[(ks + 1) & 1]);
              __builtin_amdgcn_sched_barrier(0);
#pragma unroll
              for (int dkt = 0; dkt < 4; ++dkt) C[dkt] = MFMA32(kf[ks & 1][dkt], vf[ks], C[dkt]);
              __builtin_amdgcn_sched_barrier(0); }
          asm volatile("" : "+v"(C[0]), "+v"(C[1]), "+v"(C[2]), "+v"(C[3]) :: "memory"); }
        { const int dk = tid & 127, part = tid >> 7; float s = 0.f;
#pragma unroll 8
          for (int i = 0; i < 32; ++i) { const int sp = 32 * part + i; s += sEV[sp] * bf2f(*(const LAS unsigned short*)(KS + off_b(sp, dk >> 3) + (dk & 7) * 2)); }
          sNPART[part * 128 + dk] = s; }
        __syncthreads();
        if (tid < 128) sN0[tid] = a * sN0[tid] + ((sNPART[tid] + sNPART[128 + tid]) + (sNPART[256 + tid] + sNPART[384 + tid]));
        __syncthreads();
    }
    if (!PASS2) {
        float* tc = (float*)(P.ws + WS_TUPC) + ((size_t)st * 16 + g) * 32768;
#pragma unroll
        for (int dkt = 0; dkt < 4; ++dkt)
#pragma unroll
            for (int e = 0; e < 16; ++e) tc[(32 * dkt + (e & 3) + 8 * (e >> 2) + 4 * hh) * 256 + 32 * wid + r] = C[dkt][e];
        if (tid < 128) ((float*)(P.ws + WS_TUPN))[((size_t)st * 16 + g) * 128 + tid] = sN0[tid];
        if (tid == 0) { float* ts = (float*)(P.ws + WS_TUPN + 512 * 1024) + ((size_t)st * 16 + g) * 2; ts[0] = sMISC[2]; ts[1] = sMISC[1]; }
    }
    __syncthreads();
}
DI void mlstm_pass1(const Params& P, LAS unsigned char* lds, int st, int g) {
    const int wid = wave_in_wg();
    int tid = (wid << 6) | lane_id(), lane = tid & 63, r = lane & 31, hh = lane >> 5;
    const int dir = st >> 3, b = (st >> 2) & 1, h = st & 3;
    LAS float* SC = (LAS float*)(lds + ML_SC);
    LAS float* sEVA = SC;
    LAS float* sNPART = SC + SC_NPART / 4; LAS float* sMISC = SC + SC_MISC / 4;
    LAS float* sALL = SC + 10496 / 4; LAS float* sCH = sALL + 8 * 3 * 128; LAS float* sA = sCH + 40;
    const bf16_t* Kg = (const bf16_t*)(P.ws + WS_K); const bf16_t* VT = (const bf16_t*)(P.ws + WS_VT);
    const float* gates = (const float*)(P.ws + WS_GATES);
    const int ctx_item = (g == 0); const int nchunks = ctx_item ? 2 : 8; const int seg = g - 1;
    f32x16 C[4];
#pragma unroll
    for (int i = 0; i < 4; ++i)
#pragma unroll
        for (int e = 0; e < 16; ++e) C[i][e] = 0.f;
    __syncthreads();
    auto chunk_tok0 = [&](int ci) -> int { if (ctx_item) return T + b * CTXL + (dir ? (1 - ci) : ci) * 128;
        const int cp = seg * 8 + ci; const int chunk = dir ? (NCHUNK - 1 - cp) : cp; return b * SEQ + chunk * 128; };
    if (wid < nchunks) { const int t0c = chunk_tok0(wid);
        const int p0 = dir ? 127 - 2 * lane : 2 * lane, p1 = dir ? 126 - 2 * lane : 2 * lane + 1;
        const float* g0 = gates + (size_t)(t0c + p0) * 16; const float* g1 = gates + (size_t)(t0c + p1) * 16;
        const float li0 = softcap(g0[dir * 8 + h]), li1 = softcap(g1[dir * 8 + h]); const float lf0 = logsigmoid(softcap(g0[dir * 8 + 4 + h])), lf1 = logsigmoid(softcap(g1[dir * 8 + 4 + h]));
        float sm = lf0 + lf1;
#pragma unroll
        for (int o = 1; o < 64; o <<= 1) { const float t = __shfl_up(sm, o); if (lane >= o) sm += t; }
        const float b0 = sm - lf1, b1 = sm;
        const float u0 = li0 - b0, u1 = li1 - b1;
        float mx = fmaxf(u0, u1);
#pragma unroll
        for (int o = 1; o < 64; o <<= 1) { const float t = __shfl_up(mx, o); if (lane >= o) mx = fmaxf(mx, t); }
        LAS float* A = sALL + wid * 384;
        A[p0] = u0; A[p1] = u1;
        if (lane == 63) { sCH[wid * 4 + 0] = sm; sCH[wid * 4 + 1] = mx; }
    }
    __syncthreads();
    if (tid == 0) { float m0 = -1e30f, bsum = 0.f;
        for (int c = 0; c < nchunks; ++c) { const float Bt = sCH[c * 4 + 0], U = sCH[c * 4 + 1]; const float Mp = fmaxf(m0, U); sCH[c * 4 + 3] = Mp; sA[c] = __expf(m0 - Mp); m0 = Bt + Mp; bsum += Bt; }
        sMISC[1] = m0; sMISC[2] = bsum; }
    u32x4 kq[4]; bf16x8 vf[8], vfn[8];
    { const int tok0 = chunk_tok0(0);
#pragma unroll
      for (int i = 0; i < 4; ++i) { const int n = tid + 512 * i, row = n >> 4, ch = n & 15; kq[i] = *(const u32x4*)(Kg + (size_t)(tok0 + row) * 512 + h * 128 + ch * 8); }
#pragma unroll
      for (int ks = 0; ks < 8; ++ks) vfn[ks] = *(const bf16x8*)(VT + (size_t)(h * 256 + 32 * wid + r) * MT + tok0 + 16 * ks + 8 * hh); }
    __syncthreads();
    for (int i = tid; i < nchunks * 128; i += 512) { const int c = i >> 7; sEVA[i] = __expf(sALL[c * 384 + (i & 127)] - sCH[c * 4 + 3]); }
    float nacc = 0.f;
    for (int ci = 0; ci < nchunks; ++ci) {
        tid = (wid << 6) | lane_id(); asm volatile("" : "+v"(tid)); lane = tid & 63; r = lane & 31; hh = lane >> 5;
        LAS unsigned char* KB = lds + ((ci & 1) ? ML_PS : ML_KS);
#pragma unroll
        for (int i = 0; i < 4; ++i) { const int n = tid + 512 * i, row = n >> 4, ch = n & 15; *(LAS u32x4*)(KB + off_b(row, ch)) = kq[i]; }
#pragma unroll
        for (int ks = 0; ks < 8; ++ks) vf[ks] = vfn[ks];
        if (ci + 1 < nchunks) { const int tokn = chunk_tok0(ci + 1);
#pragma unroll
            for (int i = 0; i < 4; ++i) { const int n = tid + 512 * i, row = n >> 4, ch = n & 15; kq[i] = *(const u32x4*)(Kg + (size_t)(tokn + row) * 512 + h * 128 + ch * 8); }
#pragma unroll
            for (int ks = 0; ks < 8; ++ks) vfn[ks] = *(const bf16x8*)(VT + (size_t)(h * 256 + 32 * wid + r) * MT + tokn + 16 * ks + 8 * hh); }
        __syncthreads();
        const LAS float* sEV = sEVA + ci * 128;
        const float a = sA[ci];
#pragma unroll
        for (int dkt = 0; dkt < 4; ++dkt)
#pragma unroll
            for (int e = 0; e < 16; ++e) C[dkt][e] *= a;
#pragma unroll
        for (int ks = 0; ks < 8; ++ks) { const f32x4 e0 = *(const LAS f32x4*)(sEV + 16 * ks + 8 * hh), e1 = *(const LAS f32x4*)(sEV + 16 * ks + 8 * hh + 4);
            u32x4 v = __builtin_bit_cast(u32x4, vf[ks]);
            v.x = pk2(bf_lo(v.x) * e0[0], bf_hi(v.x) * e0[1]); v.y = pk2(bf_lo(v.y) * e0[2], bf_hi(v.y) * e0[3]); v.z = pk2(bf_lo(v.z) * e1[0], bf_hi(v.z) * e1[1]); v.w = pk2(bf_lo(v.w) * e1[2], bf_hi(v.w) * e1[3]);
            vf[ks] = __builtin_bit_cast(bf16x8, v); }
        { const unsigned blk = (lane >> 4) & 1, q = (lane & 15) >> 2, p = lane & 3;
          bf16x8 kf[2][4];
          auto ldk = [&](int ks, bf16x8 (&kb)[4]) {
#pragma unroll
              for (int dkt = 0; dkt < 4; ++dkt) {
                  const s16x4 lo = __builtin_amdgcn_ds_read_tr16_b64_v4i16((LAS s16x4*)(KB + off_b(16 * ks + 8 * hh + q, 4 * dkt + 2 * blk + (p >> 1)) + 8 * (p & 1)));
                  const s16x4 hi = __builtin_amdgcn_ds_read_tr16_b64_v4i16((LAS s16x4*)(KB + off_b(16 * ks + 8 * hh + 4 + q, 4 * dkt + 2 * blk + (p >> 1)) + 8 * (p & 1)));
                  kb[dkt] = __builtin_shufflevector(lo, hi, 0, 1, 2, 3, 4, 5, 6, 7); } };
          ldk(0, kf[0]);
#pragma unroll
          for (int ks = 0; ks < 8; ++ks) {
              if (ks + 1 < 8) ldk(ks + 1, kf[(ks + 1) & 1]);
              __builtin_amdgcn_sched_barrier(0);
#pragma unroll
              for (int dkt = 0; dkt < 4; ++dkt) C[dkt] = MFMA32(kf[ks & 1][dkt], vf[ks], C[dkt]);
              __builtin_amdgcn_sched_barrier(0); }
          asm volatile("" : "+v"(C[0]), "+v"(C[1]), "+v"(C[2]), "+v"(C[3]) :: "memory"); }
        { const int dk = tid & 127, part = tid >> 7; float s_ = 0.f;
#pragma unroll 8
          for (int i = 0; i < 32; ++i) { const int sp = 32 * part + i; s_ += sEV[sp] * bf2f(*(const LAS unsigned short*)(KB + off_b(sp, dk >> 3) + (dk & 7) * 2)); }
          nacc = a * nacc + s_; }
    }
    tid = (wid << 6) | lane_id(); asm volatile("" : "+v"(tid)); lane = tid & 63; r = lane & 31; hh = lane >> 5;
    float* tc = (float*)(P.ws + WS_TUPC) + ((size_t)st * 16 + g) * 32768;
#pragma unroll
    for (int dkt = 0; dkt < 4; ++dkt)
#pragma unroll
        for (int e = 0; e < 16; ++e) tc[(32 * dkt + (e & 3) + 8 * (e >> 2) + 4 * hh) * 256 + 32 * wid + r] = C[dkt][e];
    sNPART[tid] = nacc;
    __syncthreads();
    if (tid < 128) ((float*)(P.ws + WS_TUPN))[((size_t)st * 16 + g) * 128 + tid] = (sNPART[tid] + sNPART[128 + tid]) + (sNPART[256 + tid] + sNPART[384 + tid]);
    if (tid == 0) { float* ts = (float*)(P.ws + WS_TUPN + 512 * 1024) + ((size_t)st * 16 + g) * 2; ts[0] = sMISC[2]; ts[1] = sMISC[1]; }
    __syncthreads();
}
DI void p4_scan(const Params& P, int G, int bid) {
    const int tid = my_tid();
    for (int it = bid; it < 256; it += G) { const int st = it >> 4, sl = it & 15;
        const float* tc = (const float*)(P.ws + WS_TUPC) + (size_t)st * 16 * 32768 + sl * 2048 + tid * 4;
        float* ec = (float*)(P.ws + WS_ENTC) + (size_t)st * 16 * 32768 + sl * 2048 + tid * 4;
        const float* tn = (const float*)(P.ws + WS_TUPN) + (size_t)st * 16 * 128; const float* ts = (const float*)(P.ws + WS_TUPN + 512 * 1024) + (size_t)st * 16 * 2;
        float* en = (float*)(P.ws + WS_ENTN) + (size_t)st * 16 * 128; float* em = (float*)(P.ws + WS_ENTN + 512 * 1024) + st * 16;
        f32x4 Cv = {0.f, 0.f, 0.f, 0.f}; float nv = 0.f, m = 0.f;
        f32x4 Ctv[16];
#pragma unroll
        for (int g = 0; g < 16; ++g) Ctv[g] = *(const f32x4*)(tc + (size_t)g * 32768);
        f32x4 tsv[8]; float tnv[16]; const bool nrow = (sl == 0 && tid < 128);
#pragma unroll
        for (int g = 0; g < 8; ++g) tsv[g] = *(const f32x4*)(ts + 4 * g);
#pragma unroll
        for (int g = 0; g < 16; ++g) tnv[g] = nrow ? tn[g * 128 + tid] : 0.f;
#pragma unroll
        for (int g = 0; g < 16; ++g) { const float Bt = tsv[g >> 1][2 * (g & 1)], mt = tsv[g >> 1][2 * (g & 1) + 1]; const float mn = fmaxf(Bt + m, mt); const float a = __expf(Bt + m - mn), gg = __expf(mt - mn);
            const f32x4 Ct = Ctv[g]; Cv = Cv * a + Ct * gg; *(f32x4*)(ec + (size_t)g * 32768) = Cv;
            if (nrow) { nv = a * nv + gg * tnv[g]; en[g * 128 + tid] = nv; }
            m = mn; if (sl == 0 && tid == 0) em[g] = m; }
    }
}

DI void p6_merge(const Params& P, int G, int bid) {
    const int tid = my_tid(), wid = __builtin_amdgcn_readfirstlane(tid >> 6), lane = tid & 63;
    const bf16_t* HF = (const bf16_t*)(P.ws + WS_HF); const bf16_t* HB = (const bf16_t*)(P.ws + WS_HB); const bf16_t* OB = (const bf16_t*)(P.ws + WS_O);
    const bf16_t* CB = (const bf16_t*)(P.ws + WS_CB); const bf16_t* CP = (const bf16_t*)(P.ws + WS_CC);
    unsigned char* A2 = (unsigned char*)(P.ws + WS_A2); float* asc = (float*)(P.ws + WS_ASC); const float* ng = P.in[I_NORMG]; const float* cw = P.in[I_CONVW];
    const int c0 = lane * 16;
    float ngv[16], cwv[3][16];
#pragma unroll
    for (int i = 0; i < 16; ++i) { ngv[i] = ng[c0 + i]; cwv[0][i] = cw[c0 + i]; cwv[1][i] = cw[1024 + c0 + i]; cwv[2][i] = cw[2048 + c0 + i]; }
    u32x4 L[14], N[14];
    const int dl = lane < 32 ? 1 : 64;
    auto issue = [&](int row, u32x4 (&R)[14]) {
        R[0] = *(const u32x4*)(HF + (size_t)row * 1024 + c0); R[1] = *(const u32x4*)(HF + (size_t)row * 1024 + c0 + 8);
        R[2] = *(const u32x4*)(HB + (size_t)row * 1024 + c0); R[3] = *(const u32x4*)(HB + (size_t)row * 1024 + c0 + 8);
        R[4] = *(const u32x4*)(OB + (size_t)row * 1024 + c0); R[5] = *(const u32x4*)(OB + (size_t)row * 1024 + c0 + 8);
        const int s_ = row & (SEQ - 1); const bool okl = lane < 32 ? ((s_ & 63) != 0) : (s_ >= 64); const bool okr = lane < 32 ? ((s_ & 63) != 63) : (s_ < SEQ - 64);
#pragma unroll
        for (int tpos = 0; tpos < 3; ++tpos) { const bool ok = tpos == 0 ? okl : (tpos == 2 ? okr : true);
            const size_t rr = (size_t)(row + (ok ? (tpos - 1) * dl : 0)) * 1024 + c0; R[6 + 2 * tpos] = *(const u32x4*)(CP + rr); R[7 + 2 * tpos] = *(const u32x4*)(CP + rr + 8); }
        R[12] = *(const u32x4*)(CB + (size_t)row * 1024 + c0); R[13] = *(const u32x4*)(CB + (size_t)row * 1024 + c0 + 8); };
    int row = bid * 8 + wid;
    if (row < T) issue(row, L);
    for (; row < T; row += G * 8) {
        const int nrow = row + G * 8;
        issue(nrow < T ? nrow : row, N);
        asm volatile("" ::: "memory");
        float y[16], z[16];
        { const u32x4 f0 = L[0], f1 = L[1], b0 = L[2], b1 = L[3], o0 = L[4], o1 = L[5];
          float hv[16], ov[16];
#pragma unroll
          for (int i = 0; i < 4; ++i) { hv[2 * i] = bf_lo(f0[i]) + bf_lo(b0[i]); hv[2 * i + 1] = bf_hi(f0[i]) + bf_hi(b0[i]); hv[8 + 2 * i] = bf_lo(f1[i]) + bf_lo(b1[i]); hv[8 + 2 * i + 1] = bf_hi(f1[i]) + bf_hi(b1[i]);
              ov[2 * i] = bf_lo(o0[i]); ov[2 * i + 1] = bf_hi(o0[i]); ov[8 + 2 * i] = bf_lo(o1[i]); ov[8 + 2 * i + 1] = bf_hi(o1[i]); }
          float ss = 0.f;
#pragma unroll
          for (int i = 0; i < 16; ++i) ss += hv[i] * hv[i];
          ss = row16_sum(ss);
          const float rs = 1.0f / sqrtf(ss * (1.0f / 256.0f) + EPS);
#pragma unroll
          for (int i = 0; i < 16; ++i) y[i] = hv[i] * rs * ngv[i] * (1.0f / (1.0f + __expf(-ov[i]))); }
        { const int s_ = row & (SEQ - 1); const bool okl = lane < 32 ? ((s_ & 63) != 0) : (s_ >= 64); const bool okr = lane < 32 ? ((s_ & 63) != 63) : (s_ < SEQ - 64);
          float acc[16];
#pragma unroll
          for (int i = 0; i < 16; ++i) acc[i] = 0.f;
#pragma unroll
          for (int tpos = 0; tpos < 3; ++tpos) { const u32x4 a0 = L[6 + 2 * tpos], a1 = L[7 + 2 * tpos]; const float m = tpos == 0 ? (okl ? 1.0f : 0.0f) : (tpos == 2 ? (okr ? 1.0f : 0.0f) : 1.0f);
#pragma unroll
              for (int i = 0; i < 4; ++i) { acc[2 * i] += m * cwv[tpos][2 * i] * bf_lo(a0[i]); acc[2 * i + 1] += m * cwv[tpos][2 * i + 1] * bf_hi(a0[i]);
                  acc[8 + 2 * i] += m * cwv[tpos][8 + 2 * i] * bf_lo(a1[i]); acc[8 + 2 * i + 1] += m * cwv[tpos][8 + 2 * i + 1] * bf_hi(a1[i]); } }
          const u32x4 g0 = L[12], g1 = L[13];
#pragma unroll
          for (int i = 0; i < 4; ++i) { z[2 * i] = acc[2 * i] * bf_lo(g0[i]); z[2 * i + 1] = acc[2 * i + 1] * bf_hi(g0[i]); z[8 + 2 * i] = acc[8 + 2 * i] * bf_lo(g1[i]); z[8 + 2 * i + 1] = acc[8 + 2 * i + 1] * bf_hi(g1[i]); } }
        float mx = 0.f;
#pragma unroll
        for (int i = 0; i < 16; ++i) mx = fmaxf(mx, fmaxf(fabsf(y[i]), fabsf(z[i])));
        mx = wave_max(mx);
        const float inv = mx > 0.f ? 127.0f / mx : 0.f;
        if (lane == 0) asc[row] = mx > 0.f ? mx * (1.0f / 127.0f) : 1.0f;
        u32x4 w0, w1;
        w0.x = pk4i8(__builtin_rintf(y[0] * inv), __builtin_rintf(y[1] * inv), __builtin_rintf(y[2] * inv), __builtin_rintf(y[3] * inv)); w0.y = pk4i8(__builtin_rintf(y[4] * inv), __builtin_rintf(y[5] * inv), __builtin_rintf(y[6] * inv), __builtin_rintf(y[7] * inv));
        w0.z = pk4i8(__builtin_rintf(y[8] * inv), __builtin_rintf(y[9] * inv), __builtin_rintf(y[10] * inv), __builtin_rintf(y[11] * inv)); w0.w = pk4i8(__builtin_rintf(y[12] * inv), __builtin_rintf(y[13] * inv), __builtin_rintf(y[14] * inv), __builtin_rintf(y[15] * inv));
        w1.x = pk4i8(__builtin_rintf(z[0] * inv), __builtin_rintf(z[1] * inv), __builtin_rintf(z[2] * inv), __builtin_rintf(z[3] * inv)); w1.y = pk4i8(__builtin_rintf(z[4] * inv), __builtin_rintf(z[5] * inv), __builtin_rintf(z[6] * inv), __builtin_rintf(z[7] * inv));
        w1.z = pk4i8(__builtin_rintf(z[8] * inv), __builtin_rintf(z[9] * inv), __builtin_rintf(z[10] * inv), __builtin_rintf(z[11] * inv)); w1.w = pk4i8(__builtin_rintf(z[12] * inv), __builtin_rintf(z[13] * inv), __builtin_rintf(z[14] * inv), __builtin_rintf(z[15] * inv));
        *(u32x4*)(A2 + (size_t)row * D + c0) = w0; *(u32x4*)(A2 + (size_t)row * D + 1024 + c0) = w1;
#pragma unroll
        for (int i = 0; i < 14; ++i) L[i] = N[i];
    }
}

DI void topk_block256(const Params& P, LAS unsigned char* lds, int row0) {
    const int tid = my_tid();
    LAS unsigned* lc = (LAS unsigned*)lds; LAS unsigned* lbase = lc + 32;
    const float* logits = (const float*)(P.ws + WS_LOGITS); unsigned* gc = (unsigned*)(P.ws + WS_CTL) + CW_GCNT;
    int* list = (int*)(P.ws + WS_LIST); float* listw = (float*)(P.ws + WS_LISTW);
    if (tid < 32) lc[tid] = 0u;
    __syncthreads();
    const bool act = tid < 256; const int tok = row0 + (act ? tid : 0);
    float v[32];
#pragma unroll
    for (int i = 0; i < 8; ++i) { const f32x4 t = *(const f32x4*)(logits + (size_t)tok * NE + 4 * i); v[4 * i] = t[0]; v[4 * i + 1] = t[1]; v[4 * i + 2] = t[2]; v[4 * i + 3] = t[3]; }
    int idx[4]; float val[4];
#pragma unroll
    for (int k = 0; k < 4; ++k) { float best = -3.0e38f; int bi = 0;
#pragma unroll
        for (int e = 0; e < 32; ++e) { const bool taken = (k > 0 && idx[0] == e) || (k > 1 && idx[1] == e) || (k > 2 && idx[2] == e); if (!taken && v[e] > best) { best = v[e]; bi = e; } }
        idx[k] = bi; val[k] = best; }
    float w[4]; float sum = 0.f;
#pragma unroll
    for (int k = 0; k < 4; ++k) { w[k] = __expf(val[k] - val[0]); sum += w[k]; }
    const float inv = 1.0f / sum;
    unsigned rank[4] = {0u, 0u, 0u, 0u};
    if (act) {
#pragma unroll
        for (int k = 0; k < 4; ++k) rank[k] = atomicAdd((unsigned*)&lc[idx[k]], 1u); }
    __syncthreads();
    if (tid < 32) lbase[tid] = __hip_atomic_fetch_add(gc + tid, lc[tid], __ATOMIC_RELAXED, __HIP_MEMORY_SCOPE_AGENT);
    __syncthreads();
    if (act) {
#pragma unroll
        for (int k = 0; k < 4; ++k) { const unsigned pos = lbase[idx[k]] + rank[k]; list[(size_t)idx[k] * T + pos] = tok * 4 + k; listw[(size_t)idx[k] * T + pos] = w[k] * inv; } }
    __syncthreads();
}
DI void p8_topk(const Params& P, LAS unsigned char* lds, int G, int bid) {
    const int tid = my_tid();
    LAS unsigned* lc = (LAS unsigned*)lds; LAS unsigned* lbase = lc + 32;
    const float* logits = (const float*)(P.ws + WS_LOGITS); unsigned* gc = (unsigned*)(P.ws + WS_CTL) + CW_GCNT;
    int* list = (int*)(P.ws + WS_LIST); float* listw = (float*)(P.ws + WS_LISTW);
    for (int blk = bid; blk < T / 512; blk += G) {
        __syncthreads();
        if (tid < 32) lc[tid] = 0u;
        __syncthreads();
        const int tok = blk * 512 + tid;
        float v[32];
#pragma unroll
        for (int i = 0; i < 8; ++i) { const f32x4 t = *(const f32x4*)(logits + (size_t)tok * NE + 4 * i); v[4 * i] = t[0]; v[4 * i + 1] = t[1]; v[4 * i + 2] = t[2]; v[4 * i + 3] = t[3]; }
        int idx[4]; float val[4];
#pragma unroll
        for (int k = 0; k < 4; ++k) { float best = -3.0e38f; int bi = 0;
#pragma unroll
            for (int e = 0; e < 32; ++e) { const bool taken = (k > 0 && idx[0] == e) || (k > 1 && idx[1] == e) || (k > 2 && idx[2] == e); if (!taken && v[e] > best) { best = v[e]; bi = e; } }
            idx[k] = bi; val[k] = best; }
        float w[4]; float sum = 0.f;
#pragma unroll
        for (int k = 0; k < 4; ++k) { w[k] = __expf(val[k] - val[0]); sum += w[k]; }
        const float inv = 1.0f / sum;
        unsigned rank[4];
#pragma unroll
        for (int k = 0; k < 4; ++k) rank[k] = atomicAdd((unsigned*)&lc[idx[k]], 1u);
        __syncthreads();
        if (tid < 32) lbase[tid] = __hip_atomic_fetch_add(gc + tid, lc[tid], __ATOMIC_RELAXED, __HIP_MEMORY_SCOPE_AGENT);
        __syncthreads();
#pragma unroll
        for (int k = 0; k < 4; ++k) { const unsigned pos = lbase[idx[k]] + rank[k]; list[(size_t)idx[k] * T + pos] = tok * 4 + k; listw[(size_t)idx[k] * T + pos] = w[k] * inv; }
    }
    __syncthreads();
}
DI void p8_gather(const Params& P, LAS unsigned char* lds, int G, int bid) {
    const int tid = my_tid(), wid = __builtin_amdgcn_readfirstlane(tid >> 6), lane = tid & 63;
    const LAS int* tab = (const LAS int*)(lds + LDS_CTL_OFF + 64);
    const unsigned char* XN2 = (const unsigned char*)(P.ws + WS_XN8); unsigned char* XG = (unsigned char*)(P.ws + WS_XG); const int* list = (const int*)(P.ws + WS_LIST);
    const int nrows = __builtin_amdgcn_readfirstlane(tab[64]) * 256; const int nw = G * 8; const int per = (((nrows + nw - 1) / nw) + 7) & ~7;
    const int r0 = (bid * 8 + wid) * per; const int r1 = (r0 + per) < nrows ? (r0 + per) : nrows;
#pragma unroll 1
    for (int R0 = r0; R0 < r1; R0 += 64) {
        const int R = R0 + lane; int tokv = 0;
        if (R < r1) { const int tile = R >> 8; int e = 0;
            for (int k = 1; k < 32; ++k) if (tile >= tab[32 + k]) e = k;
            const int pos = R - tab[32 + e] * 256; tokv = pos < tab[e] ? (list[(size_t)e * T + pos] >> 2) : 0; }
        const int nr = (r1 - R0) < 64 ? (r1 - R0) : 64;
#pragma unroll 1
        for (int rb = 0; rb < nr; rb += 8) { u32x4 v[8][2];
#pragma unroll
            for (int q = 0; q < 8; ++q) { const int tok = __shfl(tokv, rb + q); const u32x4* src = (const u32x4*)(XN2 + (size_t)tok * D); v[q][0] = src[lane]; v[q][1] = src[lane + 64]; }
#pragma unroll
            for (int q = 0; q < 8; ++q) { u32x4* dst = (u32x4*)(XG + (size_t)(R0 + rb + q) * D); dst[lane] = v[q][0]; dst[lane + 64] = v[q][1]; } }
    }
}

DI void p11_final(const Params& P, int G, int bid) {
    const int tid = my_tid(), wid = __builtin_amdgcn_readfirstlane(tid >> 6), lane = tid & 63;
    const bf16_t* X1 = (const bf16_t*)(P.ws + WS_X1); const unsigned char* YS = (const unsigned char*)(P.ws + WS_YS); const float* modf = (const float*)(P.ws + WS_MODF); const float* gfin = P.in[I_GFIN];
    for (int row = (bid * 8 + wid) * 2; row < T; row += G * 16) {
        const float* gt = modf + (size_t)(row / SEQ) * NMOD + 5 * D;
        f32x4 va[8], vb[8]; float sa = 0.f, sb = 0.f;
#pragma unroll
        for (int j = 0; j < 4; ++j) { const int c = 512 * j + 8 * lane; f32x4 m0 = {0.f, 0.f, 0.f, 0.f}, m1 = m0, n0 = m0, n1 = m0;
#pragma unroll
            for (int k = 0; k < 4; ++k) { const u32x2 y = *(const u32x2*)(YS + ((size_t)row * 4 + k) * D + c), z = *(const u32x2*)(YS + ((size_t)(row + 1) * 4 + k) * D + c);
                const f32x2 a = __builtin_amdgcn_cvt_pk_f32_fp8((int)y.x, false), b = __builtin_amdgcn_cvt_pk_f32_fp8((int)y.x, true), cc = __builtin_amdgcn_cvt_pk_f32_fp8((int)y.y, false), d = __builtin_amdgcn_cvt_pk_f32_fp8((int)y.y, true);
                m0[0] += a[0]; m0[1] += a[1]; m0[2] += b[0]; m0[3] += b[1]; m1[0] += cc[0]; m1[1] += cc[1]; m1[2] += d[0]; m1[3] += d[1];
                const f32x2 a2 = __builtin_amdgcn_cvt_pk_f32_fp8((int)z.x, false), b2 = __builtin_amdgcn_cvt_pk_f32_fp8((int)z.x, true), c2 = __builtin_amdgcn_cvt_pk_f32_fp8((int)z.y, false), d2 = __builtin_amdgcn_cvt_pk_f32_fp8((int)z.y, true);
                n0[0] += a2[0]; n0[1] += a2[1]; n0[2] += b2[0]; n0[3] += b2[1]; n1[0] += c2[0]; n1[1] += c2[1]; n1[2] += d2[0]; n1[3] += d2[1]; }
            f32x4 x0, x1v, y0, y1v; unpack8(*(const u32x4*)(X1 + (size_t)row * D + c), x0, x1v); unpack8(*(const u32x4*)(X1 + (size_t)(row + 1) * D + c), y0, y1v);
            const f32x4 g0 = *(const f32x4*)(gt + c), g1 = *(const f32x4*)(gt + c + 4);
            va[2 * j] = x0 + g0 * m0; va[2 * j + 1] = x1v + g1 * m1; vb[2 * j] = y0 + g0 * n0; vb[2 * j + 1] = y1v + g1 * n1;
            sa += (va[2 * j][0] * va[2 * j][0] + va[2 * j][1] * va[2 * j][1]) + (va[2 * j][2] * va[2 * j][2] + va[2 * j][3] * va[2 * j][3]) + (va[2 * j + 1][0] * va[2 * j + 1][0] + va[2 * j + 1][1] * va[2 * j + 1][1]) + (va[2 * j + 1][2] * va[2 * j + 1][2] + va[2 * j + 1][3] * va[2 * j + 1][3]);
            sb += (vb[2 * j][0] * vb[2 * j][0] + vb[2 * j][1] * vb[2 * j][1]) + (vb[2 * j][2] * vb[2 * j][2] + vb[2 * j][3] * vb[2 * j][3]) + (vb[2 * j + 1][0] * vb[2 * j + 1][0] + vb[2 * j + 1][1] * vb[2 * j + 1][1]) + (vb[2 * j + 1][2] * vb[2 * j + 1][2] + vb[2 * j + 1][3] * vb[2 * j + 1][3]); }
        const float ra = 1.0f / sqrtf(wave_sum(sa) * (1.0f / D) + EPS), rb = 1.0f / sqrtf(wave_sum(sb) * (1.0f / D) + EPS);
#pragma unroll
        for (int j = 0; j < 4; ++j) { const int c = 512 * j + 8 * lane; const f32x4 f0 = *(const f32x4*)(gfin + c), f1 = *(const f32x4*)(gfin + c + 4);
            *(f32x4*)(P.out + (size_t)row * D + c) = va[2 * j] * ra * f0; *(f32x4*)(P.out + (size_t)row * D + c + 4) = va[2 * j + 1] * ra * f1;
            *(f32x4*)(P.out + (size_t)(row + 1) * D + c) = vb[2 * j] * rb * f0; *(f32x4*)(P.out + (size_t)(row + 1) * D + c + 4) = vb[2 * j + 1] * rb * f1; }
    }
}

__global__ void __launch_bounds__(512, 2) hymba_fwd(Params P) {
    LAS unsigned char* lds = (LAS unsigned char*)lds_raw;
    const int G = gridDim.x, bid = blockIdx.x;
    { const int t0 = threadIdx.x;
      for (int u = t0; u < 256; u += 512) ((LAS unsigned*)(lds + LDS_CTL_OFF))[u] = 0u;
      if ((t0 & 63) == 0) ((LAS int*)(lds + LDS_CTL_OFF + 1024))[hw_wave_slot()] = t0 >> 6; }
    __syncthreads();
#if MK_ONE_LAUNCH
    (void)xcd_barrier_post((unsigned*)(P.ws + WS_CTL) + CW_BAR, (volatile LAS unsigned*)(lds + LDS_CTL_OFF));
#define GRID_BAR() do { XcdBarrier b_; b_.bar = (unsigned*)(P.ws + WS_CTL) + CW_BAR; b_.x = xb_xcc_id(); b_.st = (volatile LAS unsigned*)(lds + LDS_CTL_OFF); xcd_barrier(b_); } while (0)
#else
#define GRID_BAR() do {} while (0)
#endif
    const int lo = P.ph_lo, hi = P.ph_hi;
#ifndef PH_MASK
#define PH_MASK 0x1fff
#endif
#define IN(k) (((PH_MASK >> (k)) & 1) && lo <= (k) && (k) < hi)
#define SEAM(k) do { if (IN(k) && IN((k) + 1)) GRID_BAR(); } while (0)

#ifndef REP_MASK
#define REP_MASK 0
#endif
#define PHASE(k, ...) do { if (IN(k)) { __VA_ARGS__ if ((REP_MASK >> (k)) & 1) { GRID_BAR(); __VA_ARGS__ } } SEAM(k); } while (0)
    const bool slots = (G == 256); constexpr int NG_IN = 176;
    PHASE(0, { p0_adaln(P, lds, G, bid); p0_small_rows(P, G, bid); p0_w_int8<true>(P, lds, G, bid, 0); p0_w_int8<false>(P, lds, G, bid, G >= 256 ? 192 : 0); __syncthreads(); if (!slots) conv_experts(P, lds, bid * 8 + wave_in_wg(), G * 8, 0, CV_ITEMS); });
    PHASE(1, { p1_modulate(P, lds, G, bid); });
    PHASE(2, { const int ng = slots ? NG_IN : G;
               if (bid < ng) { SchedIn S{P.ws, ng, bid}; pg8::EpiStore E{P.in[I_BIF], (const float*)(P.ws + WS_XSC), (const float*)(P.ws + WS_WSC)}; pg8::gemm_phase<pg8::EpiStore, SchedIn, true, true, 2>(lds, P.ws, D, S, E); }
               if (slots) conv_pool(P, lds, 0, 0, CV_NBLK_A); });
    PHASE(3, { for (int it = bid; it < 256; it += G) mlstm_pass1(P, lds, it >> 4, it & 15); });
    PHASE(4, { p4_scan(P, G, bid); });
    PHASE(5, { for (int it = bid; it < 256; it += G) { if (it >> 7) mlstm_item<true, 1>(P, lds, it >> 4, it & 15); else mlstm_item<true, 0>(P, lds, it >> 4, it & 15); } });
    PHASE(6, { p6_merge(P, G, bid); });
    PHASE(7, { SchedOut S{P.ws, G, bid}; pg8::EpiX1q E{P.in[I_X], (bf16_t*)(P.ws + WS_X1), (const float*)(P.ws + WS_MODF), (const float*)(P.ws + WS_ASC), (const float*)(P.ws + WS_WOSC)}; pg8::gemm_phase<pg8::EpiX1q, SchedOut, true, true, 2>(lds, P.ws, D, S, E); });
    PHASE(8, { p8_modulate(P, lds, G, bid); });
    PHASE(9, { SchedRouter S{P.ws, G, bid}; pg8::EpiLogits E{P.in[I_BR], (const float*)(P.ws + WS_RSTD), (const float*)(P.ws + WS_CBR)}; pg8::gemm_phase<pg8::EpiLogits, SchedRouter, true, true>(lds, P.ws, 2 * D, S, E);
               if (slots && bid >= 128) conv_pool(P, lds, 1, CV_NBLK_A, CV_NBLK_ALL);
               asm volatile("s_waitcnt vmcnt(0)" ::: "memory"); __syncthreads();
               for (int L = bid; L < 128; L += G) topk_block256(P, lds, L * 256); });
    PHASE(10, { moe_tables(P, lds, 16, G, bid); SchedMoeT<true> S{P.ws, (const LAS int*)(lds + LDS_CTL_OFF + 64), 0}; pg8::EpiAct E{P.in[I_BGU]}; pg8::gemm_phase<pg8::EpiAct, SchedMoeT<true>, true, true, 1>(lds, P.ws, D, S, E); });
    PHASE(11, { moe_tables(P, lds, 8, G, bid); SchedMoe S{P.ws, (const LAS int*)(lds + LDS_CTL_OFF + 64), 1}; pg8::EpiDown E{P.in[I_BDN], (unsigned char*)(P.ws + WS_YS)}; pg8::gemm_phase<pg8::EpiDown, SchedMoe, true, true, 1>(lds, P.ws, D, S, E); });
    PHASE(12, { p11_final(P, G, bid); });
#undef PHASE
#undef IN
#undef SEAM
}

extern "C" void kernel_launch(void* const* d_in, const int* in_sizes, int n_in, void* d_out, int out_size, void* d_ws, size_t ws_size, hipStream_t stream) {
    static int grid = 0;
    if (grid == 0) {
        if (n_in != 20 || out_size != T * D || ws_size < WS_END) { fprintf(stderr, "kernel_launch: unexpected shapes (n_in %d, out %d, ws %zu < %zu)\n", n_in, out_size, ws_size, (size_t)WS_END); grid = -1; return; }
        int dev = 0, cus = 0, per_cu = 0;
        if (hipGetDevice(&dev) != hipSuccess || hipDeviceGetAttribute(&cus, hipDeviceAttributeMultiprocessorCount, dev) != hipSuccess) { grid = -1; return; }
        if (hipFuncSetAttribute((const void*)hymba_fwd, hipFuncAttributeMaxDynamicSharedMemorySize, LDS_BYTES) != hipSuccess) { fprintf(stderr, "kernel_launch: hipFuncSetAttribute failed\n"); grid = -1; return; }
        if (hipOccupancyMaxActiveBlocksPerMultiprocessor(&per_cu, (const void*)hymba_fwd, 512, LDS_BYTES) != hipSuccess || per_cu < 1) fprintf(stderr, "kernel_launch: occupancy query reports %d\n", per_cu);
        (void)hipGetLastError();
        grid = cus;
    }
    if (grid < 0) return;
    (void)hipMemsetAsync((char*)d_ws + WS_CTL, 0, CTL_ZERO_BYTES, stream);
    Params p{};
    for (int i = 0; i < 20; ++i) p.in[i] = (const float*)d_in[i];
    p.out = (float*)d_out; p.ws = (unsigned char*)d_ws;
#if MK_ONE_LAUNCH
    p.ph_lo = 0; p.ph_hi = NPH;
    hipLaunchKernelGGL(hymba_fwd, dim3(grid), dim3(512), LDS_BYTES, stream, p);
#else
    for (int k = 0; k < NPH; ++k) { p.ph_lo = k; p.ph_hi = k + 1; hipLaunchKernelGGL(hymba_fwd, dim3(grid), dim3(512), LDS_BYTES, stream, p); }
#endif
}
```

```cpp
#include <hip/hip_runtime.h>
#include <cstdio>
#include <cstdint>

#ifndef MK_ONE_LAUNCH
#define MK_ONE_LAUNCH 1
#endif

#define DI __device__ __forceinline__
#define LAS __attribute__((address_space(3)))
typedef unsigned short bf16_t;
typedef short bf16x8 __attribute__((ext_vector_type(8)));
typedef short s16x4 __attribute__((ext_vector_type(4)));
typedef float f32x4 __attribute__((ext_vector_type(4)));
typedef float f32x2 __attribute__((ext_vector_type(2)));
typedef float f32x16 __attribute__((ext_vector_type(16)));
typedef unsigned u32x4 __attribute__((ext_vector_type(4)));
typedef unsigned u32x2 __attribute__((ext_vector_type(2)));
typedef __bf16 bf16x2_t __attribute__((ext_vector_type(2)));

constexpr int LDS_CTL_OFF = 147456;
constexpr int LDS_BYTES = LDS_CTL_OFF + 6144;
extern __shared__ __attribute__((aligned(16))) unsigned char lds_raw[];
DI int lane_id() { int l; asm volatile("v_mbcnt_lo_u32_b32 %0, -1, 0\n\tv_mbcnt_hi_u32_b32 %0, -1, %0" : "=v"(l)); return l; }
DI unsigned hw_wave_slot() { return (unsigned)__builtin_amdgcn_s_getreg((5 << 11) | 4) & 63u; }
DI int wave_in_wg() { return __builtin_amdgcn_readfirstlane(((const LAS int*)((LAS unsigned char*)lds_raw + LDS_CTL_OFF + 1024))[hw_wave_slot()]); }
DI int my_tid() { return wave_in_wg() * 64 + lane_id(); }
DI unsigned pk2(float a, float b) { f32x2 f = {a, b}; bf16x2_t h = __builtin_convertvector(f, bf16x2_t); return __builtin_bit_cast(unsigned, h); }
constexpr float WSCALE = 512.0f, WSCALE_INV = 1.0f / 512.0f;
DI unsigned pk4f8(float a, float b, float c, float d) { int p = __builtin_amdgcn_cvt_pk_fp8_f32(a, b, 0, false); p = __builtin_amdgcn_cvt_pk_fp8_f32(c, d, p, true); return (unsigned)p; }
DI unsigned pk4i8(float a, float b, float c, float d) {
    const int qa = (int)a, qb = (int)b, qc = (int)c, qd = (int)d; return (unsigned)(qa & 255) | ((unsigned)(qb & 255) << 8) | ((unsigned)(qc & 255) << 16) | ((unsigned)qd << 24); }
DI float bf_lo(unsigned w) { return __uint_as_float(w << 16); }
DI float bf_hi(unsigned w) { return __uint_as_float(w & 0xffff0000u); }
DI float bf2f(unsigned short s) { return __uint_as_float(((unsigned)s) << 16); }

constexpr int D = 2048, NB = 2, SEQ = 16384, T = NB * SEQ, CTXL = 256, TC = NB * CTXL, MT = T + TC;
constexpr int P_IN = 6160, GATE_COL0 = 3072, NMOD = 6 * D;
constexpr int NE = 32, TOPK = 4;
constexpr int NCHUNK = SEQ / 128;
constexpr float EPS = 1e-6f;
constexpr int NPH = 13;

constexpr size_t MiB = 1u << 20;
constexpr size_t WS_CTL = 0, CTL_ZERO_BYTES = 1 * MiB;
constexpr size_t WS_MODP = 1 * MiB;
constexpr size_t WS_MODF = WS_MODP + 768 * 1024;
constexpr size_t WS_WIN = 2 * MiB;
constexpr size_t WS_WOUT = 27 * MiB;
constexpr size_t WS_WR = 35 * MiB;
constexpr size_t WS_WGU = 36 * MiB;
constexpr size_t WS_WDN = 292 * MiB;
constexpr size_t WS_XN = 420 * MiB;
constexpr size_t WS_GATES = 550 * MiB;
constexpr size_t WS_XSC = WS_GATES + 3 * MiB;
constexpr size_t WS_WSC = WS_GATES + 3 * MiB + 256 * 1024;
constexpr size_t WS_Q = 554 * MiB;
constexpr size_t WS_K = 586 * MiB;
constexpr size_t WS_VT = 619 * MiB;
constexpr size_t WS_O = 684 * MiB;
constexpr size_t WS_CB = 748 * MiB, WS_CC = 812 * MiB, WS_CX = 876 * MiB;
constexpr size_t WS_TUPC = 940 * MiB;
constexpr size_t WS_TUPN = 972 * MiB;
constexpr size_t WS_ENTC = 973 * MiB;
constexpr size_t WS_ENTN = 1005 * MiB;
constexpr size_t WS_HF = 1006 * MiB, WS_HB = 1070 * MiB;
constexpr size_t WS_A2 = 1134 * MiB;
constexpr size_t WS_XG = 1262 * MiB;
constexpr size_t WS_BGU = WS_XG, WS_BDN = WS_XG + 1 * MiB;
constexpr size_t WS_ACT = 1534 * MiB;
constexpr size_t WS_XN8 = 1806 * MiB;
constexpr size_t WS_X1 = 1870 * MiB;
constexpr size_t WS_LOGITS = 2126 * MiB;
constexpr size_t WS_LIST = 2000 * MiB;
constexpr size_t WS_LISTW = 2004 * MiB;
constexpr size_t WS_YS = 2138 * MiB;
constexpr size_t WS_END = 2394 * MiB;
static_assert(WS_ACT + (size_t)139264 * 2048 <= WS_XN8 && WS_XN8 < ((size_t)1 << 31) && WS_X1 + (size_t)T * D * 2 <= WS_LIST && WS_LISTW + 4 * MiB <= ((size_t)1 << 31), "GEMM operands and token lists below 2 GiB");
constexpr int CW_BAR = 4096;
constexpr int CW_GCNT = 16384;
constexpr size_t WS_WOSC = WS_WSC + 32768, WS_ASC = WS_WSC + 262144;
constexpr size_t WS_WR2 = WS_XG + 4 * MiB, WS_RSTD = WS_XG + 8 * MiB, WS_CBR = WS_XG + 9 * MiB;
constexpr int CW_POOL = 20480;


#define XB_TMO      128
#define XB_XCNT(j)  (256  + 64 * (j))
#define XB_XSUB(j)  (1280 + 64 * (j))
#define XB_XGEN(j)  (2304 + 64 * (j))
#define XB_TOP      3328
#define XB_TOPGEN   3392
#define XCD_BAR_WORDS 3456
#define XB_SPIN_CAP (1u << 21)
__device__ __forceinline__ unsigned xb_ld(unsigned* p)              { return __hip_atomic_load(p, __ATOMIC_RELAXED, __HIP_MEMORY_SCOPE_AGENT); }
__device__ __forceinline__ unsigned xb_add(unsigned* p, unsigned v) { return __hip_atomic_fetch_add(p, v, __ATOMIC_RELAXED, __HIP_MEMORY_SCOPE_AGENT); }
__device__ __forceinline__ unsigned xb_xcc_id() { return (unsigned)__builtin_amdgcn_s_getreg((3 << 11) | 20) & 0xFu; }
#define XB_SPIN(cond, bar) do { unsigned _sp = 0; while (cond) { __builtin_amdgcn_s_sleep(1); \
    if ((++_sp & 255u) == 0u) { if (xb_ld(&(bar)[XB_TMO])) break; if (_sp > XB_SPIN_CAP) { atomicAdd(&(bar)[XB_TMO], 1u); break; } } } } while (0)
struct XcdBarrier { unsigned* bar; unsigned x; volatile LAS unsigned* st; };
__device__ __forceinline__ XcdBarrier xcd_barrier_post(unsigned* bar, volatile LAS unsigned* st) {
    XcdBarrier b; b.bar = bar; b.x = xb_xcc_id(); b.st = st;
    if (my_tid() == 0) (void)xb_add(&bar[XB_XCNT(b.x)], 1u);
    return b;
}
__device__ __forceinline__ void xcd_barrier_complete(unsigned* bar, unsigned x, unsigned& nloc, unsigned& nx) {
    const unsigned G = gridDim.x * gridDim.y * gridDim.z;
    unsigned sum, cnt, mine, sp = 0u;
    for (;;) {
        sum = 0u; cnt = 0u; mine = 0u;
#pragma unroll
        for (unsigned j = 0; j < 16; ++j) { const unsigned c = xb_ld(&bar[XB_XCNT(j)]); sum += c; cnt += (c > 0u) ? 1u : 0u; mine = (j == x) ? c : mine; }
        if (sum == G) break;
        __builtin_amdgcn_s_sleep(1);
        if ((++sp & 255u) == 0u) { if (xb_ld(&bar[XB_TMO])) break; if (sp > XB_SPIN_CAP) { atomicAdd(&bar[XB_TMO], 1u); break; } }
    }
    nloc = mine > 0u ? mine : 1u; nx = cnt > 0u ? cnt : 1u;
}
__device__ __forceinline__ void xcd_barrier(const XcdBarrier& b) {
    asm volatile("s_waitcnt vmcnt(0)" ::: "memory");
    __syncthreads();
    if (my_tid() == 0) {
        unsigned* bar = b.bar;
        __builtin_amdgcn_s_waitcnt(0);
        unsigned nloc = b.st[0], nx = b.st[1];
        if (nloc == 0u) { xcd_barrier_complete(bar, b.x, nloc, nx); b.st[0] = nloc; b.st[1] = nx; }
        const unsigned old = xb_add(&bar[XB_XSUB(b.x)], 1u);
        const unsigned gen = old / nloc;
        if (old + 1u == (gen + 1u) * nloc) {
            __builtin_amdgcn_fence(__ATOMIC_RELEASE, "agent");
            asm volatile("s_waitcnt vmcnt(0)" ::: "memory");
            const unsigned og = xb_add(&bar[XB_TOP], 1u);
            const unsigned tg = og / nx;
            if (og + 1u == (tg + 1u) * nx) xb_add(&bar[XB_TOPGEN], 1u);
            else XB_SPIN(xb_ld(&bar[XB_TOPGEN]) == tg, bar);
            __builtin_amdgcn_fence(__ATOMIC_ACQUIRE, "agent");
            xb_add(&bar[XB_XGEN(b.x)], 1u);
            asm volatile("s_waitcnt vmcnt(0)" ::: "memory");
        } else {
            XB_SPIN(xb_ld(&bar[XB_XGEN(b.x)]) == gen, bar);
            __builtin_amdgcn_fence(__ATOMIC_ACQUIRE, "agent");
            asm volatile("s_waitcnt vmcnt(0)" ::: "memory");
        }
    }
    __syncthreads();
}

namespace pg8 {
constexpr int BM = 256, BK = 64, HALF = 128, HTB = HALF * BK * 2, STAGE_BYTES = 8 * HTB, NXCD = 8, WGM = 8;
__host__ __device__ __forceinline__ int lds_byte(int r, int c) { const int st = (r >> 4) * 2 + (c >> 5), rr = r & 15, cc = c & 31, ob = rr * 64 + cc * 2; return st * 1024 + (ob ^ (((ob >> 9) & 1) << 5)); }
__host__ __device__ __forceinline__ void stage_rc(int b, int& R, int& C) { const int st = b / 1024, sb = b % 1024, swz = sb ^ (((sb >> 9) & 1) << 5); R = (st >> 1) * 16 + swz / 64; C = (st & 1) * 32 + (swz % 64) / 2; }
__host__ __device__ __forceinline__ int perm32(int rho) { const int n = rho >> 4, i = rho & 15; return 8 * (i >> 2) + 4 * n + (i & 3); }

struct Unit { unsigned A; unsigned B; char* O; int ldc; int a0; int a1; int buf; };

__device__ __forceinline__ void tile_order(int wgid, int nwg, int nM, int nN, int& pm, int& pn) {
    const int nig = WGM * nN, gid = wgid / nig, fm = gid * WGM, gsz = (nM - fm) < WGM ? (nM - fm) : WGM;
    pm = fm + ((wgid % nig) % gsz); pn = (wgid % nig) / gsz;
}
__device__ __forceinline__ int xcd_remap(int L, int nwg) { const int q = nwg / NXCD, r = nwg % NXCD, xcd = L % NXCD, off = L / NXCD; return (xcd < r ? xcd * (q + 1) : r * (q + 1) + (xcd - r) * q) + off; }

typedef int i32x4_t __attribute__((ext_vector_type(4)));
typedef int i32x8_t __attribute__((ext_vector_type(8)));
__device__ __forceinline__ i32x8_t cat8(bf16x8 a, bf16x8 b) { return __builtin_shufflevector(__builtin_bit_cast(i32x4_t, a), __builtin_bit_cast(i32x4_t, b), 0, 1, 2, 3, 4, 5, 6, 7); }
template <class Epi, class Sched, bool ALIGN_EPI, bool SP2, int DT = 0  >
__device__ __forceinline__ void gemm_phase(LAS unsigned char* lds, const void* wsbase, const int KB, const Sched& S, const Epi& E) {
    constexpr bool F8 = (DT == 1), I8 = (DT == 2);
    const __amdgpu_buffer_rsrc_t rsrc = __builtin_amdgcn_make_buffer_rsrc((void*)wsbase, 0, -1, 0x00020000);
    const int tid = my_tid(), wid = __builtin_amdgcn_readfirstlane(tid >> 6), lane = tid & 63, wr = wid >> 2, wc = wid & 3, fr = lane & 15, fq = lane >> 4;
    const int nt = KB / 128;
    unsigned voffA[2], voffB[2];
#pragma unroll
    for (int i = 0; i < 2; ++i) { int R, C;
        { const int b = tid * 16 + i * 8192; const int p = (b >> 7) & 15, fr_ = ((p & 1) << 3) | (p >> 1); R = (b >> 11) * 16 + fr_; C = ((((b >> 4) & 7) ^ (fr_ & 7))) * 16; }
        const int Rb = Epi::PERM ? ((R & ~31) + perm32(R & 31)) : R;
        voffA[i] = (unsigned)(R * KB + C); voffB[i] = (unsigned)(Rb * KB + C); }
    constexpr bool GATHER = Sched::GATHER;
    unsigned vG[2][2];
    auto load_rows = [&](int buf, int nvalid) { const int t_ = (wid << 6) | lane_id();
#pragma unroll
        for (int i = 0; i < 2; ++i) { const int b = t_ * 16 + i * 8192; const int p = (b >> 7) & 15, fr_ = ((p & 1) << 3) | (p >> 1); const int R = (b >> 11) * 16 + fr_, C = ((((b >> 4) & 7) ^ (fr_ & 7))) * 16;
#pragma unroll
            for (int hh_ = 0; hh_ < 2; ++hh_) { const int rr = hh_ * 128 + R; const unsigned slot = ((const LAS unsigned*)(lds + LDS_CTL_OFF + 2048))[buf * 256 + rr];
                vG[hh_][i] = (rr < nvalid ? (slot >> 2) * (unsigned)KB : 0u) + (unsigned)C; } } };
    constexpr bool ETAB = Sched::ETAB;
    auto dma_etab = [&](const Unit& u_, int buf) {
        if constexpr (ETAB) { if ((wid & ~1) == 4) __builtin_amdgcn_raw_ptr_buffer_load_lds(rsrc, (LAS void*)(lds + LDS_CTL_OFF + 2048 + (wid - 4) * 2048 + buf * 1024), 16, lane_id() * 16, (int)S.etab_off(u_, wid - 4), 0, 0); } };
    constexpr bool BIAS = Sched::BIAS;
    auto dma_bias = [&](const Unit& u_, int buf) {
        if constexpr (BIAS) { if ((wid == 6 || wid == 7) && lane_id() < 32) __builtin_amdgcn_raw_ptr_buffer_load_lds(rsrc, (LAS void*)(lds + LDS_CTL_OFF + 4096 + buf * 1024 + (wid - 6) * 512), 16, lane_id() * 16, (int)S.bias_off(u_, wid - 6), 0, 0); } };
    auto dma_list = [&](unsigned goff, int buf) {
        if (wid == 4) __builtin_amdgcn_raw_ptr_buffer_load_lds(rsrc, (LAS void*)(lds + LDS_CTL_OFF + 2048 + buf * 1024), 16, lane_id() * 16, (int)goff, 0, 0); };
    const unsigned kstep = 128u;
    const unsigned hstep = (unsigned)(HALF * KB);
    const unsigned ldsw = (unsigned)wid * 1024u;
    int aoff[2], boff[2];
#pragma unroll
    for (int x = 0; x < 2; ++x) { const int ch = F8 ? (2 * fq + x) : (fq + 4 * x); const int o = ((((fr & 7) << 1) | (fr >> 3)) << 7) + ((ch ^ (fr & 7)) << 4); aoff[x] = wr * 8192 + o; boff[x] = wc * 4096 + o; }
#define PG8_SA(b, h) (((b) * 2 + (h)) * HTB)
#define PG8_SB(b, h) ((4 + (b) * 2 + (h)) * HTB)
#define PG8_STAGE(bufoff, gbase, voff) do { _Pragma("unroll") for (int _i = 0; _i < 2; ++_i) \
        __builtin_amdgcn_raw_ptr_buffer_load_lds(rsrc, (LAS void*)(lds + (bufoff) + ldsw + _i * 8192), 16, (int)(voff)[_i], (int)(gbase), 0, 0); } while (0)
#define PG8_STAGE_A(bufoff, h, goff) do { if constexpr (GATHER) { PG8_STAGE(bufoff, goff, vG[h]); } else { PG8_STAGE(bufoff, (goff) + (h) * hstep, voffA); } } while (0)
#define PG8_LDA(dst, b, h) do { _Pragma("unroll") for (int m = 0; m < 4; ++m) { \
        if constexpr (F8) dst##8[m] = cat8(*(const LAS bf16x8*)(lds + PG8_SA(b, h) + aoff[0] + m * 2048), *(const LAS bf16x8*)(lds + PG8_SA(b, h) + aoff[1] + m * 2048)); \
        else { _Pragma("unroll") for (int k = 0; k < 2; ++k) dst[m][k] = *(const LAS bf16x8*)(lds + PG8_SA(b, h) + aoff[k] + m * 2048); } } } while (0)
#define PG8_LDB(dst, b, h) do { _Pragma("unroll") for (int n = 0; n < 2; ++n) { \
        if constexpr (F8) dst##8[n] = cat8(*(const LAS bf16x8*)(lds + PG8_SB(b, h) + boff[0] + n * 2048), *(const LAS bf16x8*)(lds + PG8_SB(b, h) + boff[1] + n * 2048)); \
        else { _Pragma("unroll") for (int k = 0; k < 2; ++k) dst[n][k] = *(const LAS bf16x8*)(lds + PG8_SB(b, h) + boff[k] + n * 2048); } } } while (0)
#define PG8_MMA(ai, bj, At, Bt) do { __builtin_amdgcn_s_setprio(1); _Pragma("unroll") for (int m = 0; m < 4; ++m) _Pragma("unroll") for (int n = 0; n < 2; ++n) { \
        if constexpr (F8) { acc[ai][bj][m][n] = __builtin_amdgcn_mfma_scale_f32_16x16x128_f8f6f4(Bt##8[n], At##8[m], acc[ai][bj][m][n], 0, 0, 0, 0, 0, 0); }     \
        else if constexpr (I8) { _Pragma("unroll") for (int k = 0; k < 2; ++k) acc[ai][bj][m][n] = __builtin_bit_cast(f32x4, __builtin_amdgcn_mfma_i32_16x16x64_i8(__builtin_bit_cast(i32x4_t, Bt[n][k]), __builtin_bit_cast(i32x4_t, At[m][k]), __builtin_bit_cast(i32x4_t, acc[ai][bj][m][n]), 0, 0, 0)); } \
        else { _Pragma("unroll") for (int k = 0; k < 2; ++k) acc[ai][bj][m][n] = __builtin_amdgcn_mfma_f32_16x16x32_bf16(Bt[n][k], At[m][k], acc[ai][bj][m][n], 0, 0, 0); } } \
        __builtin_amdgcn_s_setprio(0); } while (0)
#define PG8_WAIT_V(n) asm volatile("s_waitcnt vmcnt(" #n ")" ::: "memory")
#define PG8_WAIT_L(n) asm volatile("s_waitcnt lgkmcnt(" #n ")" ::: "memory")
#define PG8_BAR __builtin_amdgcn_s_barrier()
#define PG8_SCHED __builtin_amdgcn_sched_barrier(0)
    Unit cur, nxt; int ui = 0;
    if (!S.next(0, cur)) return;
    f32x4 acc[2][2][4][2];
#pragma unroll
    for (int a = 0; a < 2; ++a)
#pragma unroll
        for (int b = 0; b < 2; ++b)
#pragma unroll
            for (int m = 0; m < 4; ++m)
#pragma unroll
                for (int n = 0; n < 2; ++n) acc[a][b][m][n] = (f32x4){0.f, 0.f, 0.f, 0.f};
    bf16x8 At[4][2], B0[2][2], B1[2][2]; i32x8_t At8[4], B08[2], B18[2];
    unsigned cA = cur.A, cB = cur.B;
    if constexpr (BIAS) { dma_bias(cur, 0); }
    if constexpr (ETAB) { dma_etab(cur, 0); asm volatile("s_waitcnt vmcnt(0)" ::: "memory"); __builtin_amdgcn_s_barrier(); }
    if constexpr (GATHER) { dma_list(S.list_off(cur), 0); asm volatile("s_waitcnt vmcnt(0)" ::: "memory"); __builtin_amdgcn_s_barrier(); load_rows(0, S.row_cnt(cur)); }
    if constexpr (SP2) {
        PG8_STAGE(PG8_SB(0, 0), cB, voffB); PG8_STAGE(PG8_SB(0, 1), cB + hstep, voffB); PG8_STAGE_A(PG8_SA(0, 0), 0, cA); PG8_STAGE_A(PG8_SA(0, 1), 1, cA);
        if (wr == 1) PG8_BAR;
        PG8_WAIT_V(2); PG8_BAR;
        PG8_STAGE(PG8_SB(1, 0), cB + kstep, voffB); PG8_STAGE_A(PG8_SA(1, 0), 0, cA + kstep); PG8_STAGE(PG8_SB(1, 1), cB + hstep + kstep, voffB);
        PG8_WAIT_V(6); PG8_BAR;
    } else {
        PG8_STAGE(PG8_SB(0, 0), cB, voffB); PG8_STAGE(PG8_SA(0, 0), cA, voffA); PG8_STAGE(PG8_SB(0, 1), cB + hstep, voffB); PG8_STAGE(PG8_SA(0, 1), cA + hstep, voffA);
        if (wr == 1) PG8_BAR;
        PG8_WAIT_V(4); PG8_BAR;
        PG8_STAGE(PG8_SB(1, 0), cB + kstep, voffB); PG8_STAGE(PG8_SA(1, 0), cA + kstep, voffA); PG8_STAGE(PG8_SB(1, 1), cB + hstep + kstep, voffB);
        PG8_WAIT_V(6); PG8_BAR;
    }
    for (;;) {
        const bool has_next = S.next(ui + 1, nxt);
        if constexpr (GATHER) { if (has_next) dma_list(S.list_off(nxt), (ui + 1) & 1); }
        if constexpr (ETAB) { if (has_next) dma_etab(nxt, (ui + 1) & 1); }
        if constexpr (BIAS) { if (has_next) dma_bias(nxt, (ui + 1) & 1); }
        const unsigned nA = has_next ? nxt.A : cA, nB = has_next ? nxt.B : cB;
        for (int t = 0; t < nt; t += 2) {
            const bool last = (t == nt - 2);
            const unsigned a1 = cA + (unsigned)(t + 1) * kstep;
            const unsigned a2 = last ? nA : cA + (unsigned)(t + 2) * kstep, b2 = last ? nB : cB + (unsigned)(t + 2) * kstep;
            const unsigned a3 = a2 + kstep, b3 = b2 + kstep;
            if constexpr (SP2) {
            PG8_LDB(B0, 0, 0); PG8_LDB(B1, 0, 1); PG8_SCHED; PG8_LDA(At, 0, 0); PG8_STAGE_A(PG8_SA(1, 1), 1, a1);
            if constexpr (GATHER) { if (last && has_next) load_rows((ui + 1) & 1, S.row_cnt(nxt)); }
            PG8_WAIT_V(8); PG8_WAIT_L(0); PG8_BAR; PG8_MMA(0, 0, At, B0); PG8_MMA(0, 1, At, B1); PG8_BAR; PG8_SCHED;
            PG8_LDA(At, 0, 1); PG8_STAGE(PG8_SB(0, 0), b2, voffB); PG8_STAGE(PG8_SB(0, 1), b2 + hstep, voffB); PG8_STAGE_A(PG8_SA(0, 0), 0, a2);
            PG8_WAIT_V(8); PG8_WAIT_L(0); PG8_BAR; PG8_MMA(1, 0, At, B0); PG8_MMA(1, 1, At, B1); PG8_BAR; PG8_SCHED;
            PG8_LDB(B0, 1, 0); PG8_LDB(B1, 1, 1); PG8_SCHED; PG8_LDA(At, 1, 0); PG8_STAGE_A(PG8_SA(0, 1), 1, a2);
            PG8_WAIT_V(8); PG8_WAIT_L(0); PG8_BAR; PG8_MMA(0, 0, At, B0); PG8_MMA(0, 1, At, B1); PG8_BAR; PG8_SCHED;
            PG8_LDA(At, 1, 1); PG8_STAGE(PG8_SB(1, 0), b3, voffB); PG8_STAGE(PG8_SB(1, 1), b3 + hstep, voffB); PG8_STAGE_A(PG8_SA(1, 0), 0, a3);
            PG8_WAIT_V(8); PG8_WAIT_L(0); PG8_BAR; PG8_MMA(1, 0, At, B0); PG8_MMA(1, 1, At, B1); PG8_BAR; PG8_SCHED;
            } else {
            PG8_LDB(B0, 0, 0); PG8_SCHED; PG8_LDA(At, 0, 0); PG8_STAGE(PG8_SA(1, 1), a1 + hstep, voffA);
            PG8_WAIT_L(8); PG8_BAR; PG8_WAIT_L(0); PG8_MMA(0, 0, At, B0); PG8_BAR; PG8_SCHED;
            PG8_LDB(B1, 0, 1); PG8_STAGE(PG8_SB(0, 0), b2, voffB);
            PG8_BAR; PG8_WAIT_L(0); PG8_MMA(0, 1, At, B1); PG8_BAR;
            PG8_LDA(At, 0, 1); PG8_STAGE(PG8_SA(0, 0), a2, voffA);
            PG8_BAR; PG8_WAIT_L(0); PG8_MMA(1, 0, At, B0); PG8_BAR; PG8_SCHED;
            PG8_STAGE(PG8_SB(0, 1), b2 + hstep, voffB);
            PG8_WAIT_V(6); PG8_BAR; PG8_MMA(1, 1, At, B1); PG8_BAR;
            PG8_LDB(B0, 1, 0); PG8_SCHED; PG8_LDA(At, 1, 0); PG8_STAGE(PG8_SA(0, 1), a2 + hstep, voffA);
            PG8_WAIT_L(8); PG8_BAR; PG8_WAIT_L(0); PG8_MMA(0, 0, At, B0); PG8_BAR; PG8_SCHED;
            PG8_LDB(B1, 1, 1); PG8_STAGE(PG8_SB(1, 0), b3, voffB);
            PG8_BAR; PG8_WAIT_L(0); PG8_MMA(0, 1, At, B1); PG8_BAR;
            PG8_LDA(At, 1, 1); PG8_STAGE(PG8_SA(1, 0), a3, voffA);
            PG8_BAR; PG8_WAIT_L(0); PG8_MMA(1, 0, At, B0); PG8_BAR; PG8_SCHED;
            PG8_STAGE(PG8_SB(1, 1), b3 + hstep, voffB);
            PG8_WAIT_V(6); PG8_BAR; PG8_MMA(1, 1, At, B1); PG8_BAR;
            }
        }
        if constexpr (ALIGN_EPI) { if (wr == 0) PG8_BAR; }
        { int l2 = lane_id(); asm volatile("" : "+v"(l2)); cur.buf = ui & 1; E(acc, cur, wr, wc, l2 & 15, l2 >> 4); }
        if (!has_next) break;
#pragma unroll
        for (int a = 0; a < 2; ++a)
#pragma unroll
            for (int b = 0; b < 2; ++b)
#pragma unroll
                for (int m = 0; m < 4; ++m)
#pragma unroll
                    for (int n = 0; n < 2; ++n) acc[a][b][m][n] = (f32x4){0.f, 0.f, 0.f, 0.f};
        cur = nxt; cA = nA; cB = nB; ++ui;
        if constexpr (ALIGN_EPI) { if (wr == 1) PG8_BAR; }
    }
    PG8_WAIT_V(0);
    if constexpr (!ALIGN_EPI) { if (wr == 0) PG8_BAR; }
    PG8_BAR;
#undef PG8_SA
#undef PG8_SB
#undef PG8_STAGE
#undef PG8_LDA
#undef PG8_STAGE_A
#undef PG8_LDB
#undef PG8_MMA
#undef PG8_WAIT_V
#undef PG8_WAIT_L
#undef PG8_BAR
#undef PG8_SCHED
}

struct EpiStore {
    static constexpr bool PERM = true;
    const float* bif; const float* xsc; const float* wsc;
    __device__ __forceinline__ void operator()(const f32x4 (&acc)[2][2][4][2], const Unit& u, int wr, int wc, int fr, int fq) const {
        const bool swapped = (u.a1 >= 4 && u.a1 < 8);
        const float* sA = swapped ? wsc + u.a1 * BM : xsc + u.a0 * BM; const float* sB = swapped ? xsc + u.a0 * BM : wsc + u.a1 * BM;
        const int row0 = wr * 64 + fr, col0 = wc * 32 + 8 * fq;
        if (u.ldc == 0) {
            if (wc == 0 && fq < 2) { float* g = (float*)u.O; const f32x4 b0 = *(const f32x4*)(bif + 8 * fq), b1 = *(const f32x4*)(bif + 8 * fq + 4); const f32x4 s0 = *(const f32x4*)(sB + 8 * fq), s1 = *(const f32x4*)(sB + 8 * fq + 4);
#pragma unroll
                for (int ai = 0; ai < 2; ++ai)
#pragma unroll
                    for (int m = 0; m < 4; ++m) { const int r = row0 + ai * HALF + m * 16; const float sr = sA[r]; float* rp = g + (size_t)r * 16 + 8 * fq;
                        const i32x4_t a0 = __builtin_bit_cast(i32x4_t, acc[ai][0][m][0]), a1 = __builtin_bit_cast(i32x4_t, acc[ai][0][m][1]);
                        *(f32x4*)rp = __builtin_convertvector(a0, f32x4) * sr * s0 + b0; *(f32x4*)(rp + 4) = __builtin_convertvector(a1, f32x4) * sr * s1 + b1; } }
            return; }
        bf16_t* base = (bf16_t*)u.O; const int ldc = u.ldc;
        f32x4 sb[2][2];
#pragma unroll
        for (int bj = 0; bj < 2; ++bj)
#pragma unroll
            for (int n = 0; n < 2; ++n) sb[bj][n] = *(const f32x4*)(sB + col0 + bj * HALF + 4 * n);
        if (u.a1 >= 16) {
#pragma unroll
            for (int ai = 0; ai < 2; ++ai)
#pragma unroll
                for (int m = 0; m < 4; ++m) { const int r = row0 + ai * HALF + m * 16; const float sr = sA[r];
                    const f32x4 p0 = (__builtin_convertvector(__builtin_bit_cast(i32x4_t, acc[ai][0][m][0]), f32x4) * sr * sb[0][0]) * (__builtin_convertvector(__builtin_bit_cast(i32x4_t, acc[ai][1][m][0]), f32x4) * sr * sb[1][0]);
                    const f32x4 p1 = (__builtin_convertvector(__builtin_bit_cast(i32x4_t, acc[ai][0][m][1]), f32x4) * sr * sb[0][1]) * (__builtin_convertvector(__builtin_bit_cast(i32x4_t, acc[ai][1][m][1]), f32x4) * sr * sb[1][1]);
                    u32x4 w; w.x = pk2(p0[0], p0[1]); w.y = pk2(p0[2], p0[3]); w.z = pk2(p1[0], p1[1]); w.w = pk2(p1[2], p1[3]);
                    *(u32x4*)(base + (size_t)r * ldc + col0) = w; }
            return; }
#pragma unroll
        for (int ai = 0; ai < 2; ++ai)
#pragma unroll
            for (int m = 0; m < 4; ++m) { const int r = row0 + ai * HALF + m * 16; const float sr = sA[r]; bf16_t* rowp = base + (size_t)r * ldc + col0;
#pragma unroll
                for (int bj = 0; bj < 2; ++bj) { const f32x4 v0 = __builtin_convertvector(__builtin_bit_cast(i32x4_t, acc[ai][bj][m][0]), f32x4) * sr * sb[bj][0], v1 = __builtin_convertvector(__builtin_bit_cast(i32x4_t, acc[ai][bj][m][1]), f32x4) * sr * sb[bj][1];
                    u32x4 w; w.x = pk2(v0[0], v0[1]); w.y = pk2(v0[2], v0[3]); w.z = pk2(v1[0], v1[1]); w.w = pk2(v1[2], v1[3]);
                    *(u32x4*)(rowp + bj * HALF) = w; } }
    }
};
struct EpiLogits {
    static constexpr bool PERM = true;
    const float* br; const float* rstd; const float* cbr;
    __device__ __forceinline__ void operator()(const f32x4 (&acc)[2][2][4][2], const Unit& u, int wr, int wc, int fr, int fq) const {
        if (wc != 0) return;
        const float* cb = cbr + (u.a0 >= 64 ? 32 : 0);
        float* lg = (float*)u.O; const f32x4 b0 = *(const f32x4*)(br + 8 * fq) + *(const f32x4*)(cb + 8 * fq), b1 = *(const f32x4*)(br + 8 * fq + 4) + *(const f32x4*)(cb + 8 * fq + 4);
#pragma unroll
        for (int ai = 0; ai < 2; ++ai)
#pragma unroll
            for (int m = 0; m < 4; ++m) { const int rl = wr * 64 + fr + ai * HALF + m * 16; const float sr = rstd[u.a0 * BM + rl]; float* rp = lg + (size_t)rl * NE + 8 * fq; *(f32x4*)rp = acc[ai][0][m][0] * sr + b0; *(f32x4*)(rp + 4) = acc[ai][0][m][1] * sr + b1; }
    }
};
struct EpiX1 {
    static constexpr bool PERM = false;
    const float* x; bf16_t* x1; const float* modf;
    __device__ __forceinline__ void operator()(const f32x4 (&acc)[2][2][4][2], const Unit& u, int wr, int wc, int fr, int fq) const {
        const int row0 = u.a0 * BM + wr * 64 + fr, col0 = u.a1 * BM + wc * 32 + 4 * fq;
        const int b = (u.a0 * BM) / SEQ; const float* gt = modf + (size_t)b * NMOD + 2 * D;
        f32x4 gv[2][2];
#pragma unroll
        for (int bj = 0; bj < 2; ++bj)
#pragma unroll
            for (int n = 0; n < 2; ++n) gv[bj][n] = *(const f32x4*)(gt + col0 + bj * HALF + n * 16);
#pragma unroll
        for (int ai = 0; ai < 2; ++ai)
#pragma unroll
            for (int m = 0; m < 4; ++m) { const size_t off = (size_t)(row0 + ai * HALF + m * 16) * D + col0;
#pragma unroll
                for (int bj = 0; bj < 2; ++bj)
#pragma unroll
                    for (int n = 0; n < 2; ++n) { const f32x4 xv = *(const f32x4*)(x + off + bj * HALF + n * 16); const f32x4 r = xv + gv[bj][n] * acc[ai][bj][m][n];
                        u32x2 w; w.x = pk2(r[0], r[1]); w.y = pk2(r[2], r[3]); *(u32x2*)(x1 + off + bj * HALF + n * 16) = w; } }
    }
};
struct EpiX1q {
    static constexpr bool PERM = false;
    const float* x; bf16_t* x1; const float* modf; const float* asc; const float* wosc;
    __device__ __forceinline__ void operator()(const f32x4 (&acc)[2][2][4][2], const Unit& u, int wr, int wc, int fr, int fq) const {
        const int row0 = u.a0 * BM + wr * 64 + fr, col0 = u.a1 * BM + wc * 32 + 4 * fq;
        const int b = (u.a0 * BM) / SEQ; const float* gt = modf + (size_t)b * NMOD + 2 * D;
        f32x4 gv[2][2];
#pragma unroll
        for (int bj = 0; bj < 2; ++bj)
#pragma unroll
            for (int n = 0; n < 2; ++n) gv[bj][n] = *(const f32x4*)(gt + col0 + bj * HALF + n * 16) * *(const f32x4*)(wosc + col0 + bj * HALF + n * 16);
#pragma unroll
        for (int ai = 0; ai < 2; ++ai)
#pragma unroll
            for (int m = 0; m < 4; ++m) { const int row = row0 + ai * HALF + m * 16; const float sr = asc[row]; const size_t off = (size_t)row * D + col0;
#pragma unroll
                for (int bj = 0; bj < 2; ++bj)
#pragma unroll
                    for (int n = 0; n < 2; ++n) { const f32x4 xv = *(const f32x4*)(x + off + bj * HALF + n * 16); const f32x4 r = xv + gv[bj][n] * (__builtin_convertvector(__builtin_bit_cast(i32x4_t, acc[ai][bj][m][n]), f32x4) * sr);
                        u32x2 w; w.x = pk2(r[0], r[1]); w.y = pk2(r[2], r[3]); *(u32x2*)(x1 + off + bj * HALF + n * 16) = w; } }
    }
};
struct EpiAct {
    static constexpr bool PERM = true;
    const float* bgu;
    __device__ __forceinline__ void operator()(const f32x4 (&acc)[2][2][4][2], const Unit& u, int wr, int wc, int fr, int fq) const {
        unsigned char* base = (unsigned char*)u.O; const int acol = u.a1 * 128 + wc * 32 + 8 * fq;
        const LAS float* bt = (const LAS float*)((LAS unsigned char*)lds_raw + LDS_CTL_OFF + 4096 + u.buf * 1024) + wc * 32 + 8 * fq;
        const int row0 = wr * 64 + fr;
        f32x4 bgv[2], buv[2];
#pragma unroll
        for (int n = 0; n < 2; ++n) { bgv[n] = *(const LAS f32x4*)(bt + 4 * n); buv[n] = *(const LAS f32x4*)(bt + 128 + 4 * n); }
#pragma unroll
        for (int ai = 0; ai < 2; ++ai)
#pragma unroll
            for (int m = 0; m < 4; ++m) {
                float o[8];
#pragma unroll
                for (int n = 0; n < 2; ++n) { const f32x4 g4 = acc[ai][0][m][n] * WSCALE_INV + bgv[n], u4 = acc[ai][1][m][n] * WSCALE_INV + buv[n];
#pragma unroll
                    for (int e = 0; e < 4; e += 2) {
                        f32x2 g = {fminf(g4[e], 7.0f), fminf(g4[e + 1], 7.0f)}; const f32x2 up = {fminf(fmaxf(u4[e], -7.0f), 7.0f), fminf(fmaxf(u4[e + 1], -7.0f), 7.0f)};
                        const f32x2 z = g * (-2.4554669595930157f); f32x2 ex; ex.x = __builtin_amdgcn_exp2f(z.x); ex.y = __builtin_amdgcn_exp2f(z.y);
                        const f32x2 den = ex + 1.0f; f32x2 sg; sg.x = __builtin_amdgcn_rcpf(den.x); sg.y = __builtin_amdgcn_rcpf(den.y);
                        const f32x2 r = (up + 1.0f) * g * sg; o[4 * n + e] = r.x; o[4 * n + e + 1] = r.y; } }
                u32x2 w; w.x = pk4f8(o[0], o[1], o[2], o[3]); w.y = pk4f8(o[4], o[5], o[6], o[7]);
                *(u32x2*)(base + (size_t)(row0 + ai * HALF + m * 16) * 2048 + acol) = w; __builtin_amdgcn_sched_barrier(0); }
    }
};
struct EpiDown {
    static constexpr bool PERM = true;
    const float* bdn; unsigned char* ys;
    __device__ __forceinline__ void operator()(const f32x4 (&acc)[2][2][4][2], const Unit& u, int wr, int wc, int fr, int fq) const {
        const LAS int* slots = (const LAS int*)((LAS unsigned char*)lds_raw + LDS_CTL_OFF + 2048 + u.buf * 1024); const LAS float* wts = (const LAS float*)((LAS unsigned char*)lds_raw + LDS_CTL_OFF + 4096 + u.buf * 1024); const int valid = u.ldc;
        const int col0 = u.a1 * BM + wc * 32 + 8 * fq; const float* bp = bdn + (size_t)u.a0 * D + col0;
        f32x4 bv[2][2];
#pragma unroll
        for (int bj = 0; bj < 2; ++bj)
#pragma unroll
            for (int n = 0; n < 2; ++n) bv[bj][n] = *(const f32x4*)(bp + bj * HALF + 4 * n);
        const int row0 = wr * 64 + fr;
#pragma unroll
        for (int ai = 0; ai < 2; ++ai)
#pragma unroll
            for (int m = 0; m < 4; ++m) { const int r = row0 + ai * HALF + m * 16;
                if (r < valid) { const int slot = slots[r]; const float w = wts[r]; unsigned char* rowp = ys + (size_t)slot * D + col0;
#pragma unroll
                    for (int bj = 0; bj < 2; ++bj) { const f32x4 v0 = (acc[ai][bj][m][0] * WSCALE_INV + bv[bj][0]) * w, v1 = (acc[ai][bj][m][1] * WSCALE_INV + bv[bj][1]) * w;
                        u32x2 o; o.x = pk4f8(v0[0], v0[1], v0[2], v0[3]); o.y = pk4f8(v1[0], v1[1], v1[2], v1[3]);
                        *(u32x2*)(rowp + bj * HALF) = o; } } }
    }
};
}

struct Params { const float* in[20]; float* out; unsigned char* ws; int ph_lo, ph_hi; };
enum { I_X = 0, I_C, I_CTX, I_CCTX, I_WADA, I_BADA, I_GMIX, I_WIN, I_BIF, I_CONVW, I_NORMG, I_WOUT, I_GFFN, I_WR, I_BR, I_WGU, I_BGU, I_WDN, I_BDN, I_GFIN };

template <int CTRL, int ROWMASK> DI float dpp_f(float v) { return __builtin_bit_cast(float, __builtin_amdgcn_update_dpp(0, __builtin_bit_cast(int, v), CTRL, ROWMASK, 0xF, false)); }
DI float row16_sum(float v) {
    v += dpp_f<0xB1, 0xF>(v); v += dpp_f<0x4E, 0xF>(v); v += dpp_f<0x124, 0xF>(v); v += dpp_f<0x128, 0xF>(v); return v; }
DI float wave_sum(float v) {
    v = row16_sum(v);
    v += dpp_f<0x142, 0xA>(v); v += dpp_f<0x143, 0xC>(v);
    return __builtin_bit_cast(float, __builtin_amdgcn_readlane(__builtin_bit_cast(int, v), 63));
}
DI float wave_max(float v) {
    v = fmaxf(v, dpp_f<0xB1, 0xF>(v)); v = fmaxf(v, dpp_f<0x4E, 0xF>(v)); v = fmaxf(v, dpp_f<0x124, 0xF>(v)); v = fmaxf(v, dpp_f<0x128, 0xF>(v));
    v = fmaxf(v, dpp_f<0x142, 0xA>(v)); v = fmaxf(v, dpp_f<0x143, 0xC>(v));
    return __builtin_bit_cast(float, __builtin_amdgcn_readlane(__builtin_bit_cast(int, v), 63));
}
DI float silu(float x) { return x / (1.0f + __expf(-x)); }

DI void p0_adaln(const Params& P, LAS unsigned char* lds, int G, int bid) {
    const int tid = my_tid(), wid = __builtin_amdgcn_readfirstlane(tid >> 6), lane = tid & 63;
    LAS float* sc = (LAS float*)lds;
    LAS float* red = (LAS float*)(lds + 8192);
    const float* w_ada = P.in[I_WADA];
    float* modp = (float*)(P.ws + WS_MODP);
    for (int it = bid; it < 48 * 4; it += G) {
        const int nb = it % 48, ks = it / 48;
        __syncthreads();
        for (int i = tid; i < 3 * 512; i += 512) { const int r = i / 512, k = i % 512; const float cv = (r < 2) ? P.in[I_C][r * D + ks * 512 + k] : P.in[I_CCTX][ks * 512 + k]; sc[i] = silu(cv); }
        __syncthreads();
        f32x4 a0 = {0, 0, 0, 0}, a1 = a0, a2 = a0;
        const float* wp = w_ada + (size_t)(ks * 512 + wid * 64) * NMOD + nb * 256 + lane * 4;
#pragma unroll 8
        for (int k = 0; k < 64; ++k) { const f32x4 w = *(const f32x4*)(wp + (size_t)k * NMOD); const int kk = wid * 64 + k;
            a0 += w * sc[kk]; a1 += w * sc[512 + kk]; a2 += w * sc[1024 + kk]; }
        *(LAS f32x4*)(red + (wid * 3 + 0) * 256 + lane * 4) = a0; *(LAS f32x4*)(red + (wid * 3 + 1) * 256 + lane * 4) = a1; *(LAS f32x4*)(red + (wid * 3 + 2) * 256 + lane * 4) = a2;
        __syncthreads();
        for (int i = tid; i < 768; i += 512) { const int r = i / 256, c = i % 256; float s = 0.f;
#pragma unroll
            for (int w = 0; w < 8; ++w) s += red[(w * 3 + r) * 256 + c];
            modp[((size_t)ks * 3 + r) * NMOD + nb * 256 + c] = s; }
    }
    __syncthreads();
}
DI void p0_transpose_item(const float* W, int K, int N, bf16_t* WT, int kind, LAS float* scr, int item, int lane) {
    const int nblk = (N + 31) / 32, kb = item / nblk, nb = item % nblk, k0 = 64 * kb, n0 = 32 * nb;
    { const int c4 = (lane & 7) * 4, r8 = lane >> 3; const bool okc = (n0 + c4) < N;
      f32x4 v[8];
#pragma unroll
      for (int i = 0; i < 8; ++i) v[i] = okc ? *(const f32x4*)(W + (size_t)(k0 + 8 * i + r8) * N + n0 + c4) : (f32x4){0.f, 0.f, 0.f, 0.f};
#pragma unroll
      for (int i = 0; i < 8; ++i) { LAS float* d = scr + (8 * i + r8) * 33 + c4; d[0] = v[i][0]; d[1] = v[i][1]; d[2] = v[i][2]; d[3] = v[i][3]; } }
    asm volatile("s_waitcnt lgkmcnt(0)" ::: "memory");
    const int c = lane & 7;
#pragma unroll
    for (int j = 0; j < 4; ++j) { const int n = (lane >> 3) + 8 * j; const int src = n0 + n; int dst = src; float scale = 1.0f;
        if (kind == 0) { if (src < 512) scale = 0.08838834764831845f; if (src >= GATE_COL0) dst = (src < GATE_COL0 + 16 || src >= P_IN) ? -1 : src - 16; }
        else if (kind == 2) { const int jj = src & 2047; dst = (jj >> 7) * 256 + (src >> 11) * 128 + (jj & 127); }
        const LAS float* s = scr + (8 * c) * 33 + n;
        u32x4 o; o.x = pk2(s[0 * 33] * scale, s[1 * 33] * scale); o.y = pk2(s[2 * 33] * scale, s[3 * 33] * scale); o.z = pk2(s[4 * 33] * scale, s[5 * 33] * scale); o.w = pk2(s[6 * 33] * scale, s[7 * 33] * scale);
        if (dst >= 0) *(u32x4*)(WT + (size_t)dst * K + k0 + 8 * c) = o; }
    asm volatile("s_waitcnt lgkmcnt(0)" ::: "memory");
}
DI void p0_transpose_item8(const float* W, int N, unsigned char* WT, int kind, LAS float* scr, int item, int lane) {
    const int nblk = N / 32, kb = item / nblk, nb = item % nblk, k0 = 128 * kb, n0 = 32 * nb;
    { const int c4 = (lane & 7) * 4, r8 = lane >> 3;
      f32x4 v[16];
#pragma unroll
      for (int i = 0; i < 16; ++i) v[i] = *(const f32x4*)(W + (size_t)(k0 + 8 * i + r8) * N + n0 + c4);
#pragma unroll
      for (int i = 0; i < 16; ++i) { LAS float* d = scr + (8 * i + r8) * 33 + c4; d[0] = v[i][0]; d[1] = v[i][1]; d[2] = v[i][2]; d[3] = v[i][3]; } }
    asm volatile("s_waitcnt lgkmcnt(0)" ::: "memory");
    const int c = lane & 7;
#pragma unroll
    for (int j = 0; j < 4; ++j) { const int n = (lane >> 3) + 8 * j; const int src = n0 + n; int dst = src;
        if (kind == 2) { const int jj = src & 2047; dst = (jj >> 7) * 256 + (src >> 11) * 128 + (jj & 127); }
        const LAS float* sp = scr + (16 * c) * 33 + n;
        u32x4 o; o.x = pk4f8(sp[0 * 33] * WSCALE, sp[1 * 33] * WSCALE, sp[2 * 33] * WSCALE, sp[3 * 33] * WSCALE); o.y = pk4f8(sp[4 * 33] * WSCALE, sp[5 * 33] * WSCALE, sp[6 * 33] * WSCALE, sp[7 * 33] * WSCALE);
        o.z = pk4f8(sp[8 * 33] * WSCALE, sp[9 * 33] * WSCALE, sp[10 * 33] * WSCALE, sp[11 * 33] * WSCALE); o.w = pk4f8(sp[12 * 33] * WSCALE, sp[13 * 33] * WSCALE, sp[14 * 33] * WSCALE, sp[15 * 33] * WSCALE);
        *(u32x4*)(WT + (size_t)dst * D + k0 + 16 * c) = o; }
    asm volatile("s_waitcnt lgkmcnt(0)" ::: "memory");
}
DI void p0_small_rows(const Params& P, int G, int bid) {
    const int t = my_tid();
    for (int i = bid * 512 + t; i < NE * 4096 / 4; i += G * 512) ((f32x4*)(P.ws + WS_BGU))[i] = ((const f32x4*)P.in[I_BGU])[i];
    for (int i = bid * 512 + t; i < NE * D / 4; i += G * 512) ((f32x4*)(P.ws + WS_BDN))[i] = ((const f32x4*)P.in[I_BDN])[i];
    for (int r = bid; r < 512; r += G) {
        if (r < 256) { const int rr = r; if (rr >= 16) { *(unsigned*)((unsigned char*)(P.ws + WS_WIN) + (size_t)(6144 + rr) * D + 4 * t) = 0u; if (t == 0) ((float*)(P.ws + WS_WSC))[6144 + rr] = 1.0f; } }
        else { const int rr = r - 256; u32x2 z; z.x = 0u; z.y = 0u;
            *(u32x2*)((bf16_t*)(P.ws + WS_WR2) + (size_t)rr * D + 4 * t) = z; *(u32x2*)((bf16_t*)(P.ws + WS_WR2) + (size_t)(256 + rr) * D + 4 * t) = z; } }
}
DI int win_dst(int src) { int dst = src < GATE_COL0 ? src : (src < GATE_COL0 + 16 ? 6144 + (src - GATE_COL0) : (src < P_IN ? src - 16 : -1));
    if (dst >= 4096 && dst < 6144) { const int c = (dst - 4096) & 1023; dst = 4096 + (c >> 7) * 256 + (dst >= 5120 ? 128 : 0) + (c & 127); }
    return dst; }
template <bool WIN>
DI void p0_w_int8(const Params& P, LAS unsigned char* lds, int G, int bid, int item0) {
    const int tid = my_tid(), wid = __builtin_amdgcn_readfirstlane(tid >> 6), lane = tid & 63;
    LAS float* scr = (LAS float*)(lds + wid * 16896); LAS float* part = (LAS float*)(lds + 135168); LAS float* sinv = part + 256;
    const float* W = WIN ? P.in[I_WIN] : P.in[I_WOUT]; unsigned char* WT = (unsigned char*)(P.ws + (WIN ? WS_WIN : WS_WOUT)); float* wsc = (float*)(P.ws + (WIN ? WS_WSC : WS_WOSC));
    constexpr int NCOL = WIN ? P_IN : D, NITEM = WIN ? 193 : 64;
    const int c4 = (lane & 7) * 4, r8 = lane >> 3;
    for (int item = bid - item0; item < NITEM; item += G) { if (item < 0) continue; const int n0 = 32 * item; const bool okc = (n0 + c4) < NCOL;
        f32x4 mx = {0.f, 0.f, 0.f, 0.f};
#pragma unroll 8
        for (int i = 0; i < 32; ++i) { const f32x4 v = okc ? *(const f32x4*)(W + (size_t)(256 * wid + 8 * i + r8) * NCOL + n0 + c4) : (f32x4){0.f, 0.f, 0.f, 0.f};
            mx[0] = fmaxf(mx[0], fabsf(v[0])); mx[1] = fmaxf(mx[1], fabsf(v[1])); mx[2] = fmaxf(mx[2], fabsf(v[2])); mx[3] = fmaxf(mx[3], fabsf(v[3])); }
#pragma unroll
        for (int e = 0; e < 4; ++e) { mx[e] = fmaxf(mx[e], __shfl_xor(mx[e], 8)); mx[e] = fmaxf(mx[e], __shfl_xor(mx[e], 16)); mx[e] = fmaxf(mx[e], __shfl_xor(mx[e], 32)); }
        if (lane < 8) *(LAS f32x4*)(part + wid * 32 + c4) = mx;
        __syncthreads();
        if (tid < 32) { float cm = 0.f;
#pragma unroll
            for (int w = 0; w < 8; ++w) cm = fmaxf(cm, part[w * 32 + tid]);
            const int src = n0 + tid; const int dst = !WIN ? src : win_dst(src);
            sinv[tid] = cm > 0.f ? 127.0f / cm : 0.f;
            if (dst >= 0) wsc[dst] = (cm > 0.f ? cm * (1.0f / 127.0f) : 1.0f) * ((WIN && dst < 512) ? 0.08838834764831845f : 1.0f); }
        __syncthreads();
        const f32x4 iv = *(const LAS f32x4*)(sinv + c4);
#pragma unroll 1
        for (int sb = 0; sb < 2; ++sb) { const int k0 = 256 * wid + 128 * sb;
            f32x4 v[16];
#pragma unroll
            for (int i = 0; i < 16; ++i) v[i] = okc ? *(const f32x4*)(W + (size_t)(k0 + 8 * i + r8) * NCOL + n0 + c4) : (f32x4){0.f, 0.f, 0.f, 0.f};
#pragma unroll
            for (int i = 0; i < 16; ++i) { LAS float* d = scr + (8 * i + r8) * 33 + c4; d[0] = __builtin_rintf(v[i][0] * iv[0]); d[1] = __builtin_rintf(v[i][1] * iv[1]); d[2] = __builtin_rintf(v[i][2] * iv[2]); d[3] = __builtin_rintf(v[i][3] * iv[3]); }
            asm volatile("s_waitcnt lgkmcnt(0)" ::: "memory");
            const int c = lane & 7;
#pragma unroll
            for (int j = 0; j < 4; ++j) { const int n = (lane >> 3) + 8 * j; const int src = n0 + n; const int dst = !WIN ? src : win_dst(src);
                const LAS float* sp = scr + (16 * c) * 33 + n;
                u32x4 o; o.x = pk4i8(sp[0 * 33], sp[1 * 33], sp[2 * 33], sp[3 * 33]); o.y = pk4i8(sp[4 * 33], sp[5 * 33], sp[6 * 33], sp[7 * 33]);
                o.z = pk4i8(sp[8 * 33], sp[9 * 33], sp[10 * 33], sp[11 * 33]); o.w = pk4i8(sp[12 * 33], sp[13 * 33], sp[14 * 33], sp[15 * 33]);
                if (dst >= 0) *(u32x4*)(WT + (size_t)dst * D + k0 + 16 * c) = o; }
            asm volatile("s_waitcnt lgkmcnt(0)" ::: "memory"); }
        __syncthreads();
    }
}
DI void p0_convert(const Params& P, LAS unsigned char* lds, int G, int bid) {
    const int tid = my_tid(), wid = __builtin_amdgcn_readfirstlane(tid >> 6), lane = tid & 63;
    LAS float* scr = (LAS float*)(lds + wid * 16896);
    const int gw = bid * 8 + wid, NGW = G * 8;
    for (int it = gw; it < 32 * 64; it += NGW) p0_transpose_item(P.in[I_WOUT], D, D, (bf16_t*)(P.ws + WS_WOUT), 1, scr, it, lane);
}
constexpr int CV_GU1 = 16 * 128, CV_DN1 = 16 * 64, CV_ITEMS = NE * (CV_GU1 + CV_DN1);
struct CvItem { const float* W; unsigned char* WT; int N, kind, k0, n0; };
DI CvItem cv_decode(const Params& P, int it) { CvItem c; int item;
    if (it < NE * CV_GU1) { const int e = it / CV_GU1; c.W = P.in[I_WGU] + (size_t)e * D * 4096; c.N = 4096; c.WT = (unsigned char*)(P.ws + WS_WGU) + (size_t)e * 4096 * D; c.kind = 2; item = it % CV_GU1; }
    else { const int r = it - NE * CV_GU1; const int e = r / CV_DN1; c.W = P.in[I_WDN] + (size_t)e * D * D; c.N = D; c.WT = (unsigned char*)(P.ws + WS_WDN) + (size_t)e * D * D; c.kind = 3; item = r % CV_DN1; }
    const int nblk = c.N / 32, kb = item / nblk, nb = item % nblk; c.k0 = 128 * kb; c.n0 = 32 * nb; return c; }
DI void cv_issue(const CvItem& c, int lane, f32x4 (&v)[16]) { const int c4 = (lane & 7) * 4, r8 = lane >> 3;
#pragma unroll
    for (int i = 0; i < 16; ++i) v[i] = *(const f32x4*)(c.W + (size_t)(c.k0 + 8 * i + r8) * c.N + c.n0 + c4); }
DI void cv_finish(const CvItem& cc, int lane, LAS float* scr, const f32x4 (&v)[16]) {
    { const int c4 = (lane & 7) * 4, r8 = lane >> 3;
#pragma unroll
      for (int i = 0; i < 16; ++i) { LAS float* d = scr + (8 * i + r8) * 33 + c4; d[0] = v[i][0]; d[1] = v[i][1]; d[2] = v[i][2]; d[3] = v[i][3]; } }
    asm volatile("s_waitcnt lgkmcnt(0)" ::: "memory");
    const int c = lane & 7;
#pragma unroll
    for (int j = 0; j < 4; ++j) { const int n = (lane >> 3) + 8 * j; const int src = cc.n0 + n; int dst = src;
        if (cc.kind == 2) { const int jj = src & 2047; dst = (jj >> 7) * 256 + (src >> 11) * 128 + (jj & 127); }
        const LAS float* sp = scr + (16 * c) * 33 + n;
        u32x4 o; o.x = pk4f8(sp[0 * 33] * WSCALE, sp[1 * 33] * WSCALE, sp[2 * 33] * WSCALE, sp[3 * 33] * WSCALE); o.y = pk4f8(sp[4 * 33] * WSCALE, sp[5 * 33] * WSCALE, sp[6 * 33] * WSCALE, sp[7 * 33] * WSCALE);
        o.z = pk4f8(sp[8 * 33] * WSCALE, sp[9 * 33] * WSCALE, sp[10 * 33] * WSCALE, sp[11 * 33] * WSCALE); o.w = pk4f8(sp[12 * 33] * WSCALE, sp[13 * 33] * WSCALE, sp[14 * 33] * WSCALE, sp[15 * 33] * WSCALE);
        *(u32x4*)(cc.WT + (size_t)dst * D + cc.k0 + 16 * c) = o; }
    asm volatile("s_waitcnt lgkmcnt(0)" ::: "memory");
}
DI void conv_experts(const Params& P, LAS unsigned char* lds, int gw, int nw, int lo, int hi) {
    const int wid = wave_in_wg(), lane = lane_id();
    LAS float* scr = (LAS float*)(lds + wid * 16896);
    int it = lo + gw; if (it >= hi) return;
    CvItem cur = cv_decode(P, it); f32x4 v[16]; cv_issue(cur, lane, v);
    for (;;) { const int nx = it + nw; const bool more = nx < hi;
        const CvItem nxt = cv_decode(P, more ? nx : it); f32x4 vn[16]; cv_issue(nxt, lane, vn);
        asm volatile("" ::: "memory");
        cv_finish(cur, lane, scr, v);
        if (!more) break;
#pragma unroll
        for (int i = 0; i < 16; ++i) v[i] = vn[i];
        cur = nxt; it = nx; }
}
constexpr int CV_BLK = 8, CV_NBLK_ALL = CV_ITEMS / CV_BLK, CV_NBLK_A = (CV_NBLK_ALL / 100) * 94;
DI void conv_pool(const Params& P, LAS unsigned char* lds, int pool, int blk_lo, int blk_hi) {
    const int wid = wave_in_wg(), lane = lane_id();
    LAS float* scr = (LAS float*)(lds + wid * 16896);
    unsigned* ctr = (unsigned*)(P.ws + WS_CTL) + CW_POOL + pool * 64;
    const int CV_NBLK = blk_hi;
    auto claim = [&]() -> int { unsigned v_ = 0u; if (lane == 0) v_ = __hip_atomic_fetch_add(ctr, 1u, __ATOMIC_RELAXED, __HIP_MEMORY_SCOPE_AGENT); return blk_lo + (int)__builtin_amdgcn_readfirstlane(v_); };
    const int blk = claim(); if (blk >= CV_NBLK) return;
    int it = blk * CV_BLK, left = CV_BLK;
    CvItem cur = cv_decode(P, it); f32x4 v[16]; cv_issue(cur, lane, v);
    for (;;) { int nx = it + 1; bool more = true;
        if (left > 1) --left; else { const int nb = claim(); if (nb >= CV_NBLK) { more = false; nx = it; } else { nx = nb * CV_BLK; left = CV_BLK; } }
        const CvItem nxt = cv_decode(P, nx); f32x4 vn[16]; cv_issue(nxt, lane, vn);
        asm volatile("" ::: "memory");
        cv_finish(cur, lane, scr, v);
        if (!more) break;
#pragma unroll
        for (int i = 0; i < 16; ++i) v[i] = vn[i];
        cur = nxt; it = nx; }
}

DI void nm_fill_mod(LAS unsigned char* lds, const Params& P, int cond, int chunk_shift, int chunk_scale, const float* g) {
    LAS float* av = (LAS float*)lds; LAS float* bv = (LAS float*)(lds + 8192);
    const float* modp = (const float*)(P.ws + WS_MODP); const float* bada = P.in[I_BADA];
    const int t = my_tid(); float shv[4], scv[4], gv[4];
#pragma unroll
    for (int u = 0; u < 4; ++u) { const int i = t + 512 * u; float sh = bada[chunk_shift * D + i], sc = bada[chunk_scale * D + i];
#pragma unroll
        for (int ks = 0; ks < 4; ++ks) { sh += modp[((size_t)ks * 3 + cond) * NMOD + chunk_shift * D + i]; sc += modp[((size_t)ks * 3 + cond) * NMOD + chunk_scale * D + i]; }
        shv[u] = sh; scv[u] = sc; gv[u] = g[i]; }
#pragma unroll
    for (int u = 0; u < 4; ++u) { const int i = t + 512 * u; av[i] = gv[u] * (1.0f + scv[u]); bv[i] = shv[u]; }
}
DI void unpack8(const u32x4 r, f32x4& lo, f32x4& hi) { lo = (f32x4){bf_lo(r.x), bf_hi(r.x), bf_lo(r.y), bf_hi(r.y)}; hi = (f32x4){bf_lo(r.z), bf_hi(r.z), bf_lo(r.w), bf_hi(r.w)}; }
template <int OUT, bool SRCBF>
DI void nm_rowpair(LAS unsigned char* lds, const void* src0v, const void* src1v, bf16_t* b0, bf16_t* b1, unsigned char* q0, unsigned char* q1, int lane, float* sc0 = nullptr) {
    const LAS float* av = (const LAS float*)lds; const LAS float* bv = (const LAS float*)(lds + 8192);
    f32x4 xa[8], xb[8]; float sa = 0.f, sb = 0.f;
    if constexpr (SRCBF) { const bf16_t* s0 = (const bf16_t*)src0v; const bf16_t* s1 = (const bf16_t*)src1v; u32x4 ra_[4], rb_[4];
#pragma unroll
        for (int j = 0; j < 4; ++j) { const int c = 512 * j + 8 * lane; ra_[j] = *(const u32x4*)(s0 + c); rb_[j] = *(const u32x4*)(s1 + c); }
#pragma unroll
        for (int j = 0; j < 4; ++j) { unpack8(ra_[j], xa[2 * j], xa[2 * j + 1]); unpack8(rb_[j], xb[2 * j], xb[2 * j + 1]); }
    } else { const float* src0 = (const float*)src0v; const float* src1 = (const float*)src1v;
#pragma unroll
    for (int j = 0; j < 4; ++j) { const int c = 512 * j + 8 * lane; xa[2 * j] = *(const f32x4*)(src0 + c); xa[2 * j + 1] = *(const f32x4*)(src0 + c + 4); xb[2 * j] = *(const f32x4*)(src1 + c); xb[2 * j + 1] = *(const f32x4*)(src1 + c + 4); } }
#pragma unroll
    for (int j = 0; j < 8; ++j) { sa += (xa[j][0] * xa[j][0] + xa[j][1] * xa[j][1]) + (xa[j][2] * xa[j][2] + xa[j][3] * xa[j][3]); sb += (xb[j][0] * xb[j][0] + xb[j][1] * xb[j][1]) + (xb[j][2] * xb[j][2] + xb[j][3] * xb[j][3]); }
    const float ra = 1.0f / sqrtf(wave_sum(sa) * (1.0f / D) + EPS), rb = 1.0f / sqrtf(wave_sum(sb) * (1.0f / D) + EPS);
    if constexpr (OUT == 2) {
        float ma = 0.f, mb = 0.f;
#pragma unroll
        for (int j = 0; j < 4; ++j) { const int c = 512 * j + 8 * lane;
            const f32x4 A0 = *(const LAS f32x4*)(av + c), A1 = *(const LAS f32x4*)(av + c + 4), B0 = *(const LAS f32x4*)(bv + c), B1 = *(const LAS f32x4*)(bv + c + 4);
            xa[2 * j] = xa[2 * j] * ra * A0 + B0; xa[2 * j + 1] = xa[2 * j + 1] * ra * A1 + B1; xb[2 * j] = xb[2 * j] * rb * A0 + B0; xb[2 * j + 1] = xb[2 * j + 1] * rb * A1 + B1;
#pragma unroll
            for (int e = 0; e < 4; ++e) { ma = fmaxf(ma, fmaxf(fabsf(xa[2 * j][e]), fabsf(xa[2 * j + 1][e]))); mb = fmaxf(mb, fmaxf(fabsf(xb[2 * j][e]), fabsf(xb[2 * j + 1][e]))); } }
        ma = wave_max(ma); mb = wave_max(mb);
        const float ia = ma > 0.f ? 127.0f / ma : 0.f, ib = mb > 0.f ? 127.0f / mb : 0.f;
        if (lane == 0) { sc0[0] = ma > 0.f ? ma * (1.0f / 127.0f) : 1.0f; sc0[1] = mb > 0.f ? mb * (1.0f / 127.0f) : 1.0f; }
#pragma unroll
        for (int j = 0; j < 4; ++j) { const int c = 512 * j + 8 * lane;
            u32x2 qa; qa.x = pk4i8(__builtin_rintf(xa[2 * j][0] * ia), __builtin_rintf(xa[2 * j][1] * ia), __builtin_rintf(xa[2 * j][2] * ia), __builtin_rintf(xa[2 * j][3] * ia));
            qa.y = pk4i8(__builtin_rintf(xa[2 * j + 1][0] * ia), __builtin_rintf(xa[2 * j + 1][1] * ia), __builtin_rintf(xa[2 * j + 1][2] * ia), __builtin_rintf(xa[2 * j + 1][3] * ia)); *(u32x2*)(q0 + c) = qa;
            u32x2 qb; qb.x = pk4i8(__builtin_rintf(xb[2 * j][0] * ib), __builtin_rintf(xb[2 * j][1] * ib), __builtin_rintf(xb[2 * j][2] * ib), __builtin_rintf(xb[2 * j][3] * ib));
            qb.y = pk4i8(__builtin_rintf(xb[2 * j + 1][0] * ib), __builtin_rintf(xb[2 * j + 1][1] * ib), __builtin_rintf(xb[2 * j + 1][2] * ib), __builtin_rintf(xb[2 * j + 1][3] * ib)); *(u32x2*)(q1 + c) = qb; }
        return; }
    constexpr bool F8OUT = (OUT == 1 || OUT == 3), BFOUT = (OUT != 3);
    if constexpr (OUT == 3) { if (lane == 0) { sc0[0] = ra; sc0[1] = rb; } }
#pragma unroll
    for (int j = 0; j < 4; ++j) { const int c = 512 * j + 8 * lane;
        const f32x4 A0 = *(const LAS f32x4*)(av + c), A1 = *(const LAS f32x4*)(av + c + 4), B0 = *(const LAS f32x4*)(bv + c), B1 = *(const LAS f32x4*)(bv + c + 4);
        const f32x4 ya0 = xa[2 * j] * ra * A0 + B0, ya1 = xa[2 * j + 1] * ra * A1 + B1, yb0 = xb[2 * j] * rb * A0 + B0, yb1 = xb[2 * j + 1] * rb * A1 + B1;
        if constexpr (BFOUT) { u32x4 w; w.x = pk2(ya0[0], ya0[1]); w.y = pk2(ya0[2], ya0[3]); w.z = pk2(ya1[0], ya1[1]); w.w = pk2(ya1[2], ya1[3]); *(u32x4*)(b0 + c) = w;
        u32x4 v; v.x = pk2(yb0[0], yb0[1]); v.y = pk2(yb0[2], yb0[3]); v.z = pk2(yb1[0], yb1[1]); v.w = pk2(yb1[2], yb1[3]); *(u32x4*)(b1 + c) = v; }
        if constexpr (F8OUT) { u32x2 qa; qa.x = pk4f8(ya0[0], ya0[1], ya0[2], ya0[3]); qa.y = pk4f8(ya1[0], ya1[1], ya1[2], ya1[3]); *(u32x2*)(q0 + c) = qa;
                               u32x2 qb; qb.x = pk4f8(yb0[0], yb0[1], yb0[2], yb0[3]); qb.y = pk4f8(yb1[0], yb1[1], yb1[2], yb1[3]); *(u32x2*)(q1 + c) = qb; }
    }
}
DI void p1_modulate(const Params& P, LAS unsigned char* lds, int G, int bid) {
    const int tid = my_tid(), wid = __builtin_amdgcn_readfirstlane(tid >> 6), lane = tid & 63;
    unsigned char* XN = (unsigned char*)(P.ws + WS_XN); float* xsc = (float*)(P.ws + WS_XSC);
    {
        const float* modp = (const float*)(P.ws + WS_MODP); float* modf = (float*)(P.ws + WS_MODF);
        for (int i = bid * 512 + tid; i < 3 * NMOD; i += G * 512) { const int r = i / NMOD, c = i % NMOD; float s = P.in[I_BADA][c];
#pragma unroll
            for (int ks = 0; ks < 4; ++ks) s += modp[((size_t)ks * 3 + r) * NMOD + c];
            modf[i] = s; }
    }
    int cur_cond = -1;
    for (int blk = bid; blk < 256; blk += G) {
        const int cond = blk < 128 ? 0 : 1;
        if (cond != cur_cond) { __syncthreads(); nm_fill_mod(lds, P, cond, 0, 1, P.in[I_GMIX]); cur_cond = cond; }
        __syncthreads();
#pragma unroll 1
        for (int pr = 0; pr < 8; ++pr) { const int row = blk * 128 + wid * 16 + pr * 2; const float* s0 = P.in[I_X] + (size_t)row * D;
            nm_rowpair<2, false>(lds, s0, s0 + D, nullptr, nullptr, XN + (size_t)row * D, XN + (size_t)(row + 1) * D, lane, xsc + row); }
    }
    __syncthreads(); nm_fill_mod(lds, P, 2, 0, 1, P.in[I_GMIX]); __syncthreads();
#pragma unroll 1
    for (int pr = bid * 8 + wid; pr < TC / 2; pr += G * 8) { const int row = T + pr * 2; const float* s0 = P.in[I_CTX] + (size_t)(pr * 2) * D;
        nm_rowpair<2, false>(lds, s0, s0 + D, nullptr, nullptr, XN + (size_t)row * D, XN + (size_t)(row + 1) * D, lane, xsc + row); }
    __syncthreads();
}
DI void p8_modulate(const Params& P, LAS unsigned char* lds, int G, int bid) {
    const int tid = my_tid(), wid = __builtin_amdgcn_readfirstlane(tid >> 6), lane = tid & 63;
    unsigned char* XN8 = (unsigned char*)(P.ws + WS_XN8); const bf16_t* X1 = (const bf16_t*)(P.ws + WS_X1); float* rstd = (float*)(P.ws + WS_RSTD);
    { const float* modf = (const float*)(P.ws + WS_MODF); const float* gf = P.in[I_GFFN]; const float* wr_ = P.in[I_WR]; LAS float* red = (LAS float*)(lds + 16384);
      for (int item = bid; item < 64; item += G) { const int b = item >> 5, rr = item & 31; const float* mf = modf + (size_t)b * NMOD;
          float v[4], part = 0.f;
#pragma unroll
          for (int i = 0; i < 4; ++i) { const int k = 4 * tid + i; const float w = wr_[(size_t)k * NE + rr]; v[i] = w * (gf[k] * (1.0f + mf[4 * D + k])); part += w * mf[3 * D + k]; }
          u32x2 o; o.x = pk2(v[0], v[1]); o.y = pk2(v[2], v[3]); *(u32x2*)((bf16_t*)(P.ws + WS_WR2) + (size_t)(b * 256 + rr) * D + 4 * tid) = o;
          part = wave_sum(part);
          __syncthreads(); if (lane == 0) red[wid] = part; __syncthreads();
          if (tid == 0) ((float*)(P.ws + WS_CBR))[b * 32 + rr] = ((red[0] + red[1]) + (red[2] + red[3])) + ((red[4] + red[5]) + (red[6] + red[7])); } }
    int cur_cond = -1;
    for (int blk = bid; blk < 256; blk += G) {
        const int cond = blk < 128 ? 0 : 1;
        if (cond != cur_cond) { __syncthreads(); nm_fill_mod(lds, P, cond, 3, 4, P.in[I_GFFN]); cur_cond = cond; }
        __syncthreads();
#pragma unroll 1
        for (int pr = 0; pr < 8; ++pr) { const int row = blk * 128 + wid * 16 + pr * 2; const bf16_t* s0 = X1 + (size_t)row * D;
            nm_rowpair<3, true>(lds, s0, s0 + D, nullptr, nullptr, XN8 + (size_t)row * D, XN8 + (size_t)(row + 1) * D, lane, rstd + row); }
    }
    __syncthreads();
}

struct SchedIn { static constexpr bool GATHER = false, ETAB = false, BIAS = false;
    unsigned char* ws; int G, c;
    DI bool next(int i, pg8::Unit& u) const {
        const int L = i * G + c; if (L >= 3200 + 14) return false;
        int pm, pn;
        if (L < 3200) pg8::tile_order(pg8::xcd_remap(L, 3200), 3200, 128, 25, pm, pn);
        else { const int j = L - 3200; pm = 128 + j / 7; pn = (j % 7) < 6 ? 2 + (j % 7) : 24; }
        const unsigned xrow = (unsigned)(WS_XN + (size_t)pm * 256 * D), wrow = (unsigned)(WS_WIN + (size_t)pn * 256 * D);
        u.a0 = pm; u.a1 = pn;
        if (pn >= 4 && pn < 8) { u.A = wrow; u.B = xrow; u.ldc = MT; u.O = (char*)(ws + WS_VT) + ((size_t)(pn - 4) * 256 * MT + (size_t)pm * 256) * 2; }
        else if (pn == 24) { u.A = xrow; u.B = wrow; u.ldc = 0; u.O = (char*)(ws + WS_GATES) + (size_t)pm * 256 * 16 * 4; }
        else { u.A = xrow; u.B = wrow;
            size_t base; int ldc, pc;
            if (pn < 2) { base = WS_Q; ldc = 512; pc = pn; } else if (pn < 4) { base = WS_K; ldc = 512; pc = pn - 2; }
            else if (pn < 12) { base = WS_O; ldc = 1024; pc = pn - 8; } else if (pn < 16) { base = WS_CB; ldc = 1024; pc = pn - 12; }
            else { base = WS_CC; ldc = 1024; pc = pn - 16; }
            u.ldc = ldc; u.O = (char*)(ws + base) + ((size_t)pm * 256 * ldc + (size_t)pc * (pn >= 16 ? 128 : 256)) * 2; }
        return true;
    }
};
struct SchedRouter { static constexpr bool GATHER = false, ETAB = false, BIAS = false;
    unsigned char* ws; int G, c;
    DI bool next(int i, pg8::Unit& u) const {
        const int L = i * G + c; if (L >= 128) return false;
        u.A = (unsigned)(WS_X1 + (size_t)L * 256 * D * 2); u.B = (unsigned)(WS_WR2 + (size_t)(L >= 64 ? 1 : 0) * 256 * D * 2); u.O = (char*)(ws + WS_LOGITS) + (size_t)L * 256 * NE * 4; u.ldc = 0; u.a0 = L; u.a1 = 0; return true;
    }
};
struct SchedOut { static constexpr bool GATHER = false, ETAB = false, BIAS = false;
    unsigned char* ws; int G, c;
    DI bool next(int i, pg8::Unit& u) const {
        const int L = i * G + c; if (L >= 1024) return false;
        int pm, pn; pg8::tile_order(pg8::xcd_remap(L, 1024), 1024, 128, 8, pm, pn);
        u.A = (unsigned)(WS_A2 + (size_t)pm * 256 * D); u.B = (unsigned)(WS_WOUT + (size_t)pn * 256 * D); u.O = nullptr; u.ldc = 0; u.a0 = pm; u.a1 = pn; return true;
    }
};
DI void moe_tables(const Params& P, LAS unsigned char* lds, int npn, int G, int bid) {
    LAS int* tab = (LAS int*)(lds + LDS_CTL_OFF + 64); LAS int* ul = (LAS int*)(lds + LDS_CTL_OFF + 384);
    __syncthreads();
    if (my_tid() < 32) { const unsigned* gc = (const unsigned*)(P.ws + WS_CTL) + CW_GCNT; const int e = my_tid();
        const int cn = (int)__hip_atomic_load(gc + e, __ATOMIC_RELAXED, __HIP_MEMORY_SCOPE_AGENT);
        const int tiles = (cn + 255) >> 8; int inc = tiles;
#pragma unroll
        for (int o = 1; o < 32; o <<= 1) { const int t_ = __shfl_up(inc, o); if (e >= o) inc += t_; }
        tab[e] = cn; tab[32 + e] = inc - tiles; if (e == 31) tab[64] = inc; }
    __syncthreads();
    if (npn > 0 && my_tid() < 64) { const int i = my_tid(); const int nwg = tab[64] * npn; const int L = i * G + bid; int d0 = -1, d1 = 0;
        if (L < nwg) { const int wg = pg8::xcd_remap(L, nwg); int e = 0;
            for (int k = 1; k < 32; ++k) if (wg >= tab[32 + k] * npn) e = k;
            const int t0 = tab[32 + e], nM = tab[32 + e + 1] - t0, w = wg - t0 * npn; int pm, pn; pg8::tile_order(w, nM * npn, nM, npn, pm, pn);
            d0 = e | (pn << 8) | (pm << 16); d1 = t0; }
        ul[2 * i] = d0; ul[2 * i + 1] = d1; }
    __syncthreads();
}
template <bool GATHER_> struct SchedMoeT { static constexpr bool GATHER = GATHER_, ETAB = !GATHER_, BIAS = GATHER_;
    DI unsigned etab_off(const pg8::Unit& u, int which) const { return (unsigned)((const unsigned char*)u.O - ws) + (which ? (unsigned)(WS_LISTW - WS_LIST) : 0u); }
    unsigned char* ws; const LAS int* tab; int down;
    DI unsigned bias_off(const pg8::Unit& u, int which) const { return down ? (unsigned)(WS_BDN + ((size_t)u.a0 * D + (size_t)u.a1 * 256 + which * 128) * 4) : (unsigned)(WS_BGU + ((size_t)u.a0 * 4096 + (size_t)u.a1 * 128 + which * 2048) * 4); }
    DI unsigned list_off(const pg8::Unit& u) const { return (unsigned)(WS_LIST + ((size_t)u.a0 * T + (size_t)u.ldc) * 4); }
    DI int row_cnt(const pg8::Unit& u) const { return __builtin_amdgcn_readfirstlane(tab[u.a0]) - u.ldc; }
    DI bool next(int i, pg8::Unit& u) const {
        if (i >= 64) return false;
        const LAS int* ul = tab + 80;
        const int d0 = __builtin_amdgcn_readfirstlane(ul[2 * i]); if (d0 < 0) return false;
        const int t0 = __builtin_amdgcn_readfirstlane(ul[2 * i + 1]); const int e = d0 & 255, pn = (d0 >> 8) & 255, pm = d0 >> 16;
        const size_t row0 = (size_t)(t0 + pm) * 256;
        u.a0 = e; u.a1 = pn;
        if (!down) { u.A = GATHER_ ? (unsigned)WS_XN8 : (unsigned)(WS_XG + row0 * D); u.B = (unsigned)(WS_WGU + ((size_t)e * 4096 + (size_t)pn * 256) * D); u.O = (char*)(ws + WS_ACT) + row0 * D; u.ldc = pm * 256; }
        else { u.A = (unsigned)(WS_ACT + row0 * D); u.B = (unsigned)(WS_WDN + ((size_t)e * D + (size_t)pn * 256) * D);
               u.O = (char*)(ws + WS_LIST) + ((size_t)e * T + (size_t)pm * 256) * 4; const int rem = __builtin_amdgcn_readfirstlane(tab[e]) - pm * 256; u.ldc = rem < 256 ? rem : 256; }
        return true;
    }
};
typedef SchedMoeT<false> SchedMoe;

constexpr int ML_QS = 0, ML_KS = 34816, ML_PS = 69632, ML_SC = 104448;
constexpr int SC_U = 0, SC_T = 512, SC_WST = 1024, SC_CL = 1536, SC_EV = 2048, SC_LF = 2560, SC_LI = 3072, SC_N0 = 3584, SC_DENP = 4096, SC_QNP = 6144, SC_NPART = 8192, SC_MISC = 10240;
DI unsigned off_b(unsigned row, unsigned ch) { return 272u * row + 16u * ch; }
DI float softcap(float x) { return 15.0f * tanhf(x * (1.0f / 15.0f)); }
DI float logsigmoid(float y) { return fminf(y, 0.f) - log1pf(__expf(-fabsf(y))); }
#define MFMA32(a, b, c) __builtin_amdgcn_mfma_f32_32x32x16_bf16((a), (b), (c), 0, 0, 0)

template <bool PASS2, int DIRT>
DI void mlstm_item(const Params& P, LAS unsigned char* lds, int st, int g) {
    const int wid = wave_in_wg();
    int tid = (wid << 6) | lane_id(), lane = tid & 63, r = lane & 31, hh = lane >> 5;
    constexpr int dir = DIRT; const int b = (st >> 2) & 1, h = st & 3;
    LAS unsigned char* QS = lds + ML_QS; LAS unsigned char* KS = lds + ML_KS; LAS unsigned char* PS = lds + ML_PS;
    LAS float* SC = (LAS float*)(lds + ML_SC);
    LAS float* sU = SC + SC_U / 4; LAS float* sT = SC + SC_T / 4; LAS float* sWST = SC + SC_WST / 4; LAS float* sCL = SC + SC_CL / 4; LAS float* sEV = SC + SC_EV / 4;
    LAS float* sLF = SC + SC_LF / 4; LAS float* sLI = SC + SC_LI / 4; LAS float* sN0 = SC + SC_N0 / 4; LAS float* sDENP = SC + SC_DENP / 4; LAS float* sQNP = SC + SC_QNP / 4;
    LAS float* sNPART = SC + SC_NPART / 4; LAS float* sMISC = SC + SC_MISC / 4;
    const bf16_t* Qg = (const bf16_t*)(P.ws + WS_Q); const bf16_t* Kg = (const bf16_t*)(P.ws + WS_K); const bf16_t* VT = (const bf16_t*)(P.ws + WS_VT);
    const float* gates = (const float*)(P.ws + WS_GATES);
    const int ctx_item = (!PASS2 && g == 0); const int nchunks = ctx_item ? 2 : 8; const int seg = PASS2 ? g : g - 1;
    f32x16 C[4];
#pragma unroll
    for (int i = 0; i < 4; ++i)
#pragma unroll
        for (int e = 0; e < 16; ++e) C[i][e] = 0.f;
    __syncthreads();
    if (PASS2) {
        const float* ec = (const float*)(P.ws + WS_ENTC) + ((size_t)st * 16 + g) * 32768;
#pragma unroll
        for (int dkt = 0; dkt < 4; ++dkt)
#pragma unroll
            for (int e = 0; e < 16; ++e) C[dkt][e] = ec[(32 * dkt + (e & 3) + 8 * (e >> 2) + 4 * hh) * 256 + 32 * wid + r];
        if (tid < 128) sN0[tid] = ((const float*)(P.ws + WS_ENTN))[((size_t)st * 16 + g) * 128 + tid];
        if (tid == 0) sMISC[1] = ((const float*)(P.ws + WS_ENTN + 512 * 1024))[st * 16 + g];
    } else {
        if (tid < 128) sN0[tid] = 0.f;
        if (tid == 0) sMISC[1] = -1e30f;
    }
    LAS float* sALL = SC + 10496 / 4;
    LAS float* sCH = sALL + 8 * 3 * 128;
    auto chunk_tok0 = [&](int ci) -> int { if (ctx_item) return T + b * CTXL + (dir ? (1 - ci) : ci) * 128;
        const int cp = seg * 8 + ci; const int chunk = dir ? (NCHUNK - 1 - cp) : cp; return b * SEQ + chunk * 128; };
    if (wid < nchunks) { const int t0c = chunk_tok0(wid);
        const int p0 = dir ? 127 - 2 * lane : 2 * lane, p1 = dir ? 126 - 2 * lane : 2 * lane + 1;
        const float* g0 = gates + (size_t)(t0c + p0) * 16; const float* g1 = gates + (size_t)(t0c + p1) * 16;
        const float li0 = softcap(g0[dir * 8 + h]), li1 = softcap(g1[dir * 8 + h]); const float lf0 = logsigmoid(softcap(g0[dir * 8 + 4 + h])), lf1 = logsigmoid(softcap(g1[dir * 8 + 4 + h]));
        float sm = lf0 + lf1;
#pragma unroll
        for (int o = 1; o < 64; o <<= 1) { const float t = __shfl_up(sm, o); if (lane >= o) sm += t; }
        const float b0 = sm - lf1, b1 = sm;
        const float u0 = li0 - b0, u1 = li1 - b1;
        float mx = fmaxf(u0, u1);
#pragma unroll
        for (int o = 1; o < 64; o <<= 1) { const float t = __shfl_up(mx, o); if (lane >= o) mx = fmaxf(mx, t); }
        float pe = __shfl_up(mx, 1); if (lane == 0) pe = -3.0e38f;
        const float pm0 = fmaxf(pe, u0), pm1 = mx;
        LAS float* A = sALL + wid * 384;
        A[p0] = u0; A[p1] = u1; A[128 + p0] = pm0; A[128 + p1] = pm1; A[256 + p0] = b0; A[256 + p1] = b1;
        if (lane == 63) { sCH[wid * 4 + 0] = sm; sCH[wid * 4 + 1] = mx; }
    }
    __syncthreads();
    if (tid == 0) { float m0 = sMISC[1], bsum = 0.f;
        for (int c = 0; c < nchunks; ++c) { const float Bt = sCH[c * 4 + 0], U = sCH[c * 4 + 1]; const float Mp = fmaxf(m0, U); sCH[c * 4 + 2] = m0; sCH[c * 4 + 3] = Mp; m0 = Bt + Mp; bsum += Bt; }
        sMISC[1] = m0; sMISC[2] = bsum; }
    u32x4 kq[8];
    { const int tok0 = chunk_tok0(0);
#pragma unroll
      for (int i = 0; i < 4; ++i) { const int n = tid + 512 * i, row = n >> 4, ch = n & 15; kq[i] = *(const u32x4*)(Kg + (size_t)(tok0 + row) * 512 + h * 128 + ch * 8);
          if (PASS2) kq[4 + i] = *(const u32x4*)(Qg + (size_t)(tok0 + row) * 512 + h * 128 + ch * 8); } }
    __syncthreads();
    for (int ci = 0; ci < nchunks; ++ci) {
        tid = (wid << 6) | lane_id(); asm volatile("" : "+v"(tid)); lane = tid & 63; r = lane & 31; hh = lane >> 5;
        const int tok0 = chunk_tok0(ci);
#pragma unroll
        for (int i = 0; i < 4; ++i) { const int n = tid + 512 * i, row = n >> 4, ch = n & 15;
            *(LAS u32x4*)(KS + off_b(row, ch)) = kq[i];
            if (PASS2) *(LAS u32x4*)(QS + off_b(row, ch)) = kq[4 + i]; }
        bf16x8 vf[8];
#pragma unroll
        for (int ks = 0; ks < 8; ++ks) vf[ks] = *(const bf16x8*)(VT + (size_t)(h * 256 + 32 * wid + r) * MT + tok0 + 16 * ks + 8 * hh);
        if (tid < 128) { const LAS float* A = sALL + ci * 384; const float u = A[tid], m0 = sCH[ci * 4 + 2], Mp = sCH[ci * 4 + 3];
            sU[tid] = u; sEV[tid] = __expf(u - Mp);
            if (PASS2) { const float t = fmaxf(m0, A[128 + tid]); sT[tid] = t; sWST[tid] = __expf(m0 - t); sCL[tid] = __expf(-(A[256 + tid] + t)); }
            if (tid == 0) sMISC[0] = __expf(m0 - Mp); }
        __syncthreads();
        f32x16 num[4];
        if (PASS2) {
            const int stt = wid >> 1;
#pragma unroll
            for (int i = 0; i < 2; ++i) { const int jt = 2 * (wid & 1) + i; const bool skip = dir ? (stt < jt) : (stt > jt); const int j = 32 * jt + r;
                if (!skip) {
                    f32x16 acc;
#pragma unroll
                    for (int e = 0; e < 16; ++e) acc[e] = 0.f;
#pragma unroll
                    for (int ks = 0; ks < 8; ++ks) { const bf16x8 a = *(const LAS bf16x8*)(KS + off_b(32 * stt + r, 2 * ks + hh)); const bf16x8 bq = *(const LAS bf16x8*)(QS + off_b(j, 2 * ks + hh)); acc = MFMA32(a, bq, acc); if ((ks & 3) == 3) asm volatile("" : "+v"(acc) :: "memory"); }
                    const float tj = sT[j]; float rs = 0.f;
#pragma unroll
                    for (int gq = 0; gq < 4; ++gq) { const f32x4 us = *(const LAS f32x4*)(sU + 32 * stt + 8 * gq + 4 * hh); float pv[4];
#pragma unroll
                        for (int e = 0; e < 4; ++e) { const int s = 32 * stt + 8 * gq + 4 * hh + e; const bool ok = dir ? (s >= j) : (s <= j); const float p = ok ? acc[4 * gq + e] * __expf(us[e] - tj) : 0.f; rs += p; pv[e] = p; }
                        u32x2 w; w.x = pk2(pv[0], pv[1]); w.y = pk2(pv[2], pv[3]); *(LAS u32x2*)(PS + off_b(j, 4 * stt + gq) + 8 * hh) = w; }
                    rs += __shfl_xor(rs, 32); if (hh == 0) sDENP[stt * 128 + j] = rs;
                } else if (hh == 0) sDENP[stt * 128 + j] = 0.f;
            }
            { const int j = tid & 127, part = tid >> 7; float s = 0.f;
#pragma unroll
              for (int cc = 0; cc < 4; ++cc) { const u32x4 q8 = *(const LAS u32x4*)(QS + off_b(j, 4 * part + cc)); const f32x4 n0a = *(const LAS f32x4*)(sN0 + 32 * part + 8 * cc), n0b = *(const LAS f32x4*)(sN0 + 32 * part + 8 * cc + 4);
                  s += bf_lo(q8.x) * n0a[0] + bf_hi(q8.x) * n0a[1] + bf_lo(q8.y) * n0a[2] + bf_hi(q8.y) * n0a[3] + bf_lo(q8.z) * n0b[0] + bf_hi(q8.z) * n0b[1] + bf_lo(q8.w) * n0b[2] + bf_hi(q8.w) * n0b[3]; }
              sQNP[part * 128 + j] = s; }
            tid = (wid << 6) | lane_id(); asm volatile("" : "+v"(tid)); lane = tid & 63; r = lane & 31; hh = lane >> 5;
#pragma unroll
            for (int jt = 0; jt < 4; ++jt)
#pragma unroll
                for (int e = 0; e < 16; ++e) num[jt][e] = 0.f;
            {
                bf16x8 qf[2][4];
                auto ldq = [&](int g_, bf16x8 (&qb)[4]) { const int dkt = g_ >> 1, s2 = g_ & 1;
#pragma unroll
                    for (int jt = 0; jt < 4; ++jt) { const s16x4 lo = *(const LAS s16x4*)(QS + off_b(32 * jt + r, 4 * dkt + 2 * s2) + 8 * hh); const s16x4 hi = *(const LAS s16x4*)(QS + off_b(32 * jt + r, 4 * dkt + 2 * s2 + 1) + 8 * hh);
                        qb[jt] = __builtin_shufflevector(lo, hi, 0, 1, 2, 3, 4, 5, 6, 7); } };
                ldq(0, qf[0]);
#pragma unroll
                for (int g_ = 0; g_ < 8; ++g_) { const int dkt = g_ >> 1, s2 = g_ & 1;
                    if (g_ + 1 < 8) ldq(g_ + 1, qf[(g_ + 1) & 1]);
                    __builtin_amdgcn_sched_barrier(0);
                    u32x4 xp; xp.x = pk2(C[dkt][8 * s2 + 0], C[dkt][8 * s2 + 1]); xp.y = pk2(C[dkt][8 * s2 + 2], C[dkt][8 * s2 + 3]); xp.z = pk2(C[dkt][8 * s2 + 4], C[dkt][8 * s2 + 5]); xp.w = pk2(C[dkt][8 * s2 + 6], C[dkt][8 * s2 + 7]);
                    const bf16x8 xs = __builtin_bit_cast(bf16x8, xp);
#pragma unroll
                    for (int jt = 0; jt < 4; ++jt) num[jt] = MFMA32(xs, qf[g_ & 1][jt], num[jt]);
                    __builtin_amdgcn_sched_barrier(0);
                    if (s2 == 1) asm volatile("" : "+v"(num[0]), "+v"(num[1]), "+v"(num[2]), "+v"(num[3]) :: "memory"); }
            }
#pragma unroll
            for (int jt = 0; jt < 4; ++jt) { const float ws_ = sWST[32 * jt + r];
#pragma unroll
                for (int e = 0; e < 16; ++e) num[jt][e] *= ws_; }
            __syncthreads();
            tid = (wid << 6) | lane_id(); asm volatile("" : "+v"(tid)); lane = tid & 63; r = lane & 31; hh = lane >> 5;
            {
                bf16x8 pf[2][4];
                auto ldp = [&](int ks, bf16x8 (&pb)[4]) {
#pragma unroll
                    for (int jt = 0; jt < 4; ++jt) { const bool on = dir ? (ks >= 2 * jt) : (ks <= 2 * jt + 1); if (on) pb[jt] = *(const LAS bf16x8*)(PS + off_b(32 * jt + r, 2 * ks + hh)); } };
                ldp(0, pf[0]);
#pragma unroll
                for (int ks = 0; ks < 8; ++ks) {
                    if (ks + 1 < 8) ldp(ks + 1, pf[(ks + 1) & 1]);
                    __builtin_amdgcn_sched_barrier(0);
#pragma unroll
                    for (int jt = 0; jt < 4; ++jt) { const bool on = dir ? (ks >= 2 * jt) : (ks <= 2 * jt + 1); if (on) num[jt] = MFMA32(vf[ks], pf[ks & 1][jt], num[jt]); }
                    __builtin_amdgcn_sched_barrier(0); }
                asm volatile("" : "+v"(num[0]), "+v"(num[1]), "+v"(num[2]), "+v"(num[3]) :: "memory");
            }
            bf16_t* Hd = (bf16_t*)(P.ws + (dir ? WS_HB : WS_HF));
#pragma unroll
            for (int jt = 0; jt < 4; ++jt) { const int j = 32 * jt + r;
                const float den = (sDENP[j] + sDENP[128 + j]) + (sDENP[256 + j] + sDENP[384 + j]) + sWST[j] * ((sQNP[j] + sQNP[128 + j]) + (sQNP[256 + j] + sQNP[384 + j]));
                const float inv = 1.0f / fmaxf(fabsf(den), sCL[j]);
                bf16_t* hp = Hd + (size_t)(tok0 + j) * 1024 + h * 256 + 32 * wid + 4 * hh;
#pragma unroll
                for (int gq = 0; gq < 4; ++gq) { u32x2 w; w.x = pk2(num[jt][4 * gq] * inv, num[jt][4 * gq + 1] * inv); w.y = pk2(num[jt][4 * gq + 2] * inv, num[jt][4 * gq + 3] * inv); *(u32x2*)(hp + 8 * gq) = w; } }
        }
        tid = (wid << 6) | lane_id(); asm volatile("" : "+v"(tid)); lane = tid & 63; r = lane & 31; hh = lane >> 5;
        { const int tokn = chunk_tok0(ci + 1 < nchunks ? ci + 1 : ci);
#pragma unroll
            for (int i = 0; i < 4; ++i) { const int n = tid + 512 * i, row = n >> 4, ch = n & 15; kq[i] = *(const u32x4*)(Kg + (size_t)(tokn + row) * 512 + h * 128 + ch * 8);
                if (PASS2) kq[4 + i] = *(const u32x4*)(Qg + (size_t)(tokn + row) * 512 + h * 128 + ch * 8); } }
        const float a = sMISC[0];
#pragma unroll
        for (int dkt = 0; dkt < 4; ++dkt)
#pragma unroll
            for (int e = 0; e < 16; ++e) C[dkt][e] *= a;
#pragma unroll
        for (int ks = 0; ks < 8; ++ks) { const f32x4 e0 = *(const LAS f32x4*)(sEV + 16 * ks + 8 * hh), e1 = *(const LAS f32x4*)(sEV + 16 * ks + 8 * hh + 4);
            u32x4 v = __builtin_bit_cast(u32x4, vf[ks]);
            v.x = pk2(bf_lo(v.x) * e0[0], bf_hi(v.x) * e0[1]); v.y = pk2(bf_lo(v.y) * e0[2], bf_hi(v.y) * e0[3]); v.z = pk2(bf_lo(v.z) * e1[0], bf_hi(v.z) * e1[1]); v.w = pk2(bf_lo(v.w) * e1[2], bf_hi(v.w) * e1[3]);
            vf[ks] = __builtin_bit_cast(bf16x8, v); }
        { const unsigned blk = (lane >> 4) & 1, q = (lane & 15) >> 2, p = lane & 3;
          bf16x8 kf[2][4];
          auto ldk = [&](int ks, bf16x8 (&kb)[4]) {
#pragma unroll
              for (int dkt = 0; dkt < 4; ++dkt) {
                  const s16x4 lo = __builtin_amdgcn_ds_read_tr16_b64_v4i16((LAS s16x4*)(KS + off_b(16 * ks + 8 * hh + q, 4 * dkt + 2 * blk + (p >> 1)) + 8 * (p & 1)));
                  const s16x4 hi = __builtin_amdgcn_ds_read_tr16_b64_v4i16((LAS s16x4*)(KS + off_b(16 * ks + 8 * hh + 4 + q, 4 * dkt + 2 * blk + (p >> 1)) + 8 * (p & 1)));
                  kb[dkt] = __builtin_shufflevector(lo, hi, 0, 1, 2, 3, 4, 5, 6, 7); } };
          ldk(0, kf[0]);
#pragma unroll
          for (int ks = 0; ks < 8; ++ks) {
              if (ks + 1 < 8) ldk(ks + 1, kf[(ks + 1) & 1]);
              __builtin_amdgcn_sched_barrier(0);
#pragma unroll
              for (int dkt = 0; dkt < 4; ++dkt) C[dkt] = MFMA32(kf[ks & 1][dkt], vf[ks], C[dkt]);
              __builtin_amdgcn_sched_barrier(0); }
          asm volatile("" : "+v"(C[0]), "+v"(C[1]), "+v"(C[2]), "+v"(C[3]) :: "memory"); }
        { const int dk = tid & 127, part = tid >> 7; float s = 0.f;
#pragma unroll 8
          for (int i = 0; i < 32; ++i) { const int sp = 32 * part + i; s += sEV[sp] * bf2f(*(const LAS unsigned short*)(KS + off_b(sp, dk >> 3) + (dk & 7) * 2)); }
          sNPART[part * 128 + dk] = s; }
        __syncthreads();
        if (tid < 128) sN0[tid] = a * sN0[tid] + ((sNPART[tid] + sNPART[128 + tid]) + (sNPART[256 + tid] + sNPART[384 + tid]));
        __syncthreads();
    }
    if (!PASS2) {
        float* tc = (float*)(P.ws + WS_TUPC) + ((size_t)st * 16 + g) * 32768;
#pragma unroll
        for (int dkt = 0; dkt < 4; ++dkt)
#pragma unroll
            for (int e = 0; e < 16; ++e) tc[(32 * dkt + (e & 3) + 8 * (e >> 2) + 4 * hh) * 256 + 32 * wid + r] = C[dkt][e];
        if (tid < 128) ((float*)(P.ws + WS_TUPN))[((size_t)st * 16 + g) * 128 + tid] = sN0[tid];
        if (tid == 0) { float* ts = (float*)(P.ws + WS_TUPN + 512 * 1024) + ((size_t)st * 16 + g) * 2; ts[0] = sMISC[2]; ts[1] = sMISC[1]; }
    }
    __syncthreads();
}
DI void mlstm_pass1(const Params& P, LAS unsigned char* lds, int st, int g) {
    const int wid = wave_in_wg();
    int tid = (wid << 6) | lane_id(), lane = tid & 63, r = lane & 31, hh = lane >> 5;
    const int dir = st >> 3, b = (st >> 2) & 1, h = st & 3;
    LAS float* SC = (LAS float*)(lds + ML_SC);
    LAS float* sEVA = SC;
    LAS float* sNPART = SC + SC_NPART / 4; LAS float* sMISC = SC + SC_MISC / 4;
    LAS float* sALL = SC + 10496 / 4; LAS float* sCH = sALL + 8 * 3 * 128; LAS float* sA = sCH + 40;
    const bf16_t* Kg = (const bf16_t*)(P.ws + WS_K); const bf16_t* VT = (const bf16_t*)(P.ws + WS_VT);
    const float* gates = (const float*)(P.ws + WS_GATES);
    const int ctx_item = (g == 0); const int nchunks = ctx_item ? 2 : 8; const int seg = g - 1;
    f32x16 C[4];
#pragma unroll
    for (int i = 0; i < 4; ++i)
#pragma unroll
        for (int e = 0; e < 16; ++e) C[i][e] = 0.f;
    __syncthreads();
    auto chunk_tok0 = [&](int ci) -> int { if (ctx_item) return T + b * CTXL + (dir ? (1 - ci) : ci) * 128;
        const int cp = seg * 8 + ci; const int chunk = dir ? (NCHUNK - 1 - cp) : cp; return b * SEQ + chunk * 128; };
    if (wid < nchunks) { const int t0c = chunk_tok0(wid);
        const int p0 = dir ? 127 - 2 * lane : 2 * lane, p1 = dir ? 126 - 2 * lane : 2 * lane + 1;
        const float* g0 = gates + (size_t)(t0c + p0) * 16; const float* g1 = gates + (size_t)(t0c + p1) * 16;
        const float li0 = softcap(g0[dir * 8 + h]), li1 = softcap(g1[dir * 8 + h]); const float lf0 = logsigmoid(softcap(g0[dir * 8 + 4 + h])), lf1 = logsigmoid(softcap(g1[dir * 8 + 4 + h]));
        float sm = lf0 + lf1;
#pragma unroll
        for (int o = 1; o < 64; o <<= 1) { const float t = __shfl_up(sm, o); if (lane >= o) sm += t; }
        const float b0 = sm - lf1, b1 = sm;
        const float u0 = li0 - b0, u1 = li1 - b1;
        float mx = fmaxf(u0, u1);
#pragma unroll
        for (int o = 1; o < 64; o <<= 1) { const float t = __shfl_up(mx, o); if (lane >= o) mx = fmaxf(mx, t); }
        LAS float* A = sALL + wid * 384;
        A[p0] = u0; A[p1] = u1;
        if (lane == 63) { sCH[wid * 4 + 0] = sm; sCH[wid * 4 + 1] = mx; }
    }
    __syncthreads();
    if (tid == 0) { float m0 = -1e30f, bsum = 0.f;
        for (int c = 0; c < nchunks; ++c) { const float Bt = sCH[c * 4 + 0], U = sCH[c * 4 + 1]; const float Mp = fmaxf(m0, U); sCH[c * 4 + 3] = Mp; sA[c] = __expf(m0 - Mp); m0 = Bt + Mp; bsum += Bt; }
        sMISC[1] = m0; sMISC[2] = bsum; }
    u32x4 kq[4]; bf16x8 vf[8], vfn[8];
    { const int tok0 = chunk_tok0(0);
#pragma unroll
      for (int i = 0; i < 4; ++i) { const int n = tid + 512 * i, row = n >> 4, ch = n & 15; kq[i] = *(const u32x4*)(Kg + (size_t)(tok0 + row) * 512 + h * 128 + ch * 8); }
#pragma unroll
      for (int ks = 0; ks < 8; ++ks) vfn[ks] = *(const bf16x8*)(VT + (size_t)(h * 256 + 32 * wid + r) * MT + tok0 + 16 * ks + 8 * hh); }
    __syncthreads();
    for (int i = tid; i < nchunks * 128; i += 512) { const int c = i >> 7; sEVA[i] = __expf(sALL[c * 384 + (i & 127)] - sCH[c * 4 + 3]); }
    float nacc = 0.f;
    for (int ci = 0; ci < nchunks; ++ci) {
        tid = (wid << 6) | lane_id(); asm volatile("" : "+v"(tid)); lane = tid & 63; r = lane & 31; hh = lane >> 5;
        LAS unsigned char* KB = lds + ((ci & 1) ? ML_PS : ML_KS);
#pragma unroll
        for (int i = 0; i < 4; ++i) { const int n = tid + 512 * i, row = n >> 4, ch = n & 15; *(LAS u32x4*)(KB + off_b(row, ch)) = kq[i]; }
#pragma unroll
        for (int ks = 0; ks < 8; ++ks) vf[ks] = vfn[ks];
        { const int tokn = chunk_tok0(ci + 1 < nchunks ? ci + 1 : ci);
#pragma unroll
            for (int i = 0; i < 4; ++i) { const int n = tid + 512 * i, row = n >> 4, ch = n & 15; kq[i] = *(const u32x4*)(Kg + (size_t)(tokn + row) * 512 + h * 128 + ch * 8); }
#pragma unroll
            for (int ks = 0; ks < 8; ++ks) vfn[ks] = *(const bf16x8*)(VT + (size_t)(h * 256 + 32 * wid + r) * MT + tokn + 16 * ks + 8 * hh); }
        __syncthreads();
        const LAS float* sEV = sEVA + ci * 128;
        const float a = sA[ci];
#pragma unroll
        for (int dkt = 0; dkt < 4; ++dkt)
#pragma unroll
            for (int e = 0; e < 16; ++e) C[dkt][e] *= a;
#pragma unroll
        for (int ks = 0; ks < 8; ++ks) { const f32x4 e0 = *(const LAS f32x4*)(sEV + 16 * ks + 8 * hh), e1 = *(const LAS f32x4*)(sEV + 16 * ks + 8 * hh + 4);
            u32x4 v = __builtin_bit_cast(u32x4, vf[ks]);
            v.x = pk2(bf_lo(v.x) * e0[0], bf_hi(v.x) * e0[1]); v.y = pk2(bf_lo(v.y) * e0[2], bf_hi(v.y) * e0[3]); v.z = pk2(bf_lo(v.z) * e1[0], bf_hi(v.z) * e1[1]); v.w = pk2(bf_lo(v.w) * e1[2], bf_hi(v.w) * e1[3]);
            vf[ks] = __builtin_bit_cast(bf16x8, v); }
        { const unsigned blk = (lane >> 4) & 1, q = (lane & 15) >> 2, p = lane & 3;
          bf16x8 kf[2][4];
          auto ldk = [&](int ks, bf16x8 (&kb)[4]) {
#pragma unroll
              for (int dkt = 0; dkt < 4; ++dkt) {
                  const s16x4 lo = __builtin_amdgcn_ds_read_tr16_b64_v4i16((LAS s16x4*)(KB + off_b(16 * ks + 8 * hh + q, 4 * dkt + 2 * blk + (p >> 1)) + 8 * (p & 1)));
                  const s16x4 hi = __builtin_amdgcn_ds_read_tr16_b64_v4i16((LAS s16x4*)(KB + off_b(16 * ks + 8 * hh + 4 + q, 4 * dkt + 2 * blk + (p >> 1)) + 8 * (p & 1)));
                  kb[dkt] = __builtin_shufflevector(lo, hi, 0, 1, 2, 3, 4, 5, 6, 7); } };
          ldk(0, kf[0]);
#pragma unroll
          for (int ks = 0; ks < 8; ++ks) {
              if (ks + 1 < 8) ldk(ks + 1, kf[(ks + 1) & 1]);
              __builtin_amdgcn_sched_barrier(0);
#pragma unroll
              for (int dkt = 0; dkt < 4; ++dkt) C[dkt] = MFMA32(kf[ks & 1][dkt], vf[ks], C[dkt]);
              __builtin_amdgcn_sched_barrier(0); }
          asm volatile("" : "+v"(C[0]), "+v"(C[1]), "+v"(C[2]), "+v"(C[3]) :: "memory"); }
        { const int dk = tid & 127, part = tid >> 7; float s_ = 0.f;
#pragma unroll 8
          for (int i = 0; i < 32; ++i) { const int sp = 32 * part + i; s_ += sEV[sp] * bf2f(*(const LAS unsigned short*)(KB + off_b(sp, dk >> 3) + (dk & 7) * 2)); }
          nacc = a * nacc + s_; }
    }
    tid = (wid << 6) | lane_id(); asm volatile("" : "+v"(tid)); lane = tid & 63; r = lane & 31; hh = lane >> 5;
    float* tc = (float*)(P.ws + WS_TUPC) + ((size_t)st * 16 + g) * 32768;
#pragma unroll
    for (int dkt = 0; dkt < 4; ++dkt)
#pragma unroll
        for (int e = 0; e < 16; ++e) tc[(32 * dkt + (e & 3) + 8 * (e >> 2) + 4 * hh) * 256 + 32 * wid + r] = C[dkt][e];
    sNPART[tid] = nacc;
    __syncthreads();
    if (tid < 128) ((float*)(P.ws + WS_TUPN))[((size_t)st * 16 + g) * 128 + tid] = (sNPART[tid] + sNPART[128 + tid]) + (sNPART[256 + tid] + sNPART[384 + tid]);
    if (tid == 0) { float* ts = (float*)(P.ws + WS_TUPN + 512 * 1024) + ((size_t)st * 16 + g) * 2; ts[0] = sMISC[2]; ts[1] = sMISC[1]; }
    __syncthreads();
}
DI void p4_scan(const Params& P, int G, int bid) {
    const int tid = my_tid();
    for (int it = bid; it < 256; it += G) { const int st = it >> 4, sl = it & 15;
        const float* tc = (const float*)(P.ws + WS_TUPC) + (size_t)st * 16 * 32768 + sl * 2048 + tid * 4;
        float* ec = (float*)(P.ws + WS_ENTC) + (size_t)st * 16 * 32768 + sl * 2048 + tid * 4;
        const float* tn = (const float*)(P.ws + WS_TUPN) + (size_t)st * 16 * 128; const float* ts = (const float*)(P.ws + WS_TUPN + 512 * 1024) + (size_t)st * 16 * 2;
        float* en = (float*)(P.ws + WS_ENTN) + (size_t)st * 16 * 128; float* em = (float*)(P.ws + WS_ENTN + 512 * 1024) + st * 16;
        f32x4 Cv = {0.f, 0.f, 0.f, 0.f}; float nv = 0.f, m = 0.f;
        f32x4 Ctv[16];
#pragma unroll
        for (int g = 0; g < 16; ++g) Ctv[g] = *(const f32x4*)(tc + (size_t)g * 32768);
        f32x4 tsv[8]; float tnv[16]; const bool nrow = (sl == 0 && tid < 128);
#pragma unroll
        for (int g = 0; g < 8; ++g) tsv[g] = *(const f32x4*)(ts + 4 * g);
#pragma unroll
        for (int g = 0; g < 16; ++g) tnv[g] = nrow ? tn[g * 128 + tid] : 0.f;
#pragma unroll
        for (int g = 0; g < 16; ++g) { const float Bt = tsv[g >> 1][2 * (g & 1)], mt = tsv[g >> 1][2 * (g & 1) + 1]; const float mn = fmaxf(Bt + m, mt); const float a = __expf(Bt + m - mn), gg = __expf(mt - mn);
            const f32x4 Ct = Ctv[g]; Cv = Cv * a + Ct * gg; *(f32x4*)(ec + (size_t)g * 32768) = Cv;
            if (nrow) { nv = a * nv + gg * tnv[g]; en[g * 128 + tid] = nv; }
            m = mn; if (sl == 0 && tid == 0) em[g] = m; }
    }
}

DI void p6_merge(const Params& P, int G, int bid) {
    const int tid = my_tid(), wid = __builtin_amdgcn_readfirstlane(tid >> 6), lane = tid & 63;
    const bf16_t* HF = (const bf16_t*)(P.ws + WS_HF); const bf16_t* HB = (const bf16_t*)(P.ws + WS_HB); const bf16_t* OB = (const bf16_t*)(P.ws + WS_O);
    const bf16_t* CB = (const bf16_t*)(P.ws + WS_CB); const bf16_t* CP = (const bf16_t*)(P.ws + WS_CC);
    unsigned char* A2 = (unsigned char*)(P.ws + WS_A2); float* asc = (float*)(P.ws + WS_ASC); const float* ng = P.in[I_NORMG]; const float* cw = P.in[I_CONVW];
    const int c0 = lane * 16;
    float ngv[16], cwv[3][16];
#pragma unroll
    for (int i = 0; i < 16; ++i) { ngv[i] = ng[c0 + i]; cwv[0][i] = cw[c0 + i]; cwv[1][i] = cw[1024 + c0 + i]; cwv[2][i] = cw[2048 + c0 + i]; }
    u32x4 L[14], N[14];
    const int dl = lane < 32 ? 1 : 64;
    auto issue = [&](int row, u32x4 (&R)[14]) {
        R[0] = *(const u32x4*)(HF + (size_t)row * 1024 + c0); R[1] = *(const u32x4*)(HF + (size_t)row * 1024 + c0 + 8);
        R[2] = *(const u32x4*)(HB + (size_t)row * 1024 + c0); R[3] = *(const u32x4*)(HB + (size_t)row * 1024 + c0 + 8);
        R[4] = *(const u32x4*)(OB + (size_t)row * 1024 + c0); R[5] = *(const u32x4*)(OB + (size_t)row * 1024 + c0 + 8);
        const int s_ = row & (SEQ - 1); const bool okl = lane < 32 ? ((s_ & 63) != 0) : (s_ >= 64); const bool okr = lane < 32 ? ((s_ & 63) != 63) : (s_ < SEQ - 64);
#pragma unroll
        for (int tpos = 0; tpos < 3; ++tpos) { const bool ok = tpos == 0 ? okl : (tpos == 2 ? okr : true);
            const size_t rr = (size_t)(row + (ok ? (tpos - 1) * dl : 0)) * 1024 + c0; R[6 + 2 * tpos] = *(const u32x4*)(CP + rr); R[7 + 2 * tpos] = *(const u32x4*)(CP + rr + 8); }
        R[12] = *(const u32x4*)(CB + (size_t)row * 1024 + c0); R[13] = *(const u32x4*)(CB + (size_t)row * 1024 + c0 + 8); };
    int row = bid * 8 + wid;
    if (row < T) issue(row, L);
    for (; row < T; row += G * 8) {
        const int nrow = row + G * 8;
        issue(nrow < T ? nrow : row, N);
        asm volatile("" ::: "memory");
        float y[16], z[16];
        { const u32x4 f0 = L[0], f1 = L[1], b0 = L[2], b1 = L[3], o0 = L[4], o1 = L[5];
          float hv[16], ov[16];
#pragma unroll
          for (int i = 0; i < 4; ++i) { hv[2 * i] = bf_lo(f0[i]) + bf_lo(b0[i]); hv[2 * i + 1] = bf_hi(f0[i]) + bf_hi(b0[i]); hv[8 + 2 * i] = bf_lo(f1[i]) + bf_lo(b1[i]); hv[8 + 2 * i + 1] = bf_hi(f1[i]) + bf_hi(b1[i]);
              ov[2 * i] = bf_lo(o0[i]); ov[2 * i + 1] = bf_hi(o0[i]); ov[8 + 2 * i] = bf_lo(o1[i]); ov[8 + 2 * i + 1] = bf_hi(o1[i]); }
          float ss = 0.f;
#pragma unroll
          for (int i = 0; i < 16; ++i) ss += hv[i] * hv[i];
          ss = row16_sum(ss);
          const float rs = 1.0f / sqrtf(ss * (1.0f / 256.0f) + EPS);
#pragma unroll
          for (int i = 0; i < 16; ++i) y[i] = hv[i] * rs * ngv[i] * (1.0f / (1.0f + __expf(-ov[i]))); }
        { const int s_ = row & (SEQ - 1); const bool okl = lane < 32 ? ((s_ & 63) != 0) : (s_ >= 64); const bool okr = lane < 32 ? ((s_ & 63) != 63) : (s_ < SEQ - 64);
          float acc[16];
#pragma unroll
          for (int i = 0; i < 16; ++i) acc[i] = 0.f;
#pragma unroll
          for (int tpos = 0; tpos < 3; ++tpos) { const u32x4 a0 = L[6 + 2 * tpos], a1 = L[7 + 2 * tpos]; const float m = tpos == 0 ? (okl ? 1.0f : 0.0f) : (tpos == 2 ? (okr ? 1.0f : 0.0f) : 1.0f);
#pragma unroll
              for (int i = 0; i < 4; ++i) { acc[2 * i] += m * cwv[tpos][2 * i] * bf_lo(a0[i]); acc[2 * i + 1] += m * cwv[tpos][2 * i + 1] * bf_hi(a0[i]);
                  acc[8 + 2 * i] += m * cwv[tpos][8 + 2 * i] * bf_lo(a1[i]); acc[8 + 2 * i + 1] += m * cwv[tpos][8 + 2 * i + 1] * bf_hi(a1[i]); } }
          const u32x4 g0 = L[12], g1 = L[13];
#pragma unroll
          for (int i = 0; i < 4; ++i) { z[2 * i] = acc[2 * i] * bf_lo(g0[i]); z[2 * i + 1] = acc[2 * i + 1] * bf_hi(g0[i]); z[8 + 2 * i] = acc[8 + 2 * i] * bf_lo(g1[i]); z[8 + 2 * i + 1] = acc[8 + 2 * i + 1] * bf_hi(g1[i]); } }
        float mx = 0.f;
#pragma unroll
        for (int i = 0; i < 16; ++i) mx = fmaxf(mx, fmaxf(fabsf(y[i]), fabsf(z[i])));
        mx = wave_max(mx);
        const float inv = mx > 0.f ? 127.0f / mx : 0.f;
        if (lane == 0) asc[row] = mx > 0.f ? mx * (1.0f / 127.0f) : 1.0f;
        u32x4 w0, w1;
        w0.x = pk4i8(__builtin_rintf(y[0] * inv), __builtin_rintf(y[1] * inv), __builtin_rintf(y[2] * inv), __builtin_rintf(y[3] * inv)); w0.y = pk4i8(__builtin_rintf(y[4] * inv), __builtin_rintf(y[5] * inv), __builtin_rintf(y[6] * inv), __builtin_rintf(y[7] * inv));
        w0.z = pk4i8(__builtin_rintf(y[8] * inv), __builtin_rintf(y[9] * inv), __builtin_rintf(y[10] * inv), __builtin_rintf(y[11] * inv)); w0.w = pk4i8(__builtin_rintf(y[12] * inv), __builtin_rintf(y[13] * inv), __builtin_rintf(y[14] * inv), __builtin_rintf(y[15] * inv));
        w1.x = pk4i8(__builtin_rintf(z[0] * inv), __builtin_rintf(z[1] * inv), __builtin_rintf(z[2] * inv), __builtin_rintf(z[3] * inv)); w1.y = pk4i8(__builtin_rintf(z[4] * inv), __builtin_rintf(z[5] * inv), __builtin_rintf(z[6] * inv), __builtin_rintf(z[7] * inv));
        w1.z = pk4i8(__builtin_rintf(z[8] * inv), __builtin_rintf(z[9] * inv), __builtin_rintf(z[10] * inv), __builtin_rintf(z[11] * inv)); w1.w = pk4i8(__builtin_rintf(z[12] * inv), __builtin_rintf(z[13] * inv), __builtin_rintf(z[14] * inv), __builtin_rintf(z[15] * inv));
        *(u32x4*)(A2 + (size_t)row * D + c0) = w0; *(u32x4*)(A2 + (size_t)row * D + 1024 + c0) = w1;
#pragma unroll
        for (int i = 0; i < 14; ++i) L[i] = N[i];
    }
}

DI void topk_block256(const Params& P, LAS unsigned char* lds, int row0) {
    const int tid = my_tid();
    LAS unsigned* lc = (LAS unsigned*)lds; LAS unsigned* lbase = lc + 32;
    const float* logits = (const float*)(P.ws + WS_LOGITS); unsigned* gc = (unsigned*)(P.ws + WS_CTL) + CW_GCNT;
    int* list = (int*)(P.ws + WS_LIST); float* listw = (float*)(P.ws + WS_LISTW);
    if (tid < 32) lc[tid] = 0u;
    __syncthreads();
    const bool act = tid < 256; const int tok = row0 + (act ? tid : 0);
    float v[32];
#pragma unroll
    for (int i = 0; i < 8; ++i) { const f32x4 t = *(const f32x4*)(logits + (size_t)tok * NE + 4 * i); v[4 * i] = t[0]; v[4 * i + 1] = t[1]; v[4 * i + 2] = t[2]; v[4 * i + 3] = t[3]; }
    int idx[4]; float val[4];
#pragma unroll
    for (int k = 0; k < 4; ++k) { float best = -3.0e38f; int bi = 0;
#pragma unroll
        for (int e = 0; e < 32; ++e) { const bool taken = (k > 0 && idx[0] == e) || (k > 1 && idx[1] == e) || (k > 2 && idx[2] == e); if (!taken && v[e] > best) { best = v[e]; bi = e; } }
        idx[k] = bi; val[k] = best; }
    float w[4]; float sum = 0.f;
#pragma unroll
    for (int k = 0; k < 4; ++k) { w[k] = __expf(val[k] - val[0]); sum += w[k]; }
    const float inv = 1.0f / sum;
    unsigned rank[4] = {0u, 0u, 0u, 0u};
    if (act) {
#pragma unroll
        for (int k = 0; k < 4; ++k) rank[k] = atomicAdd((unsigned*)&lc[idx[k]], 1u); }
    __syncthreads();
    if (tid < 32) lbase[tid] = __hip_atomic_fetch_add(gc + tid, lc[tid], __ATOMIC_RELAXED, __HIP_MEMORY_SCOPE_AGENT);
    __syncthreads();
    if (act) {
#pragma unroll
        for (int k = 0; k < 4; ++k) { const unsigned pos = lbase[idx[k]] + rank[k]; list[(size_t)idx[k] * T + pos] = tok * 4 + k; listw[(size_t)idx[k] * T + pos] = w[k] * inv; } }
    __syncthreads();
}
DI void p8_topk(const Params& P, LAS unsigned char* lds, int G, int bid) {
    const int tid = my_tid();
    LAS unsigned* lc = (LAS unsigned*)lds; LAS unsigned* lbase = lc + 32;
    const float* logits = (const float*)(P.ws + WS_LOGITS); unsigned* gc = (unsigned*)(P.ws + WS_CTL) + CW_GCNT;
    int* list = (int*)(P.ws + WS_LIST); float* listw = (float*)(P.ws + WS_LISTW);
    for (int blk = bid; blk < T / 512; blk += G) {
        __syncthreads();
        if (tid < 32) lc[tid] = 0u;
        __syncthreads();
        const int tok = blk * 512 + tid;
        float v[32];
#pragma unroll
        for (int i = 0; i < 8; ++i) { const f32x4 t = *(const f32x4*)(logits + (size_t)tok * NE + 4 * i); v[4 * i] = t[0]; v[4 * i + 1] = t[1]; v[4 * i + 2] = t[2]; v[4 * i + 3] = t[3]; }
        int idx[4]; float val[4];
#pragma unroll
        for (int k = 0; k < 4; ++k) { float best = -3.0e38f; int bi = 0;
#pragma unroll
            for (int e = 0; e < 32; ++e) { const bool taken = (k > 0 && idx[0] == e) || (k > 1 && idx[1] == e) || (k > 2 && idx[2] == e); if (!taken && v[e] > best) { best = v[e]; bi = e; } }
            idx[k] = bi; val[k] = best; }
        float w[4]; float sum = 0.f;
#pragma unroll
        for (int k = 0; k < 4; ++k) { w[k] = __expf(val[k] - val[0]); sum += w[k]; }
        const float inv = 1.0f / sum;
        unsigned rank[4];
#pragma unroll
        for (int k = 0; k < 4; ++k) rank[k] = atomicAdd((unsigned*)&lc[idx[k]], 1u);
        __syncthreads();
        if (tid < 32) lbase[tid] = __hip_atomic_fetch_add(gc + tid, lc[tid], __ATOMIC_RELAXED, __HIP_MEMORY_SCOPE_AGENT);
        __syncthreads();
#pragma unroll
        for (int k = 0; k < 4; ++k) { const unsigned pos = lbase[idx[k]] + rank[k]; list[(size_t)idx[k] * T + pos] = tok * 4 + k; listw[(size_t)idx[k] * T + pos] = w[k] * inv; }
    }
    __syncthreads();
}
DI void p8_gather(const Params& P, LAS unsigned char* lds, int G, int bid) {
    const int tid = my_tid(), wid = __builtin_amdgcn_readfirstlane(tid >> 6), lane = tid & 63;
    const LAS int* tab = (const LAS int*)(lds + LDS_CTL_OFF + 64);
    const unsigned char* XN2 = (const unsigned char*)(P.ws + WS_XN8); unsigned char* XG = (unsigned char*)(P.ws + WS_XG); const int* list = (const int*)(P.ws + WS_LIST);
    const int nrows = __builtin_amdgcn_readfirstlane(tab[64]) * 256; const int nw = G * 8; const int per = (((nrows + nw - 1) / nw) + 7) & ~7;
    const int r0 = (bid * 8 + wid) * per; const int r1 = (r0 + per) < nrows ? (r0 + per) : nrows;
#pragma unroll 1
    for (int R0 = r0; R0 < r1; R0 += 64) {
        const int R = R0 + lane; int tokv = 0;
        if (R < r1) { const int tile = R >> 8; int e = 0;
            for (int k = 1; k < 32; ++k) if (tile >= tab[32 + k]) e = k;
            const int pos = R - tab[32 + e] * 256; tokv = pos < tab[e] ? (list[(size_t)e * T + pos] >> 2) : 0; }
        const int nr = (r1 - R0) < 64 ? (r1 - R0) : 64;
#pragma unroll 1
        for (int rb = 0; rb < nr; rb += 8) { u32x4 v[8][2];
#pragma unroll
            for (int q = 0; q < 8; ++q) { const int tok = __shfl(tokv, rb + q); const u32x4* src = (const u32x4*)(XN2 + (size_t)tok * D); v[q][0] = src[lane]; v[q][1] = src[lane + 64]; }
#pragma unroll
            for (int q = 0; q < 8; ++q) { u32x4* dst = (u32x4*)(XG + (size_t)(R0 + rb + q) * D); dst[lane] = v[q][0]; dst[lane + 64] = v[q][1]; } }
    }
}

DI void p11_final(const Params& P, int G, int bid) {
    const int tid = my_tid(), wid = __builtin_amdgcn_readfirstlane(tid >> 6), lane = tid & 63;
    const bf16_t* X1 = (const bf16_t*)(P.ws + WS_X1); const unsigned char* YS = (const unsigned char*)(P.ws + WS_YS); const float* modf = (const float*)(P.ws + WS_MODF); const float* gfin = P.in[I_GFIN];
    for (int row = (bid * 8 + wid) * 2; row < T; row += G * 16) {
        const float* gt = modf + (size_t)(row / SEQ) * NMOD + 5 * D;
        f32x4 va[8], vb[8]; float sa = 0.f, sb = 0.f;
#pragma unroll
        for (int j = 0; j < 4; ++j) { const int c = 512 * j + 8 * lane; f32x4 m0 = {0.f, 0.f, 0.f, 0.f}, m1 = m0, n0 = m0, n1 = m0;
#pragma unroll
            for (int k = 0; k < 4; ++k) { const u32x2 y = *(const u32x2*)(YS + ((size_t)row * 4 + k) * D + c), z = *(const u32x2*)(YS + ((size_t)(row + 1) * 4 + k) * D + c);
                const f32x2 a = __builtin_amdgcn_cvt_pk_f32_fp8((int)y.x, false), b = __builtin_amdgcn_cvt_pk_f32_fp8((int)y.x, true), cc = __builtin_amdgcn_cvt_pk_f32_fp8((int)y.y, false), d = __builtin_amdgcn_cvt_pk_f32_fp8((int)y.y, true);
                m0[0] += a[0]; m0[1] += a[1]; m0[2] += b[0]; m0[3] += b[1]; m1[0] += cc[0]; m1[1] += cc[1]; m1[2] += d[0]; m1[3] += d[1];
                const f32x2 a2 = __builtin_amdgcn_cvt_pk_f32_fp8((int)z.x, false), b2 = __builtin_amdgcn_cvt_pk_f32_fp8((int)z.x, true), c2 = __builtin_amdgcn_cvt_pk_f32_fp8((int)z.y, false), d2 = __builtin_amdgcn_cvt_pk_f32_fp8((int)z.y, true);
                n0[0] += a2[0]; n0[1] += a2[1]; n0[2] += b2[0]; n0[3] += b2[1]; n1[0] += c2[0]; n1[1] += c2[1]; n1[2] += d2[0]; n1[3] += d2[1]; }
            f32x4 x0, x1v, y0, y1v; unpack8(*(const u32x4*)(X1 + (size_t)row * D + c), x0, x1v); unpack8(*(const u32x4*)(X1 + (size_t)(row + 1) * D + c), y0, y1v);
            const f32x4 g0 = *(const f32x4*)(gt + c), g1 = *(const f32x4*)(gt + c + 4);
            va[2 * j] = x0 + g0 * m0; va[2 * j + 1] = x1v + g1 * m1; vb[2 * j] = y0 + g0 * n0; vb[2 * j + 1] = y1v + g1 * n1;
            sa += (va[2 * j][0] * va[2 * j][0] + va[2 * j][1] * va[2 * j][1]) + (va[2 * j][2] * va[2 * j][2] + va[2 * j][3] * va[2 * j][3]) + (va[2 * j + 1][0] * va[2 * j + 1][0] + va[2 * j + 1][1] * va[2 * j + 1][1]) + (va[2 * j + 1][2] * va[2 * j + 1][2] + va[2 * j + 1][3] * va[2 * j + 1][3]);
            sb += (vb[2 * j][0] * vb[2 * j][0] + vb[2 * j][1] * vb[2 * j][1]) + (vb[2 * j][2] * vb[2 * j][2] + vb[2 * j][3] * vb[2 * j][3]) + (vb[2 * j + 1][0] * vb[2 * j + 1][0] + vb[2 * j + 1][1] * vb[2 * j + 1][1]) + (vb[2 * j + 1][2] * vb[2 * j + 1][2] + vb[2 * j + 1][3] * vb[2 * j + 1][3]); }
        const float ra = 1.0f / sqrtf(wave_sum(sa) * (1.0f / D) + EPS), rb = 1.0f / sqrtf(wave_sum(sb) * (1.0f / D) + EPS);
#pragma unroll
        for (int j = 0; j < 4; ++j) { const int c = 512 * j + 8 * lane; const f32x4 f0 = *(const f32x4*)(gfin + c), f1 = *(const f32x4*)(gfin + c + 4);
            *(f32x4*)(P.out + (size_t)row * D + c) = va[2 * j] * ra * f0; *(f32x4*)(P.out + (size_t)row * D + c + 4) = va[2 * j + 1] * ra * f1;
            *(f32x4*)(P.out + (size_t)(row + 1) * D + c) = vb[2 * j] * rb * f0; *(f32x4*)(P.out + (size_t)(row + 1) * D + c + 4) = vb[2 * j + 1] * rb * f1; }
    }
}

__global__ void __launch_bounds__(512, 2) hymba_fwd(Params P) {
    LAS unsigned char* lds = (LAS unsigned char*)lds_raw;
    const int G = gridDim.x, bid = blockIdx.x;
    { const int t0 = threadIdx.x;
      for (int u = t0; u < 256; u += 512) ((LAS unsigned*)(lds + LDS_CTL_OFF))[u] = 0u;
      if ((t0 & 63) == 0) ((LAS int*)(lds + LDS_CTL_OFF + 1024))[hw_wave_slot()] = t0 >> 6; }
    __syncthreads();
#if MK_ONE_LAUNCH
    (void)xcd_barrier_post((unsigned*)(P.ws + WS_CTL) + CW_BAR, (volatile LAS unsigned*)(lds + LDS_CTL_OFF));
#define GRID_BAR() do { XcdBarrier b_; b_.bar = (unsigned*)(P.ws + WS_CTL) + CW_BAR; b_.x = xb_xcc_id(); b_.st = (volatile LAS unsigned*)(lds + LDS_CTL_OFF); xcd_barrier(b_); } while (0)
#else
#define GRID_BAR() do {} while (0)
#endif
    const int lo = P.ph_lo, hi = P.ph_hi;
#ifndef PH_MASK
#define PH_MASK 0x1fff
#endif
#define IN(k) (((PH_MASK >> (k)) & 1) && lo <= (k) && (k) < hi)
#define SEAM(k) do { if (IN(k) && IN((k) + 1)) GRID_BAR(); } while (0)

#ifndef REP_MASK
#define REP_MASK 0
#endif
#define PHASE(k, ...) do { if (IN(k)) { __VA_ARGS__ if ((REP_MASK >> (k)) & 1) { GRID_BAR(); __VA_ARGS__ } } SEAM(k); } while (0)
    const bool slots = (G == 256); constexpr int NG_IN = 176;
    PHASE(0, { p0_adaln(P, lds, G, bid); p0_small_rows(P, G, bid); p0_w_int8<true>(P, lds, G, bid, 0); p0_w_int8<false>(P, lds, G, bid, G >= 256 ? 192 : 0); __syncthreads(); if (!slots) conv_experts(P, lds, bid * 8 + wave_in_wg(), G * 8, 0, CV_ITEMS); });
    PHASE(1, { p1_modulate(P, lds, G, bid); });
    PHASE(2, { const int ng = slots ? NG_IN : G;
               if (bid < ng) { SchedIn S{P.ws, ng, bid}; pg8::EpiStore E{P.in[I_BIF], (const float*)(P.ws + WS_XSC), (const float*)(P.ws + WS_WSC)}; pg8::gemm_phase<pg8::EpiStore, SchedIn, true, true, 2>(lds, P.ws, D, S, E); }
               if (slots) conv_pool(P, lds, 0, 0, CV_NBLK_A); });
    PHASE(3, { for (int it = bid; it < 256; it += G) mlstm_pass1(P, lds, it >> 4, it & 15); });
    PHASE(4, { p4_scan(P, G, bid); });
    PHASE(5, { for (int it = bid; it < 256; it += G) { if (it >> 7) mlstm_item<true, 1>(P, lds, it >> 4, it & 15); else mlstm_item<true, 0>(P, lds, it >> 4, it & 15); } });
    PHASE(6, { p6_merge(P, G, bid); });
    PHASE(7, { SchedOut S{P.ws, G, bid}; pg8::EpiX1q E{P.in[I_X], (bf16_t*)(P.ws + WS_X1), (const float*)(P.ws + WS_MODF), (const float*)(P.ws + WS_ASC), (const float*)(P.ws + WS_WOSC)}; pg8::gemm_phase<pg8::EpiX1q, SchedOut, true, true, 2>(lds, P.ws, D, S, E); });
    PHASE(8, { p8_modulate(P, lds, G, bid); });
    PHASE(9, { SchedRouter S{P.ws, G, bid}; pg8::EpiLogits E{P.in[I_BR], (const float*)(P.ws + WS_RSTD), (const float*)(P.ws + WS_CBR)}; pg8::gemm_phase<pg8::EpiLogits, SchedRouter, true, true>(lds, P.ws, 2 * D, S, E);
               if (slots && bid >= 128) conv_pool(P, lds, 1, CV_NBLK_A, CV_NBLK_ALL);
               asm volatile("s_waitcnt vmcnt(0)" ::: "memory"); __syncthreads();
               for (int L = bid; L < 128; L += G) topk_block256(P, lds, L * 256); });
    PHASE(10, { moe_tables(P, lds, 16, G, bid); SchedMoeT<true> S{P.ws, (const LAS int*)(lds + LDS_CTL_OFF + 64), 0}; pg8::EpiAct E{P.in[I_BGU]}; pg8::gemm_phase<pg8::EpiAct, SchedMoeT<true>, true, true, 1>(lds, P.ws, D, S, E); });
    PHASE(11, { moe_tables(P, lds, 8, G, bid); SchedMoe S{P.ws, (const LAS int*)(lds + LDS_CTL_OFF + 64), 1}; pg8::EpiDown E{P.in[I_BDN], (unsigned char*)(P.ws + WS_YS)}; pg8::gemm_phase<pg8::EpiDown, SchedMoe, true, true, 1>(lds, P.ws, D, S, E); });
    PHASE(12, { p11_final(P, G, bid); });
#undef PHASE
#undef IN
#undef SEAM
}

extern "C" void kernel_launch(void* const* d_in, const int* in_sizes, int n_in, void* d_out, int out_size, void* d_ws, size_t ws_size, hipStream_t stream) {
    static int grid = 0;
    if (grid == 0) {
        if (n_in != 20 || out_size != T * D || ws_size < WS_END) { fprintf(stderr, "kernel_launch: unexpected shapes (n_in %d, out %d, ws %zu < %zu)\n", n_in, out_size, ws_size, (size_t)WS_END); grid = -1; return; }
        int dev = 0, cus = 0, per_cu = 0;
        if (hipGetDevice(&dev) != hipSuccess || hipDeviceGetAttribute(&cus, hipDeviceAttributeMultiprocessorCount, dev) != hipSuccess) { grid = -1; return; }
        if (hipFuncSetAttribute((const void*)hymba_fwd, hipFuncAttributeMaxDynamicSharedMemorySize, LDS_BYTES) != hipSuccess) { fprintf(stderr, "kernel_launch: hipFuncSetAttribute failed\n"); grid = -1; return; }
        if (hipOccupancyMaxActiveBlocksPerMultiprocessor(&per_cu, (const void*)hymba_fwd, 512, LDS_BYTES) != hipSuccess || per_cu < 1) fprintf(stderr, "kernel_launch: occupancy query reports %d\n", per_cu);
        (void)hipGetLastError();
        grid = cus;
    }
    if (grid < 0) return;
    (void)hipMemsetAsync((char*)d_ws + WS_CTL, 0, CTL_ZERO_BYTES, stream);
    Params p{};
    for (int i = 0; i < 20; ++i) p.in[i] = (const float*)d_in[i];
    p.out = (float*)d_out; p.ws = (unsigned char*)d_ws;
#if MK_ONE_LAUNCH
    p.ph_lo = 0; p.ph_hi = NPH;
    hipLaunchKernelGGL(hymba_fwd, dim3(grid), dim3(512), LDS_BYTES, stream, p);
#else
    for (int k = 0; k < NPH; ++k) { p.ph_lo = k; p.ph_hi = k + 1; hipLaunchKernelGGL(hymba_fwd, dim3(grid), dim3(512), LDS_BYTES, stream, p); }
#endif
}
```
